# Optimizing an MI355X kernel written in HIP

```python
import jax, jax.numpy as jnp
from jax import lax
import numpy as np

D_MODEL = 2048
BATCH = 2
SEQ = 4096
DEPTH = 1

N_META = 16
MIX_WIDTH = D_MODEL
HY_WIDTH = MIX_WIDTH // 2
HY_GROUPS = 8
HY_SHORT = 3
FILT_EMB = 33
FILT_BANDS = (FILT_EMB - 1) // 2
FILT_HIDDEN = 64
FILT_FAST_DECAY = 0.3
FILT_SLOW_DECAY = 1.5
FILT_TARGET = 1e-2
GLA_WIDTH = MIX_WIDTH - HY_WIDTH
GLA_HEADS = 4
GLA_KEY_WIDTH = GLA_WIDTH // 2
GLA_DK = GLA_KEY_WIDTH // GLA_HEADS
GLA_DV = GLA_WIDTH // GLA_HEADS
GATE_RANK = 16
GATE_NORMALIZER = 16.0
CHUNK = 64
D_FF = ((8 * D_MODEL // 3 + 255) // 256) * 256
IN_SPLITS = (3 * HY_WIDTH, GLA_KEY_WIDTH, GLA_KEY_WIDTH, GLA_WIDTH, GLA_WIDTH, 2 * GATE_RANK)
IN_COLS = 3 * HY_WIDTH + 2 * GLA_KEY_WIDTH + 2 * GLA_WIDTH + 2 * GATE_RANK
EPS = 1e-6

kernel_name = 'hybrid_hyena_gla_macaron_encoder'


def rms_norm(x, gain):
    xf = x.astype(jnp.float32)
    y = xf * lax.rsqrt(jnp.mean(xf * xf, axis=-1, keepdims=True) + EPS)
    return y.astype(x.dtype) * gain


def swiglu(h, w_gate, w_up, w_down):
    return (jax.nn.silu(h @ w_gate) * (h @ w_up)) @ w_down


def centred_short_conv(u, w, b):
    L = u.shape[1]
    half = (w.shape[0] - 1) // 2
    up = jnp.pad(u, ((0, 0), (half, half), (0, 0)))
    y = b
    for j in range(w.shape[0]):
        y = y + up[:, j:j + L] * w[j]
    return y


def hyena_filters(L, w1, b1, w2, b2, w3, freq):
    f32 = jnp.float32
    t = jnp.linspace(0.0, 1.0, L, dtype=f32)[:, None]
    w = (2.0 * np.pi / L) * jnp.arange(L, dtype=f32)
    bands = jnp.linspace(1e-4, FILT_BANDS - 1, FILT_BANDS, dtype=f32)
    ang = w[:, None] * bands[None, :]
    feats = jnp.concatenate([t, jnp.cos(ang), -jnp.sin(ang)], axis=-1)
    freq = freq.astype(f32)
    z = jnp.sin(freq * (feats @ w1.astype(f32) + b1.astype(f32)))
    z = jnp.sin(freq * (z @ w2.astype(f32) + b2.astype(f32)))
    h = z @ w3.astype(f32)
    deltas = jnp.abs(jnp.linspace(np.log(FILT_TARGET) / FILT_SLOW_DECAY,
                                  np.log(FILT_TARGET) / FILT_FAST_DECAY, HY_WIDTH, dtype=f32))
    window = jnp.exp(-t * deltas[None, :])
    h = h.reshape(L, 2, HY_WIDTH) * window[:, None, :]
    return h[:, 0], h[:, 1]


def bidirectional_long_conv(u, h_fwd, h_bwd):
    B, L, C = u.shape
    g = jnp.concatenate([h_fwd[:1] + h_bwd[:1], h_fwd[1:], jnp.zeros((1, C), h_fwd.dtype), h_bwd[:0:-1]], axis=0)
    G = jnp.fft.rfft(g, axis=0)
    U = jnp.fft.rfft(u.astype(jnp.float32), n=2 * L, axis=1)
    y = jnp.fft.irfft(U * G[None], n=2 * L, axis=1)[:, :L]
    return y.astype(u.dtype)


def gla_chunk_scan(q, k, v, g):
    B, H, T, dk = q.shape
    dv = v.shape[-1]
    n = T // CHUNK

    def to_chunks(a):
        return jnp.moveaxis(a.reshape(B, H, n, CHUNK, a.shape[-1]), 2, 0)

    qc, kc, vc, gc = to_chunks(q), to_chunks(k), to_chunks(v), to_chunks(g)
    bc = jnp.cumsum(gc, axis=-2)
    mask = jnp.tril(jnp.ones((CHUNK, CHUNK), dtype=bool))

    def step(S, xs):
        qi, ki, vi, bi = xs
        o_inter = jnp.einsum('bhcd,bhde->bhce', qi * jnp.exp(bi), S)
        diff = bi[:, :, :, None, :] - bi[:, :, None, :, :]
        dec = jnp.exp(jnp.where(mask[:, :, None], diff, -jnp.inf))
        A = jnp.einsum('bhid,bhjd,bhijd->bhij', qi, ki, dec)
        o_intra = jnp.einsum('bhij,bhje->bhie', A, vi)
        b_last = bi[:, :, -1:, :]
        S = S * jnp.exp(b_last)[:, :, 0, :, None] + jnp.einsum('bhcd,bhce->bhde', ki * jnp.exp(b_last - bi), vi)
        return S, o_inter + o_intra

    S0 = jnp.zeros((B, H, dk, dv), jnp.float32)
    _, o = lax.scan(step, S0, (qc, kc, vc, bc))
    return jnp.moveaxis(o, 0, 2).reshape(B, H, T, dv)


def gla_bidirectional(q, k, v, lg_f, lg_b):
    L = q.shape[1]
    pad_front = (-N_META) % CHUNK
    pad_back = (-(pad_front + L)) % CHUNK

    def prep(a):
        a = jnp.pad(a, ((0, 0), (pad_front, pad_back), (0, 0), (0, 0)))
        return jnp.transpose(a, (0, 2, 1, 3))

    qp, kp, vp, gf, gb = prep(q), prep(k), prep(v), prep(lg_f), prep(lg_b)
    flip = lambda a: a[:, :, ::-1]
    o_f = gla_chunk_scan(qp, kp, vp, gf)
    o_b = flip(gla_chunk_scan(flip(qp), flip(kp), flip(vp), flip(gb)))
    o = (o_f + o_b)[:, :, pad_front:pad_front + L]
    return jnp.transpose(o, (0, 2, 1, 3))


def token_mixer(h, w_in, conv_w, conv_b, filt_w1, filt_b1, filt_w2, filt_b2, filt_w3, filt_freq,
                hyena_d, hyena_norm, gk_w2, gk_b2, gla_norm, w_out):
    B, L, _ = h.shape
    p = h @ w_in
    idx = np.cumsum(IN_SPLITS)[:-1].tolist()
    hy, q, k, v, og, lr = jnp.split(p, idx, axis=-1)

    hy = centred_short_conv(hy, conv_w, conv_b)
    x0, x1, vh = jnp.split(hy, 3, axis=-1)
    h_f, h_b = hyena_filters(L, filt_w1, filt_b1, filt_w2, filt_b2, filt_w3, filt_freq)
    u = vh * x1
    u = bidirectional_long_conv(u, h_f, h_b) + hyena_d * u
    y_h = u * x0
    y_h = rms_norm(y_h.reshape(B, L, HY_GROUPS, -1), hyena_norm.reshape(HY_GROUPS, -1)).reshape(B, L, HY_WIDTH)

    f32 = jnp.float32
    qh = q.reshape(B, L, GLA_HEADS, GLA_DK).astype(f32) * (GLA_DK ** -0.5)
    kh = k.reshape(B, L, GLA_HEADS, GLA_DK).astype(f32)
    vh_ = v.reshape(B, L, GLA_HEADS, GLA_DV).astype(f32)
    lr_f, lr_b = jnp.split(lr, 2, axis=-1)
    lg_f = jax.nn.log_sigmoid((lr_f @ gk_w2[0] + gk_b2[0]).astype(f32)) / GATE_NORMALIZER
    lg_b = jax.nn.log_sigmoid((lr_b @ gk_w2[1] + gk_b2[1]).astype(f32)) / GATE_NORMALIZER
    lg_f = lg_f.reshape(B, L, GLA_HEADS, GLA_DK)
    lg_b = lg_b.reshape(B, L, GLA_HEADS, GLA_DK)
    o = gla_bidirectional(qh, kh, vh_, lg_f, lg_b)
    o = rms_norm(o, gla_norm).reshape(B, L, GLA_WIDTH).astype(h.dtype)
    y_g = o * jax.nn.silu(og)

    return jnp.concatenate([y_h, y_g], axis=-1) @ w_out


def setup_inputs(seed: int = 0) -> dict:
    key = jax.random.key(seed)
    ks = iter(jax.random.split(key, 32))
    f32 = jnp.float32

    def nrm(shape, scale):
        return scale * jax.random.normal(next(ks), shape, f32)

    def gain(shape):
        return 1.0 + nrm(shape, 0.01)

    D, L_ = D_MODEL, DEPTH
    return {
        'x': nrm((BATCH, SEQ, D), 1.0),
        'meta_tokens': nrm((N_META, D), 1.0),
        'ffn1_norm': gain((L_, D)),
        'ffn1_w_gate': nrm((L_, D, D_FF), D ** -0.5),
        'ffn1_w_up': nrm((L_, D, D_FF), D ** -0.5),
        'ffn1_w_down': nrm((L_, D_FF, D), D_FF ** -0.5),
        'mix_norm': gain((L_, D)),
        'w_in': nrm((L_, D, IN_COLS), D ** -0.5),
        'conv_w': nrm((L_, HY_SHORT, 3 * HY_WIDTH), HY_SHORT ** -0.5),
        'conv_b': nrm((L_, 3 * HY_WIDTH), 0.01),
        'filt_w1': nrm((L_, FILT_EMB, FILT_HIDDEN), FILT_EMB ** -0.5),
        'filt_b1': nrm((L_, FILT_HIDDEN), 0.1),
        'filt_w2': nrm((L_, FILT_HIDDEN, FILT_HIDDEN), FILT_HIDDEN ** -0.5),
        'filt_b2': nrm((L_, FILT_HIDDEN), 0.1),
        'filt_w3': nrm((L_, FILT_HIDDEN, 2 * HY_WIDTH), FILT_HIDDEN ** -0.5),
        'filt_freq': gain((L_, FILT_HIDDEN)),
        'hyena_d': nrm((L_, HY_WIDTH), 1.0),
        'hyena_norm': gain((L_, HY_WIDTH)),
        'gk_w2': nrm((L_, 2, GATE_RANK, GLA_KEY_WIDTH), GATE_RANK ** -0.5),
        'gk_b2': nrm((L_, 2, GLA_KEY_WIDTH), 0.1),
        'gla_norm': gain((L_, GLA_DV)),
        'w_out': nrm((L_, MIX_WIDTH, D), MIX_WIDTH ** -0.5),
        'ffn2_norm': gain((L_, D)),
        'ffn2_w_gate': nrm((L_, D, D_FF), D ** -0.5),
        'ffn2_w_up': nrm((L_, D, D_FF), D ** -0.5),
        'ffn2_w_down': nrm((L_, D_FF, D), D_FF ** -0.5),
        'final_norm': gain((D,)),
    }


def reference(x, meta_tokens, ffn1_norm, ffn1_w_gate, ffn1_w_up, ffn1_w_down, mix_norm, w_in,
              conv_w, conv_b, filt_w1, filt_b1, filt_w2, filt_b2, filt_w3, filt_freq, hyena_d,
              hyena_norm, gk_w2, gk_b2, gla_norm, w_out, ffn2_norm, ffn2_w_gate, ffn2_w_up,
              ffn2_w_down, final_norm):
    B = x.shape[0]
    meta = jnp.broadcast_to(meta_tokens[None].astype(x.dtype), (B, N_META, D_MODEL))
    h = jnp.concatenate([meta, x], axis=1)
    for l in range(DEPTH):
        h = h + 0.5 * swiglu(rms_norm(h, ffn1_norm[l]), ffn1_w_gate[l], ffn1_w_up[l], ffn1_w_down[l])
        h = h + token_mixer(rms_norm(h, mix_norm[l]), w_in[l], conv_w[l], conv_b[l],
                            filt_w1[l], filt_b1[l], filt_w2[l], filt_b2[l], filt_w3[l], filt_freq[l],
                            hyena_d[l], hyena_norm[l], gk_w2[l], gk_b2[l], gla_norm[l], w_out[l])
        h = h + 0.5 * swiglu(rms_norm(h, ffn2_norm[l]), ffn2_w_gate[l], ffn2_w_up[l], ffn2_w_down[l])
    h = rms_norm(h, final_norm)
    return h[:, N_META:]
```

```cpp
#include <hip/hip_runtime.h>
#include <hip/hip_cooperative_groups.h>
#include <cstdio>
namespace cg = cooperative_groups;
namespace pg8 {
#define PG8_LAS __attribute__((address_space(3)))
typedef unsigned short bf16_t;
typedef short bf16x8 __attribute__((ext_vector_type(8)));
typedef float f32x4 __attribute__((ext_vector_type(4)));
typedef unsigned u32x4 __attribute__((ext_vector_type(4)));
constexpr int BM = 256, BK = 64, HALF = 128, HTB = HALF * BK * 2  , STAGE_BYTES = 8 * HTB, NXCD = 8, WGM = 8;

__host__ __device__ __forceinline__ int lds_byte(int r, int c) { const int st = (r >> 4) * 2 + (c >> 5), rr = r & 15, cc = c & 31, ob = rr * 64 + cc * 2; return st * 1024 + (ob ^ (((ob >> 9) & 1) << 5)); }
__host__ __device__ __forceinline__ void stage_rc(int b, int& R, int& C) { const int st = b / 1024, sb = b % 1024, swz = sb ^ (((sb >> 9) & 1) << 5); R = (st >> 1) * 16 + swz / 64; C = (st & 1) * 32 + (swz % 64) / 2; }
__host__ __device__ __forceinline__ int perm32(int rho) { const int n = rho >> 4, i = rho & 15; return 8 * (i >> 2) + 4 * n + (i & 3); }

struct Unit { int pm, pn; };
struct Gemm { const bf16_t* A; const bf16_t* Bt; int M, N, K; };

struct StaticOrder {
    int nM, nN, nwg, G, c;
    __host__ __device__ void init(int M, int N, int G_, int c_) { nM = M / BM; nN = N / BM; nwg = nM * nN; G = G_; c = c_; }
    __host__ __device__ bool next(int i, Unit& u) const {
        const long L = (long)i * G + c; if (L >= nwg) return false;
        int wgid = (int)L; { const int q = nwg / NXCD, r = nwg % NXCD, xcd = wgid % NXCD, off = wgid / NXCD; wgid = (xcd < r ? xcd * (q + 1) : r * (q + 1) + (xcd - r) * q) + off; }
        const int nig = WGM * nN, gid = wgid / nig, fm = gid * WGM, gsz = (nM - fm) < WGM ? (nM - fm) : WGM;
        u.pm = fm + ((wgid % nig) % gsz); u.pn = (wgid % nig) / gsz; return true;
    }
    __device__ __forceinline__ void a_ready(const Unit&) const {}
    __device__ __forceinline__ void done(const Unit&) const {}
};
__device__ __forceinline__ unsigned cvt_pk_bf16(float lo, float hi) { unsigned r; asm volatile("v_cvt_pk_bf16_f32 %0, %1, %2" : "=v"(r) : "v"(lo), "v"(hi)); return r; }
template <class Epi, class Sched>
__device__ __forceinline__ void gemm_phase(PG8_LAS unsigned char* lds, const Gemm g, const Sched& S, const Epi& E) {
    const int tid = threadIdx.x, wid = __builtin_amdgcn_readfirstlane(tid >> 6), lane = tid & 63, wr = wid >> 2, wc = wid & 3, fr = lane & 15, fq = lane >> 4;
    const int K = g.K, nt = K / BK;
    unsigned voffA[2], voffB[2];
#pragma unroll
    for (int i = 0; i < 2; ++i) { int R, C; stage_rc(tid * 16 + i * 8192, R, C); const int Rb = Epi::PERM ? ((R & ~31) + perm32(R & 31)) : R;
        voffA[i] = (unsigned)(R * K + C) * 2u; voffB[i] = (unsigned)(Rb * K + C) * 2u; }
    const size_t kstep = (size_t)(BK * 2);
    const size_t hstep = (size_t)HALF * K * 2;
    const size_t tstep = 2 * hstep;
    const unsigned ldsw = (unsigned)wid * 1024u;
    const int aoff = lds_byte(wr * 64 + fr, fq * 8), boff = lds_byte(wc * 32 + fr, fq * 8);
#define PG8_SA(b, h) (((b) * 2 + (h)) * HTB)
#define PG8_SB(b, h) ((4 + (b) * 2 + (h)) * HTB)
#define PG8_STAGE(bufoff, gbase, voff) do { _Pragma("unroll") for (int _i = 0; _i < 2; ++_i) \
        __builtin_amdgcn_global_load_lds((const unsigned*)((const char*)(gbase) + (voff)[_i]), (PG8_LAS unsigned*)(lds + (bufoff) + ldsw + _i * 8192), 16, 0, 0); } while (0)
#define PG8_LDA(dst, b, h) do { _Pragma("unroll") for (int m = 0; m < 4; ++m) _Pragma("unroll") for (int k = 0; k < 2; ++k) dst[m][k] = *(const PG8_LAS bf16x8*)(lds + PG8_SA(b, h) + aoff + m * 2048 + k * 1024); } while (0)
#define PG8_LDB(dst, b, h) do { _Pragma("unroll") for (int n = 0; n < 2; ++n) _Pragma("unroll") for (int k = 0; k < 2; ++k) dst[n][k] = *(const PG8_LAS bf16x8*)(lds + PG8_SB(b, h) + boff + n * 2048 + k * 1024); } while (0)
#define PG8_MMA(ai, bj, At, Bt) do { __builtin_amdgcn_s_setprio(1); _Pragma("unroll") for (int m = 0; m < 4; ++m) _Pragma("unroll") for (int n = 0; n < 2; ++n) _Pragma("unroll") for (int k = 0; k < 2; ++k) \
        acc[ai][bj][m][n] = __builtin_amdgcn_mfma_f32_16x16x32_bf16(Bt[n][k], At[m][k], acc[ai][bj][m][n], 0, 0, 0); __builtin_amdgcn_s_setprio(0); } while (0)
#define PG8_WAIT_V(n) asm volatile("s_waitcnt vmcnt(" #n ")" ::: "memory")
#define PG8_WAIT_L(n) asm volatile("s_waitcnt lgkmcnt(" #n ")" ::: "memory")
#define PG8_BAR __builtin_amdgcn_s_barrier()
#define PG8_SCHED __builtin_amdgcn_sched_barrier(0)
    Unit cur, nxt; int ui = 0;
    if (!S.next(0, cur)) return;
    f32x4 acc[2][2][4][2];
#pragma unroll
    for (int a = 0; a < 2; ++a)
#pragma unroll
        for (int b = 0; b < 2; ++b)
#pragma unroll
            for (int m = 0; m < 4; ++m)
#pragma unroll
                for (int n = 0; n < 2; ++n) acc[a][b][m][n] = (f32x4){0.f, 0.f, 0.f, 0.f};
    bf16x8 At[4][2], B0[2][2], B1[2][2];
    const char* cA = (const char*)g.A + (size_t)cur.pm * tstep; const char* cB = (const char*)g.Bt + (size_t)cur.pn * tstep;
    S.a_ready(cur);
    PG8_STAGE(PG8_SB(0, 0), cB, voffB); PG8_STAGE(PG8_SA(0, 0), cA, voffA); PG8_STAGE(PG8_SB(0, 1), cB + hstep, voffB); PG8_STAGE(PG8_SA(0, 1), cA + hstep, voffA);
    if (wr == 1) PG8_BAR;
    PG8_WAIT_V(4); PG8_BAR;
    PG8_STAGE(PG8_SB(1, 0), cB + kstep, voffB); PG8_STAGE(PG8_SA(1, 0), cA + kstep, voffA); PG8_STAGE(PG8_SB(1, 1), cB + hstep + kstep, voffB);
    PG8_WAIT_V(6); PG8_BAR;
    for (;;) {
        const bool has_next = S.next(ui + 1, nxt);
        const char* nA = has_next ? (const char*)g.A + (size_t)nxt.pm * tstep : cA; const char* nB = has_next ? (const char*)g.Bt + (size_t)nxt.pn * tstep : cB;
        for (int t = 0; t < nt; t += 2) {
            const bool last = (t == nt - 2);
            const char* a1 = cA + (size_t)(t + 1) * kstep;
            const char* a2 = last ? nA : cA + (size_t)(t + 2) * kstep; const char* b2 = last ? nB : cB + (size_t)(t + 2) * kstep;
            const char* a3 = a2 + kstep; const char* b3 = b2 + kstep;
            if (last && has_next) S.a_ready(nxt);
            PG8_LDB(B0, 0, 0); PG8_SCHED; PG8_LDA(At, 0, 0); PG8_STAGE(PG8_SA(1, 1), a1 + hstep, voffA);
            PG8_WAIT_L(8); PG8_BAR; PG8_WAIT_L(0); PG8_MMA(0, 0, At, B0); PG8_BAR; PG8_SCHED;
            PG8_LDB(B1, 0, 1); PG8_STAGE(PG8_SB(0, 0), b2, voffB);
            PG8_BAR; PG8_WAIT_L(0); PG8_MMA(0, 1, At, B1); PG8_BAR;
            PG8_LDA(At, 0, 1); PG8_STAGE(PG8_SA(0, 0), a2, voffA);
            PG8_BAR; PG8_WAIT_L(0); PG8_MMA(1, 0, At, B0); PG8_BAR; PG8_SCHED;
            PG8_STAGE(PG8_SB(0, 1), b2 + hstep, voffB);
            PG8_WAIT_V(6); PG8_BAR; PG8_MMA(1, 1, At, B1); PG8_BAR;
            PG8_LDB(B0, 1, 0); PG8_SCHED; PG8_LDA(At, 1, 0); PG8_STAGE(PG8_SA(0, 1), a2 + hstep, voffA);
            PG8_WAIT_L(8); PG8_BAR; PG8_WAIT_L(0); PG8_MMA(0, 0, At, B0); PG8_BAR; PG8_SCHED;
            PG8_LDB(B1, 1, 1); PG8_STAGE(PG8_SB(1, 0), b3, voffB);
            PG8_BAR; PG8_WAIT_L(0); PG8_MMA(0, 1, At, B1); PG8_BAR;
            PG8_LDA(At, 1, 1); PG8_STAGE(PG8_SA(1, 0), a3, voffA);
            PG8_BAR; PG8_WAIT_L(0); PG8_MMA(1, 0, At, B0); PG8_BAR; PG8_SCHED;
            PG8_STAGE(PG8_SB(1, 1), b3 + hstep, voffB);
            PG8_WAIT_V(6); PG8_BAR; PG8_MMA(1, 1, At, B1); PG8_BAR;
        }
        if constexpr (!Epi::AFTER_DRAIN) { E(acc, cur, wr, wc, fr, fq); S.done(cur); }
        if (!has_next) break;
#pragma unroll
        for (int a = 0; a < 2; ++a)
#pragma unroll
            for (int b = 0; b < 2; ++b)
#pragma unroll
                for (int m = 0; m < 4; ++m)
#pragma unroll
                    for (int n = 0; n < 2; ++n) acc[a][b][m][n] = (f32x4){0.f, 0.f, 0.f, 0.f};
        cur = nxt; cA = nA; cB = nB; ++ui;
    }
    PG8_WAIT_V(0);
    if (wr == 0) PG8_BAR;
    PG8_BAR;
    if constexpr (Epi::AFTER_DRAIN) { E.fused(acc, cur, wr, wc, fr, fq, lds, wid, lane); S.done(cur); }
#undef PG8_SA
#undef PG8_SB
#undef PG8_STAGE
#undef PG8_LDA
#undef PG8_LDB
#undef PG8_MMA
#undef PG8_WAIT_V
#undef PG8_WAIT_L
#undef PG8_BAR
#undef PG8_SCHED
}
}

#include <cstdio>
#include <ctime>
#include <cstdlib>
#include <cstring>
#include <cmath>
#include <vector>
#include <algorithm>

using pg8::bf16_t; using pg8::f32x4; using pg8::Unit;
typedef unsigned u32x2v __attribute__((ext_vector_type(2)));
typedef unsigned u32x4v __attribute__((ext_vector_type(4)));

constexpr int D = 2048, SEQ = 4096, NMETA = 16, L = 4112, M = 8224, MP = 8448, DFF = 5632, INC = 6176, INCP = 6400;
constexpr float EPS = 1e-6f;
constexpr int LDS_BYTES = 131072 + 2048;
constexpr int C_Q = 3072, C_K = 3584, C_V = 4096, C_OG = 5120, C_LR = 6144;

struct Params {
    const float *x, *meta, *ffn1_norm, *ffn1_wg, *ffn1_wu, *ffn1_wd, *mix_norm, *w_in, *conv_w, *conv_b,
        *filt_w1, *filt_b1, *filt_w2, *filt_b2, *filt_w3, *filt_freq, *hyena_d, *hyena_norm, *gk_w2, *gk_b2, *gla_norm, *w_out,
        *ffn2_norm, *ffn2_wg, *ffn2_wu, *ffn2_wd, *final_norm;
    float* out;
    bf16_t *Wgu1, *Wd1, *Win, *Wout, *Wgu2, *Wd2;
    float* h; bf16_t* hb; bf16_t* big; float* rowss; float* z2;
    bf16_t* y; float* yh; float* of; float* ob;
};

__device__ __forceinline__ float bf2f(bf16_t b) { return __uint_as_float(((unsigned)b) << 16); }
__device__ __forceinline__ unsigned pk2(float lo, float hi) { return pg8::cvt_pk_bf16(lo, hi); }
__device__ __forceinline__ float wave_sum(float v) {
#pragma unroll
    for (int o = 32; o; o >>= 1) v += __shfl_xor(v, o);
    return v;
}
__device__ __forceinline__ float silu_f(float x) { return x * __builtin_amdgcn_rcpf(1.0f + __expf(-x)); }

__device__ __forceinline__ float row_rscale(const float* rowss, int r, int fq) {
    const f32x4* q = (const f32x4*)(rowss + (size_t)r * 32 + fq * 8);
    const f32x4 a = q[0], b = q[1];
    float s = ((a[0] + a[1]) + (a[2] + a[3])) + ((b[0] + b[1]) + (b[2] + b[3]));
    s += __shfl_xor(s, 16); s += __shfl_xor(s, 32);
    return rsqrtf(s * (1.0f / D) + EPS);
}

struct EpiSwiglu {
    static constexpr bool PERM = true, AFTER_DRAIN = false;
    bf16_t* O; const float* rowss;
    __device__ __forceinline__ void operator()(const f32x4 (&acc)[2][2][4][2], const Unit& u, int wr, int wc, int fr, int fq) const {
        const int row0 = u.pm * 256 + wr * 64 + fr, col0 = u.pn * 128 + wc * 32 + 8 * fq;
#pragma unroll
        for (int ai = 0; ai < 2; ++ai)
#pragma unroll
            for (int m = 0; m < 4; ++m) {
                const int r = row0 + ai * 128 + m * 16; const float rs = row_rscale(rowss, r, fq);
                u32x4v w;
#pragma unroll
                for (int n = 0; n < 2; ++n) { const f32x4 g = acc[ai][0][m][n] * rs, uu = acc[ai][1][m][n] * rs;
                    w[2 * n] = pk2(silu_f(g[0]) * uu[0], silu_f(g[1]) * uu[1]); w[2 * n + 1] = pk2(silu_f(g[2]) * uu[2], silu_f(g[3]) * uu[3]); }
                *(u32x4v*)(O + (size_t)r * DFF + col0) = w;
            }
    }
};
struct EpiScale {
    static constexpr bool PERM = true, AFTER_DRAIN = false;
    bf16_t* O; int ldc; const float* rowss;
    __device__ __forceinline__ void operator()(const f32x4 (&acc)[2][2][4][2], const Unit& u, int wr, int wc, int fr, int fq) const {
        const int row0 = u.pm * 256 + wr * 64 + fr, col0 = u.pn * 256 + wc * 32 + 8 * fq;
#pragma unroll
        for (int ai = 0; ai < 2; ++ai)
#pragma unroll
            for (int m = 0; m < 4; ++m) {
                const int r = row0 + ai * 128 + m * 16; const float rs = row_rscale(rowss, r, fq);
#pragma unroll
                for (int bj = 0; bj < 2; ++bj) { const f32x4 a = acc[ai][bj][m][0] * rs, b = acc[ai][bj][m][1] * rs;
                    u32x4v w; w[0] = pk2(a[0], a[1]); w[1] = pk2(a[2], a[3]); w[2] = pk2(b[0], b[1]); w[3] = pk2(b[2], b[3]);
                    *(u32x4v*)(O + (size_t)r * ldc + col0 + bj * 128) = w; }
            }
    }
};
template <bool WHB> struct EpiResid {
    static constexpr bool PERM = true, AFTER_DRAIN = false;
    float* H; bf16_t* HB; float* rowss; float scale;
    __device__ __forceinline__ void operator()(const f32x4 (&acc)[2][2][4][2], const Unit& u, int wr, int wc, int fr, int fq) const {
        const int row0 = u.pm * 256 + wr * 64 + fr, col0 = u.pn * 256 + wc * 32 + 8 * fq;
#pragma unroll
        for (int ai = 0; ai < 2; ++ai)
#pragma unroll
            for (int m = 0; m < 4; ++m) {
                const int r = row0 + ai * 128 + m * 16; float ss = 0.f;
#pragma unroll
                for (int bj = 0; bj < 2; ++bj) { float* hp = H + (size_t)r * D + col0 + bj * 128;
                    f32x4 a = *(const f32x4*)hp, b = *(const f32x4*)(hp + 4);
                    a += acc[ai][bj][m][0] * scale; b += acc[ai][bj][m][1] * scale;
                    *(f32x4*)hp = a; *(f32x4*)(hp + 4) = b;
                    ss += (a[0] * a[0] + a[1] * a[1]) + (a[2] * a[2] + a[3] * a[3]) + (b[0] * b[0] + b[1] * b[1]) + (b[2] * b[2] + b[3] * b[3]);
                    if (WHB) { u32x4v w; w[0] = pk2(a[0], a[1]); w[1] = pk2(a[2], a[3]); w[2] = pk2(b[0], b[1]); w[3] = pk2(b[2], b[3]);
                        *(u32x4v*)(HB + (size_t)r * D + col0 + bj * 128) = w; } }
                ss += __shfl_xor(ss, 16); ss += __shfl_xor(ss, 32);
                if (WHB && fq == 0) rowss[(size_t)r * 32 + u.pn * 4 + wc] = ss;
            }
    }
};

constexpr int NT_FFN = 2816, NT_WIN = 3200, NT_WOUT = 1024, NT_TR = 6 * NT_FFN + NT_WIN + NT_WOUT, NT_ROWS = MP / 8, NT_Z2 = (L + 7) / 8, P0_ITEMS = NT_TR + NT_ROWS + NT_Z2;

__device__ __forceinline__ void transpose_mat(const float* src, bf16_t* dst, const float* gain, const int K, const int N, const int ld, const int nvalid, const int mode, float* tl) {
    const int ntn = N / 64, ntiles = (K / 64) * ntn, tid = threadIdx.x;
    for (int it = blockIdx.x; it < ntiles; it += gridDim.x) {
        const int kt = it / ntn, nt = it - kt * ntn, k0 = kt * 64, n0 = nt * 64;
        const long drow0 = mode == 0 ? n0 : (n0 / 128) * 256 + (n0 % 128) + (mode == 2 ? 128 : 0);
        { const int r = tid >> 4, c4 = (tid & 15) * 4;
#pragma unroll
          for (int i = 0; i < 2; ++i) { const int row = r + 32 * i, k = k0 + row, n = n0 + c4;
              f32x4 v = {0.f, 0.f, 0.f, 0.f};
              if (n < nvalid) v = *(const f32x4*)(src + (size_t)k * ld + n);
              const float g = gain ? gain[k] : 1.0f;
              float* t = tl + row * 65 + c4; t[0] = v[0] * g; t[1] = v[1] * g; t[2] = v[2] * g; t[3] = v[3] * g; } }
        __syncthreads();
        { const int n = tid >> 3, k8 = (tid & 7) * 8; float v[8];
#pragma unroll
          for (int j = 0; j < 8; ++j) v[j] = tl[(k8 + j) * 65 + n];
          u32x4v w; w[0] = pk2(v[0], v[1]); w[1] = pk2(v[2], v[3]); w[2] = pk2(v[4], v[5]); w[3] = pk2(v[6], v[7]);
          *(u32x4v*)(dst + (size_t)(drow0 + n) * K + k0 + k8) = w; }
        __syncthreads();
    }
}

__device__ void row_item(const Params& p, int item) {
    const int wid = threadIdx.x >> 6, lane = threadIdx.x & 63, m = item * 8 + wid;
    float* hrow = p.h + (size_t)m * D; bf16_t* hbrow = p.hb + (size_t)m * D;
    if (m < M) { const int b = m / L, t = m - b * L;
        const float* src = t < NMETA ? p.meta + (size_t)t * D : p.x + ((size_t)b * SEQ + t - NMETA) * D;
        float ss = 0.f;
#pragma unroll
        for (int i = 0; i < 8; ++i) { const int c = (lane + 64 * i) * 4; const f32x4 v = *(const f32x4*)(src + c);
            ss += (v[0] * v[0] + v[1] * v[1]) + (v[2] * v[2] + v[3] * v[3]);
            *(f32x4*)(hrow + c) = v; u32x2v w; w[0] = pk2(v[0], v[1]); w[1] = pk2(v[2], v[3]); *(u32x2v*)(hbrow + c) = w; }
        ss = wave_sum(ss);
        if (lane < 32) p.rowss[(size_t)m * 32 + lane] = lane == 0 ? ss : 0.f;
    } else {
#pragma unroll
        for (int i = 0; i < 8; ++i) { const int c = (lane + 64 * i) * 4; *(f32x4*)(hrow + c) = (f32x4){0.f, 0.f, 0.f, 0.f}; u32x2v w; w[0] = 0u; w[1] = 0u; *(u32x2v*)(hbrow + c) = w; }
        if (lane < 32) p.rowss[(size_t)m * 32 + lane] = 0.f;
    }
}

__device__ void z2_item(const Params& p, int item) {
    const int wid = threadIdx.x >> 6, lane = threadIdx.x & 63, j = item * 8 + wid;
    if (j >= L) return;
    float feat = 0.f;
    const float w = (float)(2.0 * 3.14159265358979323846 / L) * (float)j;
    if (lane == 0) feat = (float)j * (1.0f / (float)(L - 1));
    else if (lane <= 32) { const int bi = (lane - 1) & 15; const float band = 1e-4f + (float)bi * ((15.0f - 1e-4f) / 15.0f); const float ang = w * band;
        feat = lane <= 16 ? cosf(ang) : -sinf(ang); }
    float a = p.filt_b1[lane];
    for (int i = 0; i < 33; ++i) a += __shfl(feat, i) * p.filt_w1[i * 64 + lane];
    const float fr = p.filt_freq[lane];
    const float z1 = sinf(fr * a);
    float c = p.filt_b2[lane];
    for (int k = 0; k < 64; ++k) c += __shfl(z1, k) * p.filt_w2[k * 64 + lane];
    p.z2[(size_t)j * 64 + lane] = sinf(fr * c);
}

__device__ void hyena_naive(const Params& p, int item, float* sm) {
    const int b = item >> 10, c = item & 1023, tid = threadIdx.x;
    float* G = sm; float* U = sm + 8736; float* X0 = U + 4128; float* W3 = X0 + 4128;
    if (tid < 128) W3[tid] = p.filt_w3[(size_t)(tid & 63) * 2048 + (tid >> 6) * 1024 + c];
    for (int i = tid; i < 8736; i += 512) G[i] = 0.f;
    __syncthreads();
    const float la = -3.0701134573253945f, lb = -15.350567286626973f;
    const float delta = fabsf(la + (float)c * ((lb - la) / 1023.0f));
    for (int j = tid; j < L; j += 512) {
        const float* z = p.z2 + (size_t)j * 64; float hf = 0.f, hbk = 0.f;
        for (int k = 0; k < 64; ++k) { const float zz = z[k]; hf += zz * W3[k]; hbk += zz * W3[64 + k]; }
        const float t = (float)j * (1.0f / (float)(L - 1)); const float win = expf(-t * delta); hf *= win; hbk *= win;
        if (j == 0) G[L - 1] = hf + hbk; else { G[L - 1 + j] = hf; G[L - 1 - j] = hbk; }
    }
    const float cb0 = p.conv_b[c], cb1 = p.conv_b[1024 + c], cb2 = p.conv_b[2048 + c];
    for (int t = tid; t < L; t += 512) {
        float a0 = cb0, a1 = cb1, a2 = cb2;
#pragma unroll
        for (int jj = 0; jj < 3; ++jj) { const int tt = t + jj - 1;
            if (tt >= 0 && tt < L) { const bf16_t* row = p.big + (size_t)(b * L + tt) * INCP;
                a0 += bf2f(row[c]) * p.conv_w[jj * 3072 + c]; a1 += bf2f(row[1024 + c]) * p.conv_w[jj * 3072 + 1024 + c]; a2 += bf2f(row[2048 + c]) * p.conv_w[jj * 3072 + 2048 + c]; } }
        X0[t] = a0; U[t] = a2 * a1;
    }
    __syncthreads();
    float acc[9];
#pragma unroll
    for (int i = 0; i < 9; ++i) acc[i] = 0.f;
    for (int s = 0; s < L; ++s) { const float us = U[s]; const float* gp = G + (L - 1 - s) + tid;
#pragma unroll
        for (int i = 0; i < 9; ++i) acc[i] += gp[512 * i] * us; }
    const float dc = p.hyena_d[c];
#pragma unroll
    for (int i = 0; i < 9; ++i) { const int t = tid + 512 * i; if (t < L) p.yh[(size_t)(b * L + t) * 1024 + c] = (acc[i] + dc * U[t]) * X0[t]; }
    __syncthreads();
}

__device__ void gla_naive(const Params& p, int item, float* sm) {
    const int dir = item & 1, hh = (item >> 1) & 3, b = item >> 3, tid = threadIdx.x, e = tid & 255, half = tid >> 8;
    float* Q = sm; float* Kk = Q + 2048; float* A = Kk + 2048; float* V = A + 2048; float* PO = V + 4096; float* LR = PO + 8192; float* W2s = LR + 256; float* B2s = W2s + 2048;
    for (int i = tid; i < 2048; i += 512) { const int r = i >> 7, d = i & 127; W2s[i] = p.gk_w2[(size_t)(dir * 16 + r) * 512 + hh * 128 + d]; }
    if (tid < 128) B2s[tid] = p.gk_b2[dir * 512 + hh * 128 + tid];
    float S[64];
#pragma unroll
    for (int i = 0; i < 64; ++i) S[i] = 0.f;
    float* outp = dir ? p.ob : p.of;
    for (int t0 = 0; t0 < L; t0 += 16) {
        for (int idx = tid; idx < 2048; idx += 512) { const int i = idx >> 7, d = idx & 127; const int t = dir ? (L - 1 - (t0 + i)) : (t0 + i);
            const bf16_t* row = p.big + (size_t)(b * L + t) * INCP;
            Q[idx] = bf2f(row[C_Q + hh * 128 + d]) * 0.08838834764831845f; Kk[idx] = bf2f(row[C_K + hh * 128 + d]); }
        for (int idx = tid; idx < 4096; idx += 512) { const int i = idx >> 8, ee = idx & 255; const int t = dir ? (L - 1 - (t0 + i)) : (t0 + i);
            V[idx] = bf2f(p.big[(size_t)(b * L + t) * INCP + C_V + hh * 256 + ee]); }
        if (tid < 256) { const int i = tid >> 4, r = tid & 15; const int t = dir ? (L - 1 - (t0 + i)) : (t0 + i);
            LR[tid] = bf2f(p.big[(size_t)(b * L + t) * INCP + C_LR + dir * 16 + r]); }
        __syncthreads();
        for (int idx = tid; idx < 2048; idx += 512) { const int i = idx >> 7, d = idx & 127; float xg = B2s[d];
#pragma unroll
            for (int r = 0; r < 16; ++r) xg += LR[i * 16 + r] * W2s[r * 128 + d];
            const float ls = fminf(xg, 0.f) - log1pf(expf(-fabsf(xg)));
            A[idx] = expf(ls * (1.0f / 16.0f)); }
        __syncthreads();
        for (int i = 0; i < 16; ++i) { float po = 0.f; const float v = V[i * 256 + e];
            const float* ap = A + i * 128 + half * 64; const float* kp = Kk + i * 128 + half * 64; const float* qp = Q + i * 128 + half * 64;
#pragma unroll
            for (int dd = 0; dd < 64; ++dd) { S[dd] = S[dd] * ap[dd] + kp[dd] * v; po += qp[dd] * S[dd]; }
            PO[(i * 2 + half) * 256 + e] = po; }
        __syncthreads();
        for (int idx = tid; idx < 4096; idx += 512) { const int i = idx >> 8, ee = idx & 255; const int t = dir ? (L - 1 - (t0 + i)) : (t0 + i);
            outp[(size_t)(b * L + t) * 1024 + hh * 256 + ee] = PO[(i * 2) * 256 + ee] + PO[(i * 2 + 1) * 256 + ee]; }
    }
    __syncthreads();
}

__device__ void fin_item(const Params& p, int item) {
    const int wid = threadIdx.x >> 6, lane = threadIdx.x & 63, m = item * 8 + wid;
    bf16_t* yrow = p.y + (size_t)m * D;
    if (m >= M) { const u32x4v z = {0u, 0u, 0u, 0u};
#pragma unroll
        for (int i = 0; i < 4; ++i) *(u32x4v*)(yrow + (lane + 64 * i) * 8) = z;
        return; }
    const int c0 = lane * 16;
    { const float* src = p.yh + (size_t)m * 1024 + c0; f32x4 v[4]; float ss = 0.f;
#pragma unroll
      for (int i = 0; i < 4; ++i) { v[i] = *(const f32x4*)(src + 4 * i); ss += (v[i][0] * v[i][0] + v[i][1] * v[i][1]) + (v[i][2] * v[i][2] + v[i][3] * v[i][3]); }
      ss += __shfl_xor(ss, 1); ss += __shfl_xor(ss, 2); ss += __shfl_xor(ss, 4);
      const float r = rsqrtf(ss * (1.0f / 128.0f) + EPS);
      u32x4v w0, w1;
#pragma unroll
      for (int i = 0; i < 4; ++i) { const f32x4 g = *(const f32x4*)(p.hyena_norm + c0 + 4 * i); const f32x4 o = v[i] * r * g;
          if (i < 2) { w0[2 * i] = pk2(o[0], o[1]); w0[2 * i + 1] = pk2(o[2], o[3]); } else { w1[2 * i - 4] = pk2(o[0], o[1]); w1[2 * i - 3] = pk2(o[2], o[3]); } }
      *(u32x4v*)(yrow + c0) = w0; *(u32x4v*)(yrow + c0 + 8) = w1; }
    { const float* s1 = p.of + (size_t)m * 1024 + c0; const float* s2 = p.ob + (size_t)m * 1024 + c0; f32x4 v[4]; float ss = 0.f;
#pragma unroll
      for (int i = 0; i < 4; ++i) { v[i] = *(const f32x4*)(s1 + 4 * i) + *(const f32x4*)(s2 + 4 * i); ss += (v[i][0] * v[i][0] + v[i][1] * v[i][1]) + (v[i][2] * v[i][2] + v[i][3] * v[i][3]); }
      ss += __shfl_xor(ss, 1); ss += __shfl_xor(ss, 2); ss += __shfl_xor(ss, 4); ss += __shfl_xor(ss, 8);
      const float r = rsqrtf(ss * (1.0f / 256.0f) + EPS);
      const bf16_t* og = p.big + (size_t)m * INCP + C_OG + c0;
      const u32x4v g0 = *(const u32x4v*)og, g1 = *(const u32x4v*)(og + 8);
      float ogf[16];
#pragma unroll
      for (int i = 0; i < 4; ++i) { ogf[2 * i] = __uint_as_float(g0[i] << 16); ogf[2 * i + 1] = __uint_as_float(g0[i] & 0xffff0000u); ogf[8 + 2 * i] = __uint_as_float(g1[i] << 16); ogf[8 + 2 * i + 1] = __uint_as_float(g1[i] & 0xffff0000u); }
      u32x4v w0, w1;
#pragma unroll
      for (int i = 0; i < 4; ++i) { const f32x4 g = *(const f32x4*)(p.gla_norm + ((c0 + 4 * i) & 255)); f32x4 o = v[i] * r * g;
          o[0] *= silu_f(ogf[4 * i]); o[1] *= silu_f(ogf[4 * i + 1]); o[2] *= silu_f(ogf[4 * i + 2]); o[3] *= silu_f(ogf[4 * i + 3]);
          if (i < 2) { w0[2 * i] = pk2(o[0], o[1]); w0[2 * i + 1] = pk2(o[2], o[3]); } else { w1[2 * i - 4] = pk2(o[0], o[1]); w1[2 * i - 3] = pk2(o[2], o[3]); } }
      *(u32x4v*)(yrow + 1024 + c0) = w0; *(u32x4v*)(yrow + 1024 + c0 + 8) = w1; }
}

__device__ void final_item(const Params& p, int item) {
    const int wid = threadIdx.x >> 6, lane = threadIdx.x & 63, row = item * 8 + wid, b = row >> 12, s = row & 4095, m = b * L + NMETA + s;
    const float* hrow = p.h + (size_t)m * D; float* orow = p.out + (size_t)row * D; f32x4 v[8]; float ss = 0.f;
#pragma unroll
    for (int i = 0; i < 8; ++i) { v[i] = *(const f32x4*)(hrow + (lane + 64 * i) * 4); ss += (v[i][0] * v[i][0] + v[i][1] * v[i][1]) + (v[i][2] * v[i][2] + v[i][3] * v[i][3]); }
    ss = wave_sum(ss); const float r = rsqrtf(ss * (1.0f / D) + EPS);
#pragma unroll
    for (int i = 0; i < 8; ++i) { const int c = (lane + 64 * i) * 4; *(f32x4*)(orow + c) = v[i] * r * *(const f32x4*)(p.final_norm + c); }
}

template <class Epi> __device__ __forceinline__ void run_gemm(PG8_LAS unsigned char* lds, const bf16_t* A, const bf16_t* Bt, int N, int K, const Epi& E) {
    pg8::Gemm g; g.A = A; g.Bt = Bt; g.M = MP; g.N = N; g.K = K;
    pg8::StaticOrder S; S.init(MP, N, (int)gridDim.x, (int)blockIdx.x);
    pg8::gemm_phase<Epi, pg8::StaticOrder>(lds, g, S, E);
}

__global__ __launch_bounds__(512, 2) void mega(Params p) {
    extern __shared__ __attribute__((aligned(16))) unsigned char smem[];
    cg::grid_group grid = cg::this_grid();
    PG8_LAS unsigned char* lds = (PG8_LAS unsigned char*)smem;
    float* smf = (float*)smem;
    const int G = gridDim.x, bid = blockIdx.x;
    transpose_mat(p.ffn1_wg, p.Wgu1, p.ffn1_norm, D, DFF, DFF, DFF, 1, smf);
    transpose_mat(p.ffn1_wu, p.Wgu1, p.ffn1_norm, D, DFF, DFF, DFF, 2, smf);
    transpose_mat(p.ffn1_wd, p.Wd1, nullptr, DFF, D, D, D, 0, smf);
    transpose_mat(p.w_in, p.Win, p.mix_norm, D, INCP, INC, INC, 0, smf);
    transpose_mat(p.w_out, p.Wout, nullptr, D, D, D, D, 0, smf);
    transpose_mat(p.ffn2_wg, p.Wgu2, p.ffn2_norm, D, DFF, DFF, DFF, 1, smf);
    transpose_mat(p.ffn2_wu, p.Wgu2, p.ffn2_norm, D, DFF, DFF, DFF, 2, smf);
    transpose_mat(p.ffn2_wd, p.Wd2, nullptr, DFF, D, D, D, 0, smf);
    for (int it = bid; it < NT_ROWS + NT_Z2; it += G) { if (it < NT_ROWS) row_item(p, it); else z2_item(p, it - NT_ROWS); }
    grid.sync();
    { EpiSwiglu E; E.O = p.big; E.rowss = p.rowss; run_gemm(lds, p.hb, p.Wgu1, 2 * DFF, D, E); }
    grid.sync();
    { EpiResid<true> E; E.H = p.h; E.HB = p.hb; E.rowss = p.rowss; E.scale = 0.5f; run_gemm(lds, p.big, p.Wd1, D, DFF, E); }
    grid.sync();
    { EpiScale E; E.O = p.big; E.ldc = INCP; E.rowss = p.rowss; run_gemm(lds, p.hb, p.Win, INCP, D, E); }
    grid.sync();
    for (int it = bid; it < 16 + 2048; it += G) { if (it < 16) gla_naive(p, it, smf); else hyena_naive(p, it - 16, smf); }
    grid.sync();
    for (int it = bid; it < MP / 8; it += G) fin_item(p, it);
    grid.sync();
    { EpiResid<true> E; E.H = p.h; E.HB = p.hb; E.rowss = p.rowss; E.scale = 1.0f; run_gemm(lds, p.y, p.Wout, D, D, E); }
    grid.sync();
    { EpiSwiglu E; E.O = p.big; E.rowss = p.rowss; run_gemm(lds, p.hb, p.Wgu2, 2 * DFF, D, E); }
    grid.sync();
    { EpiResid<false> E; E.H = p.h; E.HB = nullptr; E.rowss = nullptr; E.scale = 0.5f; run_gemm(lds, p.big, p.Wd2, D, DFF, E); }
    grid.sync();
    for (int it = bid; it < 1024; it += G) final_item(p, it);
}

extern "C" void kernel_launch(void* const* d_in, const int* in_sizes, int n_in, void* d_out, int out_size, void* d_ws, size_t ws_size, hipStream_t stream) {
    static int grid_blocks = 0;
    if (!grid_blocks) {
        (void)hipFuncSetAttribute((const void*)mega, hipFuncAttributeMaxDynamicSharedMemorySize, LDS_BYTES);
        int dev = 0, cus = 0, per_cu = 0;
        (void)hipGetDevice(&dev);
        (void)hipDeviceGetAttribute(&cus, hipDeviceAttributeMultiprocessorCount, dev);
        (void)hipOccupancyMaxActiveBlocksPerMultiprocessor(&per_cu, mega, 512, LDS_BYTES);
        if (per_cu > 1) per_cu = 1;
        if (per_cu < 1) { fprintf(stderr, "occupancy query returned %d\n", per_cu); per_cu = 1; }
        grid_blocks = cus * per_cu;
    }
    Params p{};
    const float* const* in = (const float* const*)d_in;
    p.x = in[0]; p.meta = in[1]; p.ffn1_norm = in[2]; p.ffn1_wg = in[3]; p.ffn1_wu = in[4]; p.ffn1_wd = in[5]; p.mix_norm = in[6]; p.w_in = in[7];
    p.conv_w = in[8]; p.conv_b = in[9]; p.filt_w1 = in[10]; p.filt_b1 = in[11]; p.filt_w2 = in[12]; p.filt_b2 = in[13]; p.filt_w3 = in[14]; p.filt_freq = in[15];
    p.hyena_d = in[16]; p.hyena_norm = in[17]; p.gk_w2 = in[18]; p.gk_b2 = in[19]; p.gla_norm = in[20]; p.w_out = in[21];
    p.ffn2_norm = in[22]; p.ffn2_wg = in[23]; p.ffn2_wu = in[24]; p.ffn2_wd = in[25]; p.final_norm = in[26];
    p.out = (float*)d_out;
    unsigned char* ws = (unsigned char*)d_ws;
    constexpr size_t SZ_WGU = (size_t)2 * DFF * D * 2, SZ_WD = (size_t)D * DFF * 2, SZ_WIN = (size_t)INCP * D * 2, SZ_WOUT = (size_t)D * D * 2;
    constexpr size_t SZ_H = (size_t)MP * D * 4, SZ_HB = (size_t)MP * D * 2, SZ_BIG = (size_t)MP * INCP * 2, SZ_RS = (size_t)MP * 32 * 4, SZ_Z2 = (size_t)L * 64 * 4;
    size_t o = 0;
    p.Wgu1 = (bf16_t*)(ws + o); o += SZ_WGU; p.Wd1 = (bf16_t*)(ws + o); o += SZ_WD; p.Win = (bf16_t*)(ws + o); o += SZ_WIN; p.Wout = (bf16_t*)(ws + o); o += SZ_WOUT;
    p.Wgu2 = (bf16_t*)(ws + o); o += SZ_WGU; p.Wd2 = (bf16_t*)(ws + o); o += SZ_WD;
    p.h = (float*)(ws + o); o += SZ_H; p.hb = (bf16_t*)(ws + o); o += SZ_HB; p.big = (bf16_t*)(ws + o); o += SZ_BIG; p.rowss = (float*)(ws + o); o += SZ_RS; p.z2 = (float*)(ws + o); o += SZ_Z2;
    p.y = (bf16_t*)ws; p.yh = (float*)(ws + SZ_HB); p.of = (float*)p.hb; p.ob = (float*)d_out;
    if (o > ws_size) fprintf(stderr, "workspace too small: need %zu have %zu\n", o, ws_size);
    void* args[] = {&p};
    hipError_t e = hipLaunchCooperativeKernel((void*)mega, dim3(grid_blocks), dim3(512), args, LDS_BYTES, stream);
    if (e != hipSuccess) fprintf(stderr, "cooperative launch failed: %s (grid %d)\n", hipGetErrorString(e), grid_blocks);
}
```

```cpp
#include <hip/hip_runtime.h>
#include <hip/hip_cooperative_groups.h>
#include <cstdio>
namespace cg = cooperative_groups;
namespace pg8 {
#define PG8_LAS __attribute__((address_space(3)))
typedef unsigned short bf16_t;
typedef short bf16x8 __attribute__((ext_vector_type(8)));
typedef float f32x4 __attribute__((ext_vector_type(4)));
typedef unsigned u32x4 __attribute__((ext_vector_type(4)));
constexpr int BM = 256, BK = 64, HALF = 128, HTB = HALF * BK * 2  , STAGE_BYTES = 8 * HTB, NXCD = 8, WGM = 8;

__host__ __device__ __forceinline__ int lds_byte(int r, int c) { const int st = (r >> 4) * 2 + (c >> 5), rr = r & 15, cc = c & 31, ob = rr * 64 + cc * 2; return st * 1024 + (ob ^ (((ob >> 9) & 1) << 5)); }
__host__ __device__ __forceinline__ void stage_rc(int b, int& R, int& C) { const int st = b / 1024, sb = b % 1024, swz = sb ^ (((sb >> 9) & 1) << 5); R = (st >> 1) * 16 + swz / 64; C = (st & 1) * 32 + (swz % 64) / 2; }
__host__ __device__ __forceinline__ int perm32(int rho) { const int n = rho >> 4, i = rho & 15; return 8 * (i >> 2) + 4 * n + (i & 3); }

struct Unit { int pm, pn; };
struct Gemm { const bf16_t* A; const bf16_t* Bt; int M, N, K; };

struct StaticOrder {
    int nM, nN, nwg, G, c;
    __host__ __device__ void init(int M, int N, int G_, int c_) { nM = M / BM; nN = N / BM; nwg = nM * nN; G = G_; c = c_; }
    __host__ __device__ bool next(int i, Unit& u) const {
        const long L = (long)i * G + c; if (L >= nwg) return false;
        int wgid = (int)L; { const int q = nwg / NXCD, r = nwg % NXCD, xcd = wgid % NXCD, off = wgid / NXCD; wgid = (xcd < r ? xcd * (q + 1) : r * (q + 1) + (xcd - r) * q) + off; }
        const int nig = WGM * nN, gid = wgid / nig, fm = gid * WGM, gsz = (nM - fm) < WGM ? (nM - fm) : WGM;
        u.pm = fm + ((wgid % nig) % gsz); u.pn = (wgid % nig) / gsz; return true;
    }
    __device__ __forceinline__ void a_ready(const Unit&) const {}
    __device__ __forceinline__ void done(const Unit&) const {}
};
__device__ __forceinline__ unsigned cvt_pk_bf16(float lo, float hi) { unsigned r; asm volatile("v_cvt_pk_bf16_f32 %0, %1, %2" : "=v"(r) : "v"(lo), "v"(hi)); return r; }
template <class Epi, class Sched>
__device__ __forceinline__ void gemm_phase(PG8_LAS unsigned char* lds, const Gemm g, const Sched& S, const Epi& E) {
    const int tid = threadIdx.x, wid = __builtin_amdgcn_readfirstlane(tid >> 6), lane = tid & 63, wr = wid >> 2, wc = wid & 3, fr = lane & 15, fq = lane >> 4;
    const int K = g.K, nt = K / BK;
    unsigned voffA[2], voffB[2];
#pragma unroll
    for (int i = 0; i < 2; ++i) { int R, C; stage_rc(tid * 16 + i * 8192, R, C); const int Rb = Epi::PERM ? ((R & ~31) + perm32(R & 31)) : R;
        voffA[i] = (unsigned)(R * K + C) * 2u; voffB[i] = (unsigned)(Rb * K + C) * 2u; }
    const size_t kstep = (size_t)(BK * 2);
    const size_t hstep = (size_t)HALF * K * 2;
    const size_t tstep = 2 * hstep;
    const unsigned ldsw = (unsigned)wid * 1024u;
    const int aoff = lds_byte(wr * 64 + fr, fq * 8), boff = lds_byte(wc * 32 + fr, fq * 8);
#define PG8_SA(b, h) (((b) * 2 + (h)) * HTB)
#define PG8_SB(b, h) ((4 + (b) * 2 + (h)) * HTB)
#define PG8_STAGE(bufoff, gbase, voff) do { _Pragma("unroll") for (int _i = 0; _i < 2; ++_i) \
        __builtin_amdgcn_global_load_lds((const unsigned*)((const char*)(gbase) + (voff)[_i]), (PG8_LAS unsigned*)(lds + (bufoff) + ldsw + _i * 8192), 16, 0, 0); } while (0)
#define PG8_LDA(dst, b, h) do { _Pragma("unroll") for (int m = 0; m < 4; ++m) _Pragma("unroll") for (int k = 0; k < 2; ++k) dst[m][k] = *(const PG8_LAS bf16x8*)(lds + PG8_SA(b, h) + aoff + m * 2048 + k * 1024); } while (0)
#define PG8_LDB(dst, b, h) do { _Pragma("unroll") for (int n = 0; n < 2; ++n) _Pragma("unroll") for (int k = 0; k < 2; ++k) dst[n][k] = *(const PG8_LAS bf16x8*)(lds + PG8_SB(b, h) + boff + n * 2048 + k * 1024); } while (0)
#define PG8_MMA(ai, bj, At, Bt) do { __builtin_amdgcn_s_setprio(1); _Pragma("unroll") for (int m = 0; m < 4; ++m) _Pragma("unroll") for (int n = 0; n < 2; ++n) _Pragma("unroll") for (int k = 0; k < 2; ++k) \
        acc[ai][bj][m][n] = __builtin_amdgcn_mfma_f32_16x16x32_bf16(Bt[n][k], At[m][k], acc[ai][bj][m][n], 0, 0, 0); __builtin_amdgcn_s_setprio(0); } while (0)
#define PG8_WAIT_V(n) asm volatile("s_waitcnt vmcnt(" #n ")" ::: "memory")
#define PG8_WAIT_L(n) asm volatile("s_waitcnt lgkmcnt(" #n ")" ::: "memory")
#define PG8_BAR __builtin_amdgcn_s_barrier()
#define PG8_SCHED __builtin_amdgcn_sched_barrier(0)
    Unit cur, nxt; int ui = 0;
    if (!S.next(0, cur)) return;
    f32x4 acc[2][2][4][2];
#pragma unroll
    for (int a = 0; a < 2; ++a)
#pragma unroll
        for (int b = 0; b < 2; ++b)
#pragma unroll
            for (int m = 0; m < 4; ++m)
#pragma unroll
                for (int n = 0; n < 2; ++n) acc[a][b][m][n] = (f32x4){0.f, 0.f, 0.f, 0.f};
    bf16x8 At[4][2], B0[2][2], B1[2][2];
    const char* cA = (const char*)g.A + (size_t)cur.pm * tstep; const char* cB = (const char*)g.Bt + (size_t)cur.pn * tstep;
    S.a_ready(cur);
    PG8_STAGE(PG8_SB(0, 0), cB, voffB); PG8_STAGE(PG8_SA(0, 0), cA, voffA); PG8_STAGE(PG8_SB(0, 1), cB + hstep, voffB); PG8_STAGE(PG8_SA(0, 1), cA + hstep, voffA);
    if (wr == 1) PG8_BAR;
    PG8_WAIT_V(4); PG8_BAR;
    PG8_STAGE(PG8_SB(1, 0), cB + kstep, voffB); PG8_STAGE(PG8_SA(1, 0), cA + kstep, voffA); PG8_STAGE(PG8_SB(1, 1), cB + hstep + kstep, voffB);
    PG8_WAIT_V(6); PG8_BAR;
    for (;;) {
        const bool has_next = S.next(ui + 1, nxt);
        const char* nA = has_next ? (const char*)g.A + (size_t)nxt.pm * tstep : cA; const char* nB = has_next ? (const char*)g.Bt + (size_t)nxt.pn * tstep : cB;
        for (int t = 0; t < nt; t += 2) {
            const bool last = (t == nt - 2);
            const char* a1 = cA + (size_t)(t + 1) * kstep;
            const char* a2 = last ? nA : cA + (size_t)(t + 2) * kstep; const char* b2 = last ? nB : cB + (size_t)(t + 2) * kstep;
            const char* a3 = a2 + kstep; const char* b3 = b2 + kstep;
            if (last && has_next) S.a_ready(nxt);
            PG8_LDB(B0, 0, 0); PG8_SCHED; PG8_LDA(At, 0, 0); PG8_STAGE(PG8_SA(1, 1), a1 + hstep, voffA);
            PG8_WAIT_L(8); PG8_BAR; PG8_WAIT_L(0); PG8_MMA(0, 0, At, B0); PG8_BAR; PG8_SCHED;
            PG8_LDB(B1, 0, 1); PG8_STAGE(PG8_SB(0, 0), b2, voffB);
            PG8_BAR; PG8_WAIT_L(0); PG8_MMA(0, 1, At, B1); PG8_BAR;
            PG8_LDA(At, 0, 1); PG8_STAGE(PG8_SA(0, 0), a2, voffA);
            PG8_BAR; PG8_WAIT_L(0); PG8_MMA(1, 0, At, B0); PG8_BAR; PG8_SCHED;
            PG8_STAGE(PG8_SB(0, 1), b2 + hstep, voffB);
            PG8_WAIT_V(6); PG8_BAR; PG8_MMA(1, 1, At, B1); PG8_BAR;
            PG8_LDB(B0, 1, 0); PG8_SCHED; PG8_LDA(At, 1, 0); PG8_STAGE(PG8_SA(0, 1), a2 + hstep, voffA);
            PG8_WAIT_L(8); PG8_BAR; PG8_WAIT_L(0); PG8_MMA(0, 0, At, B0); PG8_BAR; PG8_SCHED;
            PG8_LDB(B1, 1, 1); PG8_STAGE(PG8_SB(1, 0), b3, voffB);
            PG8_BAR; PG8_WAIT_L(0); PG8_MMA(0, 1, At, B1); PG8_BAR;
            PG8_LDA(At, 1, 1); PG8_STAGE(PG8_SA(1, 0), a3, voffA);
            PG8_BAR; PG8_WAIT_L(0); PG8_MMA(1, 0, At, B0); PG8_BAR; PG8_SCHED;
            PG8_STAGE(PG8_SB(1, 1), b3 + hstep, voffB);
            PG8_WAIT_V(6); PG8_BAR; PG8_MMA(1, 1, At, B1); PG8_BAR;
        }
        if constexpr (!Epi::AFTER_DRAIN) { E(acc, cur, wr, wc, fr, fq); S.done(cur); }
        if (!has_next) break;
#pragma unroll
        for (int a = 0; a < 2; ++a)
#pragma unroll
            for (int b = 0; b < 2; ++b)
#pragma unroll
                for (int m = 0; m < 4; ++m)
#pragma unroll
                    for (int n = 0; n < 2; ++n) acc[a][b][m][n] = (f32x4){0.f, 0.f, 0.f, 0.f};
        cur = nxt; cA = nA; cB = nB; ++ui;
    }
    PG8_WAIT_V(0);
    if (wr == 0) PG8_BAR;
    PG8_BAR;
    if constexpr (Epi::AFTER_DRAIN) { E.fused(acc, cur, wr, wc, fr, fq, lds, wid, lane); S.done(cur); }
#undef PG8_SA
#undef PG8_SB
#undef PG8_STAGE
#undef PG8_LDA
#undef PG8_LDB
#undef PG8_MMA
#undef PG8_WAIT_V
#undef PG8_WAIT_L
#undef PG8_BAR
#undef PG8_SCHED
}
}

#include <cstdio>
#include <ctime>
#include <cstdlib>
#include <cstring>
#include <cmath>
#include <vector>
#include <algorithm>

using pg8::bf16_t; using pg8::f32x4; using pg8::Unit;
typedef unsigned u32x2v __attribute__((ext_vector_type(2)));
typedef unsigned u32x4v __attribute__((ext_vector_type(4)));

constexpr int D = 2048, SEQ = 4096, NMETA = 16, L = 4112, M = 8224, MP = 8448, DFF = 5632, INC = 6176, INCP = 6400;
constexpr float EPS = 1e-6f;
constexpr int LDS_BYTES = 4 * (16640 + 2 * 65 * 144) + 256;
constexpr int C_Q = 3072, C_K = 3584, C_V = 4096, C_OG = 5120, C_LR = 6144;

struct Params {
    const float *x, *meta, *ffn1_norm, *ffn1_wg, *ffn1_wu, *ffn1_wd, *mix_norm, *w_in, *conv_w, *conv_b,
        *filt_w1, *filt_b1, *filt_w2, *filt_b2, *filt_w3, *filt_freq, *hyena_d, *hyena_norm, *gk_w2, *gk_b2, *gla_norm, *w_out,
        *ffn2_norm, *ffn2_wg, *ffn2_wu, *ffn2_wd, *final_norm;
    float* out;
    bf16_t *Wgu1, *Wd1, *Win, *Wout, *Wgu2, *Wd2;
    float* h; bf16_t* hb; bf16_t* big; float* rowss; float* z2;
    bf16_t* y; bf16_t* yc; float* of; float* ob; unsigned char* gp; unsigned* ctr;
};

__device__ __forceinline__ float bf2f(bf16_t b) { return __uint_as_float(((unsigned)b) << 16); }
__device__ __forceinline__ unsigned pk2(float lo, float hi) { return pg8::cvt_pk_bf16(lo, hi); }
__device__ __forceinline__ float wave_sum(float v) {
#pragma unroll
    for (int o = 32; o; o >>= 1) v += __shfl_xor(v, o);
    return v;
}
__device__ __forceinline__ float silu_f(float x) { return x * __builtin_amdgcn_rcpf(1.0f + __expf(-x)); }

__device__ __forceinline__ float row_rscale(const float* rowss, int r, int fq) {
    const f32x4* q = (const f32x4*)(rowss + (size_t)r * 32 + fq * 8);
    const f32x4 a = q[0], b = q[1];
    float s = ((a[0] + a[1]) + (a[2] + a[3])) + ((b[0] + b[1]) + (b[2] + b[3]));
    s += __shfl_xor(s, 16); s += __shfl_xor(s, 32);
    return rsqrtf(s * (1.0f / D) + EPS);
}

struct EpiSwiglu {
    static constexpr bool PERM = true, AFTER_DRAIN = false;
    bf16_t* O; const float* rowss;
    __device__ __forceinline__ void operator()(const f32x4 (&acc)[2][2][4][2], const Unit& u, int wr, int wc, int fr, int fq) const {
        const int row0 = u.pm * 256 + wr * 64 + fr, col0 = u.pn * 128 + wc * 32 + 8 * fq;
#pragma unroll
        for (int ai = 0; ai < 2; ++ai)
#pragma unroll
            for (int m = 0; m < 4; ++m) {
                const int r = row0 + ai * 128 + m * 16; const float rs = row_rscale(rowss, r, fq);
                u32x4v w;
#pragma unroll
                for (int n = 0; n < 2; ++n) { const f32x4 g = acc[ai][0][m][n] * rs, uu = acc[ai][1][m][n] * rs;
                    w[2 * n] = pk2(silu_f(g[0]) * uu[0], silu_f(g[1]) * uu[1]); w[2 * n + 1] = pk2(silu_f(g[2]) * uu[2], silu_f(g[3]) * uu[3]); }
                *(u32x4v*)(O + (size_t)r * DFF + col0) = w;
            }
    }
};
struct EpiScale {
    static constexpr bool PERM = true, AFTER_DRAIN = false;
    bf16_t* O; int ldc; const float* rowss;
    __device__ __forceinline__ void operator()(const f32x4 (&acc)[2][2][4][2], const Unit& u, int wr, int wc, int fr, int fq) const {
        const int row0 = u.pm * 256 + wr * 64 + fr, col0 = u.pn * 256 + wc * 32 + 8 * fq;
#pragma unroll
        for (int ai = 0; ai < 2; ++ai)
#pragma unroll
            for (int m = 0; m < 4; ++m) {
                const int r = row0 + ai * 128 + m * 16; const float rs = row_rscale(rowss, r, fq);
#pragma unroll
                for (int bj = 0; bj < 2; ++bj) { const f32x4 a = acc[ai][bj][m][0] * rs, b = acc[ai][bj][m][1] * rs;
                    u32x4v w; w[0] = pk2(a[0], a[1]); w[1] = pk2(a[2], a[3]); w[2] = pk2(b[0], b[1]); w[3] = pk2(b[2], b[3]);
                    *(u32x4v*)(O + (size_t)r * ldc + col0 + bj * 128) = w; }
            }
    }
};
template <bool WHB> struct EpiResid {
    static constexpr bool PERM = true, AFTER_DRAIN = false;
    float* H; bf16_t* HB; float* rowss; float scale;
    __device__ __forceinline__ void operator()(const f32x4 (&acc)[2][2][4][2], const Unit& u, int wr, int wc, int fr, int fq) const {
        const int row0 = u.pm * 256 + wr * 64 + fr, col0 = u.pn * 256 + wc * 32 + 8 * fq;
#pragma unroll
        for (int ai = 0; ai < 2; ++ai)
#pragma unroll
            for (int m = 0; m < 4; ++m) {
                const int r = row0 + ai * 128 + m * 16; float ss = 0.f;
#pragma unroll
                for (int bj = 0; bj < 2; ++bj) { float* hp = H + (size_t)r * D + col0 + bj * 128;
                    f32x4 a = *(const f32x4*)hp, b = *(const f32x4*)(hp + 4);
                    a += acc[ai][bj][m][0] * scale; b += acc[ai][bj][m][1] * scale;
                    *(f32x4*)hp = a; *(f32x4*)(hp + 4) = b;
                    ss += (a[0] * a[0] + a[1] * a[1]) + (a[2] * a[2] + a[3] * a[3]) + (b[0] * b[0] + b[1] * b[1]) + (b[2] * b[2] + b[3] * b[3]);
                    if (WHB) { u32x4v w; w[0] = pk2(a[0], a[1]); w[1] = pk2(a[2], a[3]); w[2] = pk2(b[0], b[1]); w[3] = pk2(b[2], b[3]);
                        *(u32x4v*)(HB + (size_t)r * D + col0 + bj * 128) = w; } }
                ss += __shfl_xor(ss, 16); ss += __shfl_xor(ss, 32);
                if (WHB && fq == 0) rowss[(size_t)r * 32 + u.pn * 4 + wc] = ss;
            }
    }
};

constexpr int NT_FFN = 2816, NT_WIN = 3200, NT_WOUT = 1024, NT_TR = 6 * NT_FFN + NT_WIN + NT_WOUT, NT_ROWS = MP / 8, NT_Z2 = (L + 7) / 8, P0_ITEMS = NT_TR + NT_ROWS + NT_Z2;

__device__ __forceinline__ void transpose_mat(const float* src, bf16_t* dst, const float* gain, const int K, const int N, const int ld, const int nvalid, const int mode, float* tl) {
    const int ntn = N / 64, ntiles = (K / 64) * ntn, tid = threadIdx.x;
    for (int it = blockIdx.x; it < ntiles; it += gridDim.x) {
        const int kt = it / ntn, nt = it - kt * ntn, k0 = kt * 64, n0 = nt * 64;
        const long drow0 = mode == 0 ? n0 : (n0 / 128) * 256 + (n0 % 128) + (mode == 2 ? 128 : 0);
        { const int r = tid >> 4, c4 = (tid & 15) * 4;
#pragma unroll
          for (int i = 0; i < 2; ++i) { const int row = r + 32 * i, k = k0 + row, n = n0 + c4;
              f32x4 v = {0.f, 0.f, 0.f, 0.f};
              if (n < nvalid) v = *(const f32x4*)(src + (size_t)k * ld + n);
              const float g = gain ? gain[k] : 1.0f;
              float* t = tl + row * 65 + c4; t[0] = v[0] * g; t[1] = v[1] * g; t[2] = v[2] * g; t[3] = v[3] * g; } }
        __syncthreads();
        { const int n = tid >> 3, k8 = (tid & 7) * 8; float v[8];
#pragma unroll
          for (int j = 0; j < 8; ++j) v[j] = tl[(k8 + j) * 65 + n];
          u32x4v w; w[0] = pk2(v[0], v[1]); w[1] = pk2(v[2], v[3]); w[2] = pk2(v[4], v[5]); w[3] = pk2(v[6], v[7]);
          *(u32x4v*)(dst + (size_t)(drow0 + n) * K + k0 + k8) = w; }
        __syncthreads();
    }
}

__device__ void row_item(const Params& p, int item) {
    const int wid = threadIdx.x >> 6, lane = threadIdx.x & 63, m = item * 8 + wid;
    float* hrow = p.h + (size_t)m * D; bf16_t* hbrow = p.hb + (size_t)m * D;
    if (m < M) { const int b = m / L, t = m - b * L;
        const float* src = t < NMETA ? p.meta + (size_t)t * D : p.x + ((size_t)b * SEQ + t - NMETA) * D;
        float ss = 0.f;
#pragma unroll
        for (int i = 0; i < 8; ++i) { const int c = (lane + 64 * i) * 4; const f32x4 v = *(const f32x4*)(src + c);
            ss += (v[0] * v[0] + v[1] * v[1]) + (v[2] * v[2] + v[3] * v[3]);
            *(f32x4*)(hrow + c) = v; u32x2v w; w[0] = pk2(v[0], v[1]); w[1] = pk2(v[2], v[3]); *(u32x2v*)(hbrow + c) = w; }
        ss = wave_sum(ss);
        if (lane < 32) p.rowss[(size_t)m * 32 + lane] = lane == 0 ? ss : 0.f;
    } else {
#pragma unroll
        for (int i = 0; i < 8; ++i) { const int c = (lane + 64 * i) * 4; *(f32x4*)(hrow + c) = (f32x4){0.f, 0.f, 0.f, 0.f}; u32x2v w; w[0] = 0u; w[1] = 0u; *(u32x2v*)(hbrow + c) = w; }
        if (lane < 32) p.rowss[(size_t)m * 32 + lane] = 0.f;
    }
}

__device__ void z2_item(const Params& p, int item) {
    const int wid = threadIdx.x >> 6, lane = threadIdx.x & 63, j = item * 8 + wid;
    if (j >= L) return;
    float feat = 0.f;
    const float w = (float)(2.0 * 3.14159265358979323846 / L) * (float)j;
    if (lane == 0) feat = (float)j * (1.0f / (float)(L - 1));
    else if (lane <= 32) { const int bi = (lane - 1) & 15; const float band = 1e-4f + (float)bi * ((15.0f - 1e-4f) / 15.0f); const float ang = w * band;
        feat = lane <= 16 ? cosf(ang) : -sinf(ang); }
    float a = p.filt_b1[lane];
    for (int i = 0; i < 33; ++i) a += __shfl(feat, i) * p.filt_w1[i * 64 + lane];
    const float fr = p.filt_freq[lane];
    const float z1 = sinf(fr * a);
    float c = p.filt_b2[lane];
    for (int k = 0; k < 64; ++k) c += __shfl(z1, k) * p.filt_w2[k * 64 + lane];
    p.z2[(size_t)j * 64 + lane] = sinf(fr * c);
}

constexpr int HY_G_BYTES = 16640, HY_USTR = 144, HY_U_BYTES = 65 * HY_USTR, HY_CH_BYTES = HY_G_BYTES + 2 * HY_U_BYTES, HY_ZERO_OFF = 4 * HY_CH_BYTES;
static_assert(HY_ZERO_OFF + 256 <= LDS_BYTES, "lds");
__device__ __forceinline__ pg8::bf16x8 hy_gfrag(const unsigned char* gp) {
    pg8::bf16x8 f;
#pragma unroll
    for (int j = 0; j < 8; ++j) f[j] = (short)*(const unsigned short*)(gp + 2 * (7 - j));
    return f;
}
__device__ void hyena_group(const Params& p, int grp, unsigned char* sm) {
    const int tid = threadIdx.x, wid = tid >> 6, lane = tid & 63, c0 = grp * 4;
    float* W3 = (float*)(sm + 3 * HY_CH_BYTES + HY_G_BYTES);
    W3[tid] = p.filt_w3[(size_t)(tid & 63) * 2048 + ((tid >> 6) & 1) * 1024 + c0 + (tid >> 7)];
    if (tid < 36) ((unsigned*)(sm + HY_ZERO_OFF))[tid] = 0u;
    for (int i = tid; i < 4 * 97; i += 512) { const int ch = i / 97, q = i % 97; const int idx = q < 49 ? q : 8272 + (q - 49);
        *(unsigned short*)(sm + ch * HY_CH_BYTES + 2 * idx) = 0; }
    __syncthreads();
    {
        const float la = -3.0701134573253945f, lb = -15.350567286626973f;
        float delta[4];
#pragma unroll
        for (int ch = 0; ch < 4; ++ch) delta[ch] = fabsf(la + (float)(c0 + ch) * ((lb - la) / 1023.0f));
        for (int j = tid; j < L; j += 512) {
            const f32x4* z = (const f32x4*)(p.z2 + (size_t)j * 64);
            float hf[4] = {0.f, 0.f, 0.f, 0.f}, hbk[4] = {0.f, 0.f, 0.f, 0.f};
#pragma unroll 4
            for (int k4 = 0; k4 < 16; ++k4) { const f32x4 zz = z[k4];
#pragma unroll
                for (int ch = 0; ch < 4; ++ch) { const f32x4 wf = *(const f32x4*)(W3 + ch * 128 + k4 * 4), wb = *(const f32x4*)(W3 + ch * 128 + 64 + k4 * 4);
                    hf[ch] += zz[0] * wf[0] + zz[1] * wf[1] + zz[2] * wf[2] + zz[3] * wf[3]; hbk[ch] += zz[0] * wb[0] + zz[1] * wb[1] + zz[2] * wb[2] + zz[3] * wb[3]; } }
            const float t = (float)j * (1.0f / (float)(L - 1));
#pragma unroll
            for (int ch = 0; ch < 4; ++ch) { const float win = expf(-t * delta[ch]); const float f = hf[ch] * win, bk = hbk[ch] * win;
                unsigned short* gb = (unsigned short*)(sm + ch * HY_CH_BYTES);
                if (j == 0) gb[4160] = (unsigned short)(pk2(f + bk, 0.f) & 0xffffu);
                else { gb[4160 + j] = (unsigned short)(pk2(f, 0.f) & 0xffffu); gb[4160 - j] = (unsigned short)(pk2(bk, 0.f) & 0xffffu); } }
        }
    }
    __syncthreads();
    {
        float cw1[3][4], cw2[3][4], cb1[4], cb2[4];
#pragma unroll
        for (int ch = 0; ch < 4; ++ch) { cb1[ch] = p.conv_b[1024 + c0 + ch]; cb2[ch] = p.conv_b[2048 + c0 + ch];
#pragma unroll
            for (int jj = 0; jj < 3; ++jj) { cw1[jj][ch] = p.conv_w[jj * 3072 + 1024 + c0 + ch]; cw2[jj][ch] = p.conv_w[jj * 3072 + 2048 + c0 + ch]; } }
        for (int tt = tid; tt < 2 * 4160; tt += 512) { const int b = tt >= 4160 ? 1 : 0, t = tt - b * 4160;
            float a1[4], a2[4];
#pragma unroll
            for (int ch = 0; ch < 4; ++ch) { a1[ch] = cb1[ch]; a2[ch] = cb2[ch]; }
            if (t < L) {
#pragma unroll
                for (int jj = 0; jj < 3; ++jj) { const int t2 = t + jj - 1;
                    if (t2 >= 0 && t2 < L) { const bf16_t* row = p.big + (size_t)(b * L + t2) * INCP + c0;
                        const u32x2v x1 = *(const u32x2v*)(row + 1024), vh = *(const u32x2v*)(row + 2048);
                        a1[0] += __uint_as_float(x1[0] << 16) * cw1[jj][0]; a1[1] += __uint_as_float(x1[0] & 0xffff0000u) * cw1[jj][1];
                        a1[2] += __uint_as_float(x1[1] << 16) * cw1[jj][2]; a1[3] += __uint_as_float(x1[1] & 0xffff0000u) * cw1[jj][3];
                        a2[0] += __uint_as_float(vh[0] << 16) * cw2[jj][0]; a2[1] += __uint_as_float(vh[0] & 0xffff0000u) * cw2[jj][1];
                        a2[2] += __uint_as_float(vh[1] << 16) * cw2[jj][2]; a2[3] += __uint_as_float(vh[1] & 0xffff0000u) * cw2[jj][3]; } }
            } else {
#pragma unroll
                for (int ch = 0; ch < 4; ++ch) { a1[ch] = 0.f; a2[ch] = 0.f; }
            }
#pragma unroll
            for (int ch = 0; ch < 4; ++ch)
                *(unsigned short*)(sm + ch * HY_CH_BYTES + HY_G_BYTES + b * HY_U_BYTES + (t >> 6) * HY_USTR + (t & 63) * 2) = (unsigned short)(pk2(a1[ch] * a2[ch], 0.f) & 0xffffu);
        }
    }
    __syncthreads();
    const int ch = wid >> 1, b = wid & 1, li = lane & 15, kq = lane >> 4;
    const unsigned char* Gb = sm + ch * HY_CH_BYTES;
    unsigned char* Ub = sm + ch * HY_CH_BYTES + HY_G_BYTES + b * HY_U_BYTES;
    const unsigned char* Zb = sm + HY_ZERO_OFF + kq * 16;
    f32x4 acc[4][5];
#pragma unroll
    for (int rb = 0; rb < 4; ++rb)
#pragma unroll
        for (int nb = 0; nb < 5; ++nb) acc[rb][nb] = (f32x4){0.f, 0.f, 0.f, 0.f};
    const unsigned char* gl = Gb + 2 * (4160 + li - 8 * kq - 7);
    pg8::bf16x8 F[6];
    { const int d0 = -64;
#pragma unroll
      for (int q = 0; q < 2; ++q) F[4 + q] = hy_gfrag(gl + 32 * (4 * d0 - 2 + q)); }
    for (int d = -64; d <= 64; ++d) {
        F[0] = F[4]; F[1] = F[5];
#pragma unroll
        for (int q = 2; q < 6; ++q) F[q] = hy_gfrag(gl + 32 * (4 * d - 2 + q));
        const int nb_lo = d > 0 ? (d >> 4) : 0, nb_hi = (d + 64) >> 4;
#pragma unroll
        for (int nb = 0; nb < 5; ++nb) {
            if (nb >= nb_lo && nb <= nb_hi) {
                const int sblk = 16 * nb + li - d;
                const unsigned char* up = ((unsigned)sblk < 65u) ? (Ub + sblk * HY_USTR + kq * 16) : Zb;
                const pg8::bf16x8 B0 = *(const pg8::bf16x8*)up, B1 = *(const pg8::bf16x8*)(up + 64);
#pragma unroll
                for (int rb = 0; rb < 4; ++rb) {
                    acc[rb][nb] = __builtin_amdgcn_mfma_f32_16x16x32_bf16(F[rb + 2], B0, acc[rb][nb], 0, 0, 0);
                    acc[rb][nb] = __builtin_amdgcn_mfma_f32_16x16x32_bf16(F[rb], B1, acc[rb][nb], 0, 0, 0);
                }
            }
        }
    }
    {
        const float dc = p.hyena_d[c0 + ch];
#pragma unroll
        for (int nb = 0; nb < 5; ++nb) { const int t1 = 16 * nb + li;
            if (t1 < 65) {
#pragma unroll
                for (int rb = 0; rb < 4; ++rb) { unsigned char* up = Ub + t1 * HY_USTR + (16 * rb + 4 * kq) * 2;
                    const u32x2v uu = *(const u32x2v*)up; const f32x4 a = acc[rb][nb];
                    u32x2v w; w[0] = pk2(a[0] + dc * __uint_as_float(uu[0] << 16), a[1] + dc * __uint_as_float(uu[0] & 0xffff0000u));
                    w[1] = pk2(a[2] + dc * __uint_as_float(uu[1] << 16), a[3] + dc * __uint_as_float(uu[1] & 0xffff0000u));
                    *(u32x2v*)up = w; } } }
    }
    __syncthreads();
    for (int tt = tid; tt < 2 * L; tt += 512) { const int bb = tt >= L ? 1 : 0, t = tt - bb * L;
        const unsigned char* up = sm + HY_G_BYTES + bb * HY_U_BYTES + (t >> 6) * HY_USTR + (t & 63) * 2;
        const unsigned v0 = *(const unsigned short*)up, v1 = *(const unsigned short*)(up + HY_CH_BYTES), v2 = *(const unsigned short*)(up + 2 * HY_CH_BYTES), v3 = *(const unsigned short*)(up + 3 * HY_CH_BYTES);
        u32x2v w; w[0] = v0 | (v1 << 16); w[1] = v2 | (v3 << 16);
        *(u32x2v*)(p.yc + (size_t)(bb * L + t) * 1024 + c0) = w; }
    __syncthreads();
}

constexpr int GP_QT = 0, GP_KT = 16384, GP_AM = 32768, GP_DEC = 40960, GP_STRIDE = 41472;
__device__ __forceinline__ bf16_t f2bf(float v) { return (bf16_t)(pk2(v, 0.f) & 0xffffu); }
__device__ void gla_pre(const Params& p, int item, unsigned char* sm) {
    const int n = item % 65, bdh = item / 65, hh = bdh & 3, dir = (bdh >> 2) & 1, b = bdh >> 3;
    const int tid = threadIdx.x, d = tid & 127, seg = tid >> 7, lane = tid & 63, wid = tid >> 6, li = lane & 15, kq = lane >> 4;
    float* LR = (float*)sm; float* SEGT = LR + 1024; bf16_t* QS = (bf16_t*)(sm + 8192); bf16_t* KS = QS + 64 * 136;
    unsigned char* gp = p.gp + (size_t)item * GP_STRIDE;
    { const int i = tid >> 3, r2 = (tid & 7) * 2; const int tau = dir ? 4159 - (64 * n + i) : 64 * n + i; float v0 = 0.f, v1 = 0.f;
      if (tau >= 48) { const unsigned w = *(const unsigned*)(p.big + (size_t)(b * L + tau - 48) * INCP + C_LR + dir * 16 + r2); v0 = __uint_as_float(w << 16); v1 = __uint_as_float(w & 0xffff0000u); }
      LR[i * 16 + r2] = v0; LR[i * 16 + r2 + 1] = v1; }
    float w2[16];
#pragma unroll
    for (int r = 0; r < 16; ++r) w2[r] = p.gk_w2[(size_t)(dir * 16 + r) * 512 + hh * 128 + d];
    const float b2 = p.gk_b2[dir * 512 + hh * 128 + d];
    __syncthreads();
    float cs[16]; float run = 0.f;
#pragma unroll
    for (int ii = 0; ii < 16; ++ii) { const int i = seg * 16 + ii; const int tau = dir ? 4159 - (64 * n + i) : 64 * n + i;
        float xg = b2;
#pragma unroll
        for (int r4 = 0; r4 < 4; ++r4) { const f32x4 l4 = *(const f32x4*)(LR + i * 16 + 4 * r4); xg += l4[0] * w2[4 * r4] + l4[1] * w2[4 * r4 + 1] + l4[2] * w2[4 * r4 + 2] + l4[3] * w2[4 * r4 + 3]; }
        const float lg = tau >= 48 ? (fminf(xg, 0.f) - log1pf(expf(-fabsf(xg)))) * (1.0f / 16.0f) : 0.f;
        run += lg; cs[ii] = run; }
    SEGT[seg * 128 + d] = run;
    __syncthreads();
    float off = 0.f, tot = 0.f;
#pragma unroll
    for (int s = 0; s < 4; ++s) { const float v = SEGT[s * 128 + d]; if (s < seg) off += v; tot += v; }
    unsigned kt[8];
#pragma unroll
    for (int ii = 0; ii < 16; ii += 2) { float kh[2];
#pragma unroll
        for (int x = 0; x < 2; ++x) { const int i = seg * 16 + ii + x; const int tau = dir ? 4159 - (64 * n + i) : 64 * n + i; float q = 0.f, k = 0.f;
            if (tau >= 48) { const bf16_t* row = p.big + (size_t)(b * L + tau - 48) * INCP + hh * 128 + d; q = bf2f(row[C_Q]); k = bf2f(row[C_K]); }
            const float bi = off + cs[ii + x]; const bf16_t qv = f2bf(q * 0.08838834764831845f * expf(bi));
            QS[i * 136 + d] = qv; KS[i * 136 + d] = f2bf(k * expf(-bi)); *(bf16_t*)(gp + GP_QT + (i * 128 + d) * 2) = qv; kh[x] = k * expf(tot - bi); }
        kt[ii >> 1] = pk2(kh[0], kh[1]); }
    { u32x4v w0, w1; w0[0] = kt[0]; w0[1] = kt[1]; w0[2] = kt[2]; w0[3] = kt[3]; w1[0] = kt[4]; w1[1] = kt[5]; w1[2] = kt[6]; w1[3] = kt[7];
      *(u32x4v*)(gp + GP_KT + (d * 64 + seg * 16) * 2) = w0; *(u32x4v*)(gp + GP_KT + (d * 64 + seg * 16 + 8) * 2) = w1; }
    if (seg == 0) *(float*)(gp + GP_DEC + d * 4) = expf(tot);
    __syncthreads();
    { const int it = wid >> 1;
#pragma unroll
      for (int x = 0; x < 2; ++x) { const int jt = (wid & 1) * 2 + x; f32x4 acc = {0.f, 0.f, 0.f, 0.f};
#pragma unroll
          for (int ks = 0; ks < 4; ++ks) { const pg8::bf16x8 a = *(const pg8::bf16x8*)(QS + (16 * it + li) * 136 + 32 * ks + 8 * kq), bb = *(const pg8::bf16x8*)(KS + (16 * jt + li) * 136 + 32 * ks + 8 * kq);
              acc = __builtin_amdgcn_mfma_f32_16x16x32_bf16(a, bb, acc, 0, 0, 0); }
#pragma unroll
          for (int r = 0; r < 4; ++r) { const int i = 16 * it + 4 * kq + r, j = 16 * jt + li; *(bf16_t*)(gp + GP_AM + (i * 64 + j) * 2) = f2bf(j <= i ? acc[r] : 0.f); } } }
    __syncthreads();
}

__device__ void gla_scan(const Params& p, int item, unsigned char* sm) {
    const int s = item & 3, bdh = item >> 2, hh = bdh & 3, dir = (bdh >> 2) & 1, b = bdh >> 3;
    const int tid = threadIdx.x, lane = tid & 63, wid = tid >> 6, li = lane & 15, kq = lane >> 4;
    constexpr int O_QS = 0, O_KT = 17408, O_AS = O_KT + 18432, O_VT = O_AS + 9216, O_DEC = O_VT + 9216, BUF = O_DEC + 512, O_ST = 2 * BUF;
    static_assert(O_ST + 17408 <= HY_ZERO_OFF, "lds");
    float* outp = dir ? p.ob : p.of;
    const unsigned char* gbase = p.gp + (size_t)(bdh * 65) * GP_STRIDE;
    u32x4v rq[2], rk[2], ra, rv, rd;
    auto LOAD = [&](int n) {
        const unsigned char* g = gbase + (size_t)n * GP_STRIDE;
        rq[0] = *(const u32x4v*)(g + GP_QT + tid * 16); rq[1] = *(const u32x4v*)(g + GP_QT + (tid + 512) * 16);
        rk[0] = *(const u32x4v*)(g + GP_KT + tid * 16); rk[1] = *(const u32x4v*)(g + GP_KT + (tid + 512) * 16);
        ra = *(const u32x4v*)(g + GP_AM + tid * 16);
        if (tid < 32) rd = *(const u32x4v*)(g + GP_DEC + tid * 16);
        const int tau = dir ? 4159 - (64 * n + lane) : 64 * n + lane;
        rv = (u32x4v){0u, 0u, 0u, 0u};
        if (tau >= 48) rv = *(const u32x4v*)(p.big + (size_t)(b * L + tau - 48) * INCP + C_V + hh * 256 + s * 64 + wid * 8);
    };
    auto STORE = [&](int buf) {
        unsigned char* base = sm + buf * BUF;
#pragma unroll
        for (int k = 0; k < 2; ++k) { const int c = tid + 512 * k;
            *(u32x4v*)(base + O_QS + ((c >> 4) * 136 + (c & 15) * 8) * 2) = rq[k];
            *(u32x4v*)(base + O_KT + ((c >> 3) * 72 + (c & 7) * 8) * 2) = rk[k]; }
        *(u32x4v*)(base + O_AS + ((tid >> 3) * 72 + (tid & 7) * 8) * 2) = ra;
        if (tid < 32) *(u32x4v*)(base + O_DEC + tid * 16) = rd;
        bf16_t* vt = (bf16_t*)(base + O_VT);
#pragma unroll
        for (int x = 0; x < 4; ++x) { vt[(wid * 8 + 2 * x) * 72 + lane] = (bf16_t)(rv[x] & 0xffffu); vt[(wid * 8 + 2 * x + 1) * 72 + lane] = (bf16_t)(rv[x] >> 16); }
    };
    f32x4 S[4];
#pragma unroll
    for (int e = 0; e < 4; ++e) S[e] = (f32x4){0.f, 0.f, 0.f, 0.f};
    for (int i = tid; i < 17408 / 16; i += 512) *(u32x4v*)(sm + O_ST + i * 16) = (u32x4v){0u, 0u, 0u, 0u};
    LOAD(0); STORE(0);
    __syncthreads();
    const bf16_t* ST = (const bf16_t*)(sm + O_ST);
    for (int n = 0; n < 65; ++n) {
        const unsigned char* base = sm + (n & 1) * BUF;
        if (n + 1 < 65) LOAD(n + 1);
        const bf16_t* QS = (const bf16_t*)(base + O_QS); const bf16_t* KTS = (const bf16_t*)(base + O_KT); const bf16_t* AS = (const bf16_t*)(base + O_AS); const bf16_t* VT = (const bf16_t*)(base + O_VT);
        const int it = wid >> 1;
#pragma unroll
        for (int x = 0; x < 2; ++x) { const int et = (wid & 1) * 2 + x; f32x4 o = {0.f, 0.f, 0.f, 0.f};
#pragma unroll
            for (int ks = 0; ks < 2; ++ks) { const pg8::bf16x8 a = *(const pg8::bf16x8*)(AS + (16 * it + li) * 72 + 32 * ks + 8 * kq), bb = *(const pg8::bf16x8*)(VT + (16 * et + li) * 72 + 32 * ks + 8 * kq);
                o = __builtin_amdgcn_mfma_f32_16x16x32_bf16(a, bb, o, 0, 0, 0); }
#pragma unroll
            for (int ks = 0; ks < 4; ++ks) { const pg8::bf16x8 a = *(const pg8::bf16x8*)(QS + (16 * it + li) * 136 + 32 * ks + 8 * kq), bb = *(const pg8::bf16x8*)(ST + (16 * et + li) * 136 + 32 * ks + 8 * kq);
                o = __builtin_amdgcn_mfma_f32_16x16x32_bf16(a, bb, o, 0, 0, 0); }
#pragma unroll
            for (int r = 0; r < 4; ++r) { const int i = 16 * it + 4 * kq + r; const int tau = dir ? 4159 - (64 * n + i) : 64 * n + i;
                if (tau >= 48) outp[(size_t)(b * L + tau - 48) * 1024 + hh * 256 + s * 64 + 16 * et + li] = o[r]; } }
        { const f32x4 dec4 = *(const f32x4*)(base + O_DEC + (16 * wid + 4 * kq) * 4);
#pragma unroll
          for (int et = 0; et < 4; ++et) { S[et] *= dec4;
#pragma unroll
              for (int ks = 0; ks < 2; ++ks) { const pg8::bf16x8 a = *(const pg8::bf16x8*)(KTS + (16 * wid + li) * 72 + 32 * ks + 8 * kq), bb = *(const pg8::bf16x8*)(VT + (16 * et + li) * 72 + 32 * ks + 8 * kq);
                  S[et] = __builtin_amdgcn_mfma_f32_16x16x32_bf16(a, bb, S[et], 0, 0, 0); } } }
        __syncthreads();
#pragma unroll
        for (int et = 0; et < 4; ++et) { u32x2v w; w[0] = pk2(S[et][0], S[et][1]); w[1] = pk2(S[et][2], S[et][3]);
            *(u32x2v*)(sm + O_ST + ((16 * et + li) * 136 + 16 * wid + 4 * kq) * 2) = w; }
        if (n + 1 < 65) STORE((n + 1) & 1);
        __syncthreads();
    }
}

__device__ void fin_item(const Params& p, int item) {
    const int wid = threadIdx.x >> 6, lane = threadIdx.x & 63, m = item * 8 + wid;
    bf16_t* yrow = p.y + (size_t)m * D;
    if (m >= M) { const u32x4v z = {0u, 0u, 0u, 0u};
#pragma unroll
        for (int i = 0; i < 4; ++i) *(u32x4v*)(yrow + (lane + 64 * i) * 8) = z;
        return; }
    const int c0 = lane * 16;
    {
      const int b = m >= L ? 1 : 0, t = m - b * L;
      float x0[16];
#pragma unroll
      for (int i = 0; i < 4; ++i) { const f32x4 cb = *(const f32x4*)(p.conv_b + c0 + 4 * i); x0[4 * i] = cb[0]; x0[4 * i + 1] = cb[1]; x0[4 * i + 2] = cb[2]; x0[4 * i + 3] = cb[3]; }
#pragma unroll
      for (int jj = 0; jj < 3; ++jj) { const int t2 = t + jj - 1;
          if (t2 >= 0 && t2 < L) { const bf16_t* row = p.big + (size_t)(b * L + t2) * INCP + c0; const u32x4v r0 = *(const u32x4v*)row, r1 = *(const u32x4v*)(row + 8);
#pragma unroll
              for (int i = 0; i < 4; ++i) { const f32x4 cw = *(const f32x4*)(p.conv_w + jj * 3072 + c0 + 4 * i); const unsigned lo = i < 2 ? r0[2 * i] : r1[2 * i - 4], hi = i < 2 ? r0[2 * i + 1] : r1[2 * i - 3];
                  x0[4 * i] += __uint_as_float(lo << 16) * cw[0]; x0[4 * i + 1] += __uint_as_float(lo & 0xffff0000u) * cw[1]; x0[4 * i + 2] += __uint_as_float(hi << 16) * cw[2]; x0[4 * i + 3] += __uint_as_float(hi & 0xffff0000u) * cw[3]; } } }
      const bf16_t* src = p.yc + (size_t)m * 1024 + c0; const u32x4v y0 = *(const u32x4v*)src, y1 = *(const u32x4v*)(src + 8);
      f32x4 v[4]; float ss = 0.f;
#pragma unroll
      for (int i = 0; i < 4; ++i) { const unsigned lo = i < 2 ? y0[2 * i] : y1[2 * i - 4], hi = i < 2 ? y0[2 * i + 1] : y1[2 * i - 3];
          v[i][0] = __uint_as_float(lo << 16) * x0[4 * i]; v[i][1] = __uint_as_float(lo & 0xffff0000u) * x0[4 * i + 1]; v[i][2] = __uint_as_float(hi << 16) * x0[4 * i + 2]; v[i][3] = __uint_as_float(hi & 0xffff0000u) * x0[4 * i + 3];
          ss += (v[i][0] * v[i][0] + v[i][1] * v[i][1]) + (v[i][2] * v[i][2] + v[i][3] * v[i][3]); }
      ss += __shfl_xor(ss, 1); ss += __shfl_xor(ss, 2); ss += __shfl_xor(ss, 4);
      const float r = rsqrtf(ss * (1.0f / 128.0f) + EPS);
      u32x4v w0, w1;
#pragma unroll
      for (int i = 0; i < 4; ++i) { const f32x4 g = *(const f32x4*)(p.hyena_norm + c0 + 4 * i); const f32x4 o = v[i] * r * g;
          if (i < 2) { w0[2 * i] = pk2(o[0], o[1]); w0[2 * i + 1] = pk2(o[2], o[3]); } else { w1[2 * i - 4] = pk2(o[0], o[1]); w1[2 * i - 3] = pk2(o[2], o[3]); } }
      *(u32x4v*)(yrow + c0) = w0; *(u32x4v*)(yrow + c0 + 8) = w1; }
    { const float* s1 = p.of + (size_t)m * 1024 + c0; const float* s2 = p.ob + (size_t)m * 1024 + c0; f32x4 v[4]; float ss = 0.f;
#pragma unroll
      for (int i = 0; i < 4; ++i) { v[i] = *(const f32x4*)(s1 + 4 * i) + *(const f32x4*)(s2 + 4 * i); ss += (v[i][0] * v[i][0] + v[i][1] * v[i][1]) + (v[i][2] * v[i][2] + v[i][3] * v[i][3]); }
      ss += __shfl_xor(ss, 1); ss += __shfl_xor(ss, 2); ss += __shfl_xor(ss, 4); ss += __shfl_xor(ss, 8);
      const float r = rsqrtf(ss * (1.0f / 256.0f) + EPS);
      const bf16_t* og = p.big + (size_t)m * INCP + C_OG + c0;
      const u32x4v g0 = *(const u32x4v*)og, g1 = *(const u32x4v*)(og + 8);
      float ogf[16];
#pragma unroll
      for (int i = 0; i < 4; ++i) { ogf[2 * i] = __uint_as_float(g0[i] << 16); ogf[2 * i + 1] = __uint_as_float(g0[i] & 0xffff0000u); ogf[8 + 2 * i] = __uint_as_float(g1[i] << 16); ogf[8 + 2 * i + 1] = __uint_as_float(g1[i] & 0xffff0000u); }
      u32x4v w0, w1;
#pragma unroll
      for (int i = 0; i < 4; ++i) { const f32x4 g = *(const f32x4*)(p.gla_norm + ((c0 + 4 * i) & 255)); f32x4 o = v[i] * r * g;
          o[0] *= silu_f(ogf[4 * i]); o[1] *= silu_f(ogf[4 * i + 1]); o[2] *= silu_f(ogf[4 * i + 2]); o[3] *= silu_f(ogf[4 * i + 3]);
          if (i < 2) { w0[2 * i] = pk2(o[0], o[1]); w0[2 * i + 1] = pk2(o[2], o[3]); } else { w1[2 * i - 4] = pk2(o[0], o[1]); w1[2 * i - 3] = pk2(o[2], o[3]); } }
      *(u32x4v*)(yrow + 1024 + c0) = w0; *(u32x4v*)(yrow + 1024 + c0 + 8) = w1; }
}

__device__ void final_item(const Params& p, int item) {
    const int wid = threadIdx.x >> 6, lane = threadIdx.x & 63, row = item * 8 + wid, b = row >> 12, s = row & 4095, m = b * L + NMETA + s;
    const float* hrow = p.h + (size_t)m * D; float* orow = p.out + (size_t)row * D; f32x4 v[8]; float ss = 0.f;
#pragma unroll
    for (int i = 0; i < 8; ++i) { v[i] = *(const f32x4*)(hrow + (lane + 64 * i) * 4); ss += (v[i][0] * v[i][0] + v[i][1] * v[i][1]) + (v[i][2] * v[i][2] + v[i][3] * v[i][3]); }
    ss = wave_sum(ss); const float r = rsqrtf(ss * (1.0f / D) + EPS);
#pragma unroll
    for (int i = 0; i < 8; ++i) { const int c = (lane + 64 * i) * 4; *(f32x4*)(orow + c) = v[i] * r * *(const f32x4*)(p.final_norm + c); }
}

template <class Epi> __device__ __forceinline__ void run_gemm(PG8_LAS unsigned char* lds, const bf16_t* A, const bf16_t* Bt, int N, int K, const Epi& E) {
    pg8::Gemm g; g.A = A; g.Bt = Bt; g.M = MP; g.N = N; g.K = K;
    pg8::StaticOrder S; S.init(MP, N, (int)gridDim.x, (int)blockIdx.x);
    pg8::gemm_phase<Epi, pg8::StaticOrder>(lds, g, S, E);
}

__global__ __launch_bounds__(512, 2) void mega(Params p) {
    extern __shared__ __attribute__((aligned(16))) unsigned char smem[];
    cg::grid_group grid = cg::this_grid();
    PG8_LAS unsigned char* lds = (PG8_LAS unsigned char*)smem;
    float* smf = (float*)smem;
    const int G = gridDim.x, bid = blockIdx.x;
    transpose_mat(p.ffn1_wg, p.Wgu1, p.ffn1_norm, D, DFF, DFF, DFF, 1, smf);
    transpose_mat(p.ffn1_wu, p.Wgu1, p.ffn1_norm, D, DFF, DFF, DFF, 2, smf);
    transpose_mat(p.ffn1_wd, p.Wd1, nullptr, DFF, D, D, D, 0, smf);
    transpose_mat(p.w_in, p.Win, p.mix_norm, D, INCP, INC, INC, 0, smf);
    transpose_mat(p.w_out, p.Wout, nullptr, D, D, D, D, 0, smf);
    transpose_mat(p.ffn2_wg, p.Wgu2, p.ffn2_norm, D, DFF, DFF, DFF, 1, smf);
    transpose_mat(p.ffn2_wu, p.Wgu2, p.ffn2_norm, D, DFF, DFF, DFF, 2, smf);
    transpose_mat(p.ffn2_wd, p.Wd2, nullptr, DFF, D, D, D, 0, smf);
    if (bid == 0 && threadIdx.x == 0) *p.ctr = 0u;
    for (int it = bid; it < NT_ROWS + NT_Z2; it += G) { if (it < NT_ROWS) row_item(p, it); else z2_item(p, it - NT_ROWS); }
    grid.sync();
    { EpiSwiglu E; E.O = p.big; E.rowss = p.rowss; run_gemm(lds, p.hb, p.Wgu1, 2 * DFF, D, E); }
    grid.sync();
    { EpiResid<true> E; E.H = p.h; E.HB = p.hb; E.rowss = p.rowss; E.scale = 0.5f; run_gemm(lds, p.big, p.Wd1, D, DFF, E); }
    grid.sync();
    { EpiScale E; E.O = p.big; E.ldc = INCP; E.rowss = p.rowss; run_gemm(lds, p.hb, p.Win, INCP, D, E); }
    grid.sync();
    for (int it = bid; it < 1040; it += G) gla_pre(p, it, smem);
    grid.sync();
    if (bid < 64) gla_scan(p, bid, smem);
    for (;;) {
        if (threadIdx.x == 0) *(int*)(smem + HY_ZERO_OFF + 192) = (int)atomicAdd(p.ctr, 1u);
        __syncthreads();
        const int g = *(const int*)(smem + HY_ZERO_OFF + 192);
        __syncthreads();
        if (g >= 256) break;
        hyena_group(p, (g & 7) * 32 + (g >> 3), smem);
    }
    grid.sync();
    for (int it = bid; it < MP / 8; it += G) fin_item(p, it);
    grid.sync();
    { EpiResid<true> E; E.H = p.h; E.HB = p.hb; E.rowss = p.rowss; E.scale = 1.0f; run_gemm(lds, p.y, p.Wout, D, D, E); }
    grid.sync();
    { EpiSwiglu E; E.O = p.big; E.rowss = p.rowss; run_gemm(lds, p.hb, p.Wgu2, 2 * DFF, D, E); }
    grid.sync();
    { EpiResid<false> E; E.H = p.h; E.HB = nullptr; E.rowss = nullptr; E.scale = 0.5f; run_gemm(lds, p.big, p.Wd2, D, DFF, E); }
    grid.sync();
    for (int it = bid; it < 1024; it += G) final_item(p, it);
}

extern "C" void kernel_launch(void* const* d_in, const int* in_sizes, int n_in, void* d_out, int out_size, void* d_ws, size_t ws_size, hipStream_t stream) {
    static int grid_blocks = 0;
    if (!grid_blocks) {
        (void)hipFuncSetAttribute((const void*)mega, hipFuncAttributeMaxDynamicSharedMemorySize, LDS_BYTES);
        int dev = 0, cus = 0, per_cu = 0;
        (void)hipGetDevice(&dev);
        (void)hipDeviceGetAttribute(&cus, hipDeviceAttributeMultiprocessorCount, dev);
        (void)hipOccupancyMaxActiveBlocksPerMultiprocessor(&per_cu, mega, 512, LDS_BYTES);
        if (per_cu > 1) per_cu = 1;
        if (per_cu < 1) { fprintf(stderr, "occupancy query returned %d\n", per_cu); per_cu = 1; }
        grid_blocks = cus * per_cu;
    }
    Params p{};
    const float* const* in = (const float* const*)d_in;
    p.x = in[0]; p.meta = in[1]; p.ffn1_norm = in[2]; p.ffn1_wg = in[3]; p.ffn1_wu = in[4]; p.ffn1_wd = in[5]; p.mix_norm = in[6]; p.w_in = in[7];
    p.conv_w = in[8]; p.conv_b = in[9]; p.filt_w1 = in[10]; p.filt_b1 = in[11]; p.filt_w2 = in[12]; p.filt_b2 = in[13]; p.filt_w3 = in[14]; p.filt_freq = in[15];
    p.hyena_d = in[16]; p.hyena_norm = in[17]; p.gk_w2 = in[18]; p.gk_b2 = in[19]; p.gla_norm = in[20]; p.w_out = in[21];
    p.ffn2_norm = in[22]; p.ffn2_wg = in[23]; p.ffn2_wu = in[24]; p.ffn2_wd = in[25]; p.final_norm = in[26];
    p.out = (float*)d_out;
    unsigned char* ws = (unsigned char*)d_ws;
    constexpr size_t SZ_WGU = (size_t)2 * DFF * D * 2, SZ_WD = (size_t)D * DFF * 2, SZ_WIN = (size_t)INCP * D * 2, SZ_WOUT = (size_t)D * D * 2;
    constexpr size_t SZ_H = (size_t)MP * D * 4, SZ_HB = (size_t)MP * D * 2, SZ_BIG = (size_t)MP * INCP * 2, SZ_RS = (size_t)MP * 32 * 4, SZ_Z2 = (size_t)L * 64 * 4;
    size_t o = 0;
    p.Wgu1 = (bf16_t*)(ws + o); o += SZ_WGU; p.Wd1 = (bf16_t*)(ws + o); o += SZ_WD; p.Win = (bf16_t*)(ws + o); o += SZ_WIN; p.Wout = (bf16_t*)(ws + o); o += SZ_WOUT;
    p.Wgu2 = (bf16_t*)(ws + o); o += SZ_WGU; p.Wd2 = (bf16_t*)(ws + o); o += SZ_WD;
    p.h = (float*)(ws + o); o += SZ_H; p.hb = (bf16_t*)(ws + o); o += SZ_HB; p.big = (bf16_t*)(ws + o); o += SZ_BIG; p.rowss = (float*)(ws + o); o += SZ_RS; p.z2 = (float*)(ws + o); o += SZ_Z2; p.ctr = (unsigned*)(ws + o); o += 256;
    p.yc = (bf16_t*)ws; p.y = (bf16_t*)(ws + (size_t)M * 1024 * 2); p.of = (float*)p.hb; p.ob = (float*)d_out; p.gp = ws + (size_t)M * 1024 * 2;
    if (o > ws_size) fprintf(stderr, "workspace too small: need %zu have %zu\n", o, ws_size);
    void* args[] = {&p};
    hipError_t e = hipLaunchCooperativeKernel((void*)mega, dim3(grid_blocks), dim3(512), args, LDS_BYTES, stream);
    if (e != hipSuccess) fprintf(stderr, "cooperative launch failed: %s (grid %d)\n", hipGetErrorString(e), grid_blocks);
}
```

```cpp
#include <hip/hip_runtime.h>
#include <hip/hip_cooperative_groups.h>
#include <cstdio>
namespace cg = cooperative_groups;
namespace pg8 {
#define PG8_LAS __attribute__((address_space(3)))
typedef unsigned short bf16_t;
typedef short bf16x8 __attribute__((ext_vector_type(8)));
typedef float f32x4 __attribute__((ext_vector_type(4)));
typedef unsigned u32x4 __attribute__((ext_vector_type(4)));
constexpr int BM = 256, BK = 64, HALF = 128, HTB = HALF * BK * 2  , STAGE_BYTES = 8 * HTB, NXCD = 8, WGM = 8;

__host__ __device__ __forceinline__ int lds_byte(int r, int c) { const int st = (r >> 4) * 2 + (c >> 5), rr = r & 15, cc = c & 31, ob = rr * 64 + cc * 2; return st * 1024 + (ob ^ (((ob >> 9) & 1) << 5)); }
__host__ __device__ __forceinline__ void stage_rc(int b, int& R, int& C) { const int st = b / 1024, sb = b % 1024, swz = sb ^ (((sb >> 9) & 1) << 5); R = (st >> 1) * 16 + swz / 64; C = (st & 1) * 32 + (swz % 64) / 2; }
__host__ __device__ __forceinline__ int perm32(int rho) { const int n = rho >> 4, i = rho & 15; return 8 * (i >> 2) + 4 * n + (i & 3); }

struct Unit { int pm, pn; };
struct Gemm { const bf16_t* A; const bf16_t* Bt; int M, N, K; };

struct StaticOrder {
    int nM, nN, nwg, G, c;
    __host__ __device__ void init(int M, int N, int G_, int c_) { nM = M / BM; nN = N / BM; nwg = nM * nN; G = G_; c = c_; }
    __host__ __device__ bool next(int i, Unit& u) const {
        const long L = (long)i * G + c; if (L >= nwg) return false;
        int wgid = (int)L; { const int q = nwg / NXCD, r = nwg % NXCD, xcd = wgid % NXCD, off = wgid / NXCD; wgid = (xcd < r ? xcd * (q + 1) : r * (q + 1) + (xcd - r) * q) + off; }
        const int nig = WGM * nN, gid = wgid / nig, fm = gid * WGM, gsz = (nM - fm) < WGM ? (nM - fm) : WGM;
        u.pm = fm + ((wgid % nig) % gsz); u.pn = (wgid % nig) / gsz; return true;
    }
    __device__ __forceinline__ void a_ready(const Unit&) const {}
    __device__ __forceinline__ void done(const Unit&) const {}
};
__device__ __forceinline__ unsigned cvt_pk_bf16(float lo, float hi) { unsigned r; asm volatile("v_cvt_pk_bf16_f32 %0, %1, %2" : "=v"(r) : "v"(lo), "v"(hi)); return r; }
template <class Epi, class Sched>
__device__ __forceinline__ void gemm_phase(PG8_LAS unsigned char* lds, const Gemm g, const Sched& S, const Epi& E) {
    int tid_ = threadIdx.x; asm volatile("" : "+v"(tid_));
    const int tid = tid_, wid = __builtin_amdgcn_readfirstlane(tid >> 6), lane = tid & 63, wr = wid >> 2, wc = wid & 3, fr = lane & 15, fq = lane >> 4;
    const int K = g.K, nt = K / BK;
    unsigned voffA[2], voffB[2];
#pragma unroll
    for (int i = 0; i < 2; ++i) { int R, C; stage_rc(tid * 16 + i * 8192, R, C); const int Rb = Epi::PERM ? ((R & ~31) + perm32(R & 31)) : R;
        voffA[i] = (unsigned)(R * K + C) * 2u; voffB[i] = (unsigned)(Rb * K + C) * 2u; }
    const size_t kstep = (size_t)(BK * 2);
    const size_t hstep = (size_t)HALF * K * 2;
    const size_t tstep = 2 * hstep;
    const unsigned ldsw = (unsigned)wid * 1024u;
    const int aoff = lds_byte(wr * 64 + fr, fq * 8), boff = lds_byte(wc * 32 + fr, fq * 8);
#define PG8_SA(b, h) (((b) * 2 + (h)) * HTB)
#define PG8_SB(b, h) ((4 + (b) * 2 + (h)) * HTB)
#define PG8_STAGE(bufoff, gbase, voff) do { _Pragma("unroll") for (int _i = 0; _i < 2; ++_i) \
        __builtin_amdgcn_global_load_lds((const unsigned*)((const char*)(gbase) + (voff)[_i]), (PG8_LAS unsigned*)(lds + (bufoff) + ldsw + _i * 8192), 16, 0, 0); } while (0)
#define PG8_LDA(dst, b, h) do { _Pragma("unroll") for (int m = 0; m < 4; ++m) _Pragma("unroll") for (int k = 0; k < 2; ++k) dst[m][k] = *(const PG8_LAS bf16x8*)(lds + PG8_SA(b, h) + aoff + m * 2048 + k * 1024); } while (0)
#define PG8_LDB(dst, b, h) do { _Pragma("unroll") for (int n = 0; n < 2; ++n) _Pragma("unroll") for (int k = 0; k < 2; ++k) dst[n][k] = *(const PG8_LAS bf16x8*)(lds + PG8_SB(b, h) + boff + n * 2048 + k * 1024); } while (0)
#define PG8_MMA(ai, bj, At, Bt) do { __builtin_amdgcn_s_setprio(1); _Pragma("unroll") for (int m = 0; m < 4; ++m) _Pragma("unroll") for (int n = 0; n < 2; ++n) _Pragma("unroll") for (int k = 0; k < 2; ++k) \
        acc[ai][bj][m][n] = __builtin_amdgcn_mfma_f32_16x16x32_bf16(Bt[n][k], At[m][k], acc[ai][bj][m][n], 0, 0, 0); __builtin_amdgcn_s_setprio(0); } while (0)
#define PG8_WAIT_V(n) asm volatile("s_waitcnt vmcnt(" #n ")" ::: "memory")
#define PG8_WAIT_L(n) asm volatile("s_waitcnt lgkmcnt(" #n ")" ::: "memory")
#define PG8_BAR __builtin_amdgcn_s_barrier()
#define PG8_SCHED __builtin_amdgcn_sched_barrier(0)
    Unit cur, nxt; int ui = 0;
    if (!S.next(0, cur)) return;
    f32x4 acc[2][2][4][2];
#pragma unroll
    for (int a = 0; a < 2; ++a)
#pragma unroll
        for (int b = 0; b < 2; ++b)
#pragma unroll
            for (int m = 0; m < 4; ++m)
#pragma unroll
                for (int n = 0; n < 2; ++n) acc[a][b][m][n] = (f32x4){0.f, 0.f, 0.f, 0.f};
    bf16x8 At[4][2], B0[2][2], B1[2][2];
    const char* cA = (const char*)g.A + (size_t)cur.pm * tstep; const char* cB = (const char*)g.Bt + (size_t)cur.pn * tstep;
    S.a_ready(cur);
    PG8_STAGE(PG8_SB(0, 0), cB, voffB); PG8_STAGE(PG8_SA(0, 0), cA, voffA); PG8_STAGE(PG8_SB(0, 1), cB + hstep, voffB); PG8_STAGE(PG8_SA(0, 1), cA + hstep, voffA);
    if (wr == 1) PG8_BAR;
    PG8_WAIT_V(4); PG8_BAR;
    PG8_STAGE(PG8_SB(1, 0), cB + kstep, voffB); PG8_STAGE(PG8_SA(1, 0), cA + kstep, voffA); PG8_STAGE(PG8_SB(1, 1), cB + hstep + kstep, voffB);
    PG8_WAIT_V(6); PG8_BAR;
    for (;;) {
        const bool has_next = S.next(ui + 1, nxt);
        const char* nA = has_next ? (const char*)g.A + (size_t)nxt.pm * tstep : cA; const char* nB = has_next ? (const char*)g.Bt + (size_t)nxt.pn * tstep : cB;
        for (int t = 0; t < nt; t += 2) {
            const bool last = (t == nt - 2);
            const char* a1 = cA + (size_t)(t + 1) * kstep;
            const char* a2 = last ? nA : cA + (size_t)(t + 2) * kstep; const char* b2 = last ? nB : cB + (size_t)(t + 2) * kstep;
            const char* a3 = a2 + kstep; const char* b3 = b2 + kstep;
            if (last && has_next) S.a_ready(nxt);
            PG8_LDB(B0, 0, 0); PG8_SCHED; PG8_LDA(At, 0, 0); PG8_STAGE(PG8_SA(1, 1), a1 + hstep, voffA);
            PG8_WAIT_L(8); PG8_BAR; PG8_WAIT_L(0); PG8_MMA(0, 0, At, B0); PG8_BAR; PG8_SCHED;
            PG8_LDB(B1, 0, 1); PG8_STAGE(PG8_SB(0, 0), b2, voffB);
            PG8_BAR; PG8_WAIT_L(0); PG8_MMA(0, 1, At, B1); PG8_BAR;
            PG8_LDA(At, 0, 1); PG8_STAGE(PG8_SA(0, 0), a2, voffA);
            PG8_BAR; PG8_WAIT_L(0); PG8_MMA(1, 0, At, B0); PG8_BAR; PG8_SCHED;
            PG8_STAGE(PG8_SB(0, 1), b2 + hstep, voffB);
            PG8_WAIT_V(6); PG8_BAR; PG8_MMA(1, 1, At, B1); PG8_BAR;
            PG8_LDB(B0, 1, 0); PG8_SCHED; PG8_LDA(At, 1, 0); PG8_STAGE(PG8_SA(0, 1), a2 + hstep, voffA);
            PG8_WAIT_L(8); PG8_BAR; PG8_WAIT_L(0); PG8_MMA(0, 0, At, B0); PG8_BAR; PG8_SCHED;
            PG8_LDB(B1, 1, 1); PG8_STAGE(PG8_SB(1, 0), b3, voffB);
            PG8_BAR; PG8_WAIT_L(0); PG8_MMA(0, 1, At, B1); PG8_BAR;
            PG8_LDA(At, 1, 1); PG8_STAGE(PG8_SA(1, 0), a3, voffA);
            PG8_BAR; PG8_WAIT_L(0); PG8_MMA(1, 0, At, B0); PG8_BAR; PG8_SCHED;
            PG8_STAGE(PG8_SB(1, 1), b3 + hstep, voffB);
            PG8_WAIT_V(6); PG8_BAR; PG8_MMA(1, 1, At, B1); PG8_BAR;
        }
        if constexpr (!Epi::AFTER_DRAIN) { E(acc, cur, wr, wc, fr, fq); S.done(cur); }
        if (!has_next) break;
#pragma unroll
        for (int a = 0; a < 2; ++a)
#pragma unroll
            for (int b = 0; b < 2; ++b)
#pragma unroll
                for (int m = 0; m < 4; ++m)
#pragma unroll
                    for (int n = 0; n < 2; ++n) acc[a][b][m][n] = (f32x4){0.f, 0.f, 0.f, 0.f};
        cur = nxt; cA = nA; cB = nB; ++ui;
    }
    PG8_WAIT_V(0);
    if (wr == 0) PG8_BAR;
    PG8_BAR;
    if constexpr (Epi::AFTER_DRAIN) { E.fused(acc, cur, wr, wc, fr, fq, lds, wid, lane); S.done(cur); }
#undef PG8_SA
#undef PG8_SB
#undef PG8_STAGE
#undef PG8_LDA
#undef PG8_LDB
#undef PG8_MMA
#undef PG8_WAIT_V
#undef PG8_WAIT_L
#undef PG8_BAR
#undef PG8_SCHED
}
}

#include <cstdio>
#include <ctime>
#include <cstdlib>
#include <cstring>
#include <cmath>
#include <vector>
#include <algorithm>

using pg8::bf16_t; using pg8::f32x4; using pg8::Unit;
typedef unsigned u32x2v __attribute__((ext_vector_type(2)));
typedef unsigned u32x4v __attribute__((ext_vector_type(4)));

constexpr int D = 2048, SEQ = 4096, NMETA = 16, L = 4112, M = 8224, MP = 8448, DFF = 5632, INC = 6176, INCP = 6400;
constexpr float EPS = 1e-6f;
constexpr int LDS_BYTES = 4 * (8336 * 2 + 2 * 65 * 144) + 256;
constexpr unsigned PROBE_MASK = 0u; constexpr int PROBE_K = 8;
constexpr int C_Q = 3072, C_K = 3584, C_V = 4096, C_OG = 5120, C_LR = 6144;

struct Params {
    const float *x, *meta, *ffn1_norm, *ffn1_wg, *ffn1_wu, *ffn1_wd, *mix_norm, *w_in, *conv_w, *conv_b,
        *filt_w1, *filt_b1, *filt_w2, *filt_b2, *filt_w3, *filt_freq, *hyena_d, *hyena_norm, *gk_w2, *gk_b2, *gla_norm, *w_out,
        *ffn2_norm, *ffn2_wg, *ffn2_wu, *ffn2_wd, *final_norm;
    float* out;
    bf16_t *Wgu1, *Wd1, *Win, *Wout, *Wgu2, *Wd2;
    float* h; bf16_t* hb; bf16_t* big; float* rowss; float* z2;
    bf16_t* y; bf16_t* yc; float* of; float* ob; unsigned char* gp; unsigned* ctr; bf16_t* uT;
};

__device__ __forceinline__ float bf2f(bf16_t b) { return __uint_as_float(((unsigned)b) << 16); }
__device__ __forceinline__ unsigned pk2(float lo, float hi) { return pg8::cvt_pk_bf16(lo, hi); }
__device__ __forceinline__ float wave_sum(float v) {
#pragma unroll
    for (int o = 32; o; o >>= 1) v += __shfl_xor(v, o);
    return v;
}
__device__ __forceinline__ float silu_f(float x) { return x * __builtin_amdgcn_rcpf(1.0f + __expf(-x)); }

__device__ __forceinline__ float row_rscale(const float* rowss, int r, int fq) {
    const f32x4* q = (const f32x4*)(rowss + (size_t)r * 32 + fq * 8);
    const f32x4 a = q[0], b = q[1];
    float s = ((a[0] + a[1]) + (a[2] + a[3])) + ((b[0] + b[1]) + (b[2] + b[3]));
    s += __shfl_xor(s, 16); s += __shfl_xor(s, 32);
    return rsqrtf(s * (1.0f / D) + EPS);
}

struct EpiSwiglu {
    static constexpr bool PERM = true, AFTER_DRAIN = false;
    bf16_t* O; const float* rowss;
    __device__ __forceinline__ void operator()(const f32x4 (&acc)[2][2][4][2], const Unit& u, int wr, int wc, int fr, int fq) const {
        const int row0 = u.pm * 256 + wr * 64 + fr, col0 = u.pn * 128 + wc * 32 + 8 * fq;
#pragma unroll
        for (int ai = 0; ai < 2; ++ai)
#pragma unroll
            for (int m = 0; m < 4; ++m) {
                const int r = row0 + ai * 128 + m * 16; const float rs = row_rscale(rowss, r, fq);
                u32x4v w;
#pragma unroll
                for (int n = 0; n < 2; ++n) { const f32x4 g = acc[ai][0][m][n] * rs, uu = acc[ai][1][m][n] * rs;
                    w[2 * n] = pk2(silu_f(g[0]) * uu[0], silu_f(g[1]) * uu[1]); w[2 * n + 1] = pk2(silu_f(g[2]) * uu[2], silu_f(g[3]) * uu[3]); }
                *(u32x4v*)(O + (size_t)r * DFF + col0) = w;
            }
    }
};
struct EpiScale {
    static constexpr bool PERM = true, AFTER_DRAIN = false;
    bf16_t* O; int ldc; const float* rowss;
    __device__ __forceinline__ void operator()(const f32x4 (&acc)[2][2][4][2], const Unit& u, int wr, int wc, int fr, int fq) const {
        const int row0 = u.pm * 256 + wr * 64 + fr, col0 = u.pn * 256 + wc * 32 + 8 * fq;
#pragma unroll
        for (int ai = 0; ai < 2; ++ai)
#pragma unroll
            for (int m = 0; m < 4; ++m) {
                const int r = row0 + ai * 128 + m * 16; const float rs = row_rscale(rowss, r, fq);
#pragma unroll
                for (int bj = 0; bj < 2; ++bj) { const f32x4 a = acc[ai][bj][m][0] * rs, b = acc[ai][bj][m][1] * rs;
                    u32x4v w; w[0] = pk2(a[0], a[1]); w[1] = pk2(a[2], a[3]); w[2] = pk2(b[0], b[1]); w[3] = pk2(b[2], b[3]);
                    *(u32x4v*)(O + (size_t)r * ldc + col0 + bj * 128) = w; }
            }
    }
};
template <bool WHB> struct EpiResid {
    static constexpr bool PERM = true, AFTER_DRAIN = false;
    float* H; bf16_t* HB; float* rowss; float scale;
    __device__ __forceinline__ void operator()(const f32x4 (&acc)[2][2][4][2], const Unit& u, int wr, int wc, int fr, int fq) const {
        const int row0 = u.pm * 256 + wr * 64 + fr, col0 = u.pn * 256 + wc * 32 + 8 * fq;
#pragma unroll
        for (int ai = 0; ai < 2; ++ai)
#pragma unroll
            for (int m = 0; m < 4; ++m) {
                const int r = row0 + ai * 128 + m * 16; float ss = 0.f;
#pragma unroll
                for (int bj = 0; bj < 2; ++bj) { float* hp = H + (size_t)r * D + col0 + bj * 128;
                    f32x4 a = *(const f32x4*)hp, b = *(const f32x4*)(hp + 4);
                    a += acc[ai][bj][m][0] * scale; b += acc[ai][bj][m][1] * scale;
                    *(f32x4*)hp = a; *(f32x4*)(hp + 4) = b;
                    ss += (a[0] * a[0] + a[1] * a[1]) + (a[2] * a[2] + a[3] * a[3]) + (b[0] * b[0] + b[1] * b[1]) + (b[2] * b[2] + b[3] * b[3]);
                    if (WHB) { u32x4v w; w[0] = pk2(a[0], a[1]); w[1] = pk2(a[2], a[3]); w[2] = pk2(b[0], b[1]); w[3] = pk2(b[2], b[3]);
                        *(u32x4v*)(HB + (size_t)r * D + col0 + bj * 128) = w; } }
                ss += __shfl_xor(ss, 16); ss += __shfl_xor(ss, 32);
                if (WHB && fq == 0) rowss[(size_t)r * 32 + u.pn * 4 + wc] = ss;
            }
    }
};

constexpr int NT_FFN = 2816, NT_WIN = 3200, NT_WOUT = 1024, NT_TR = 6 * NT_FFN + NT_WIN + NT_WOUT, NT_ROWS = MP / 8, NT_Z2 = (L + 7) / 8, P0_ITEMS = NT_TR + NT_ROWS + NT_Z2;

__device__ __forceinline__ void transpose_mat(const float* src, bf16_t* dst, const float* gain, const int K, const int N, const int ld, const int nvalid, const int mode, float* tl) {
    const int ntn = N / 64, ntiles = (K / 64) * ntn, tid = threadIdx.x;
    for (int it = blockIdx.x; it < ntiles; it += gridDim.x) {
        const int kt = it / ntn, nt = it - kt * ntn, k0 = kt * 64, n0 = nt * 64;
        const long drow0 = mode == 0 ? n0 : (n0 / 128) * 256 + (n0 % 128) + (mode == 2 ? 128 : 0);
        { const int r = tid >> 4, c4 = (tid & 15) * 4;
#pragma unroll
          for (int i = 0; i < 2; ++i) { const int row = r + 32 * i, k = k0 + row, n = n0 + c4;
              f32x4 v = {0.f, 0.f, 0.f, 0.f};
              if (n < nvalid) v = *(const f32x4*)(src + (size_t)k * ld + n);
              const float g = gain ? gain[k] : 1.0f;
              float* t = tl + row * 65 + c4; t[0] = v[0] * g; t[1] = v[1] * g; t[2] = v[2] * g; t[3] = v[3] * g; } }
        __syncthreads();
        { const int n = tid >> 3, k8 = (tid & 7) * 8; float v[8];
#pragma unroll
          for (int j = 0; j < 8; ++j) v[j] = tl[(k8 + j) * 65 + n];
          u32x4v w; w[0] = pk2(v[0], v[1]); w[1] = pk2(v[2], v[3]); w[2] = pk2(v[4], v[5]); w[3] = pk2(v[6], v[7]);
          *(u32x4v*)(dst + (size_t)(drow0 + n) * K + k0 + k8) = w; }
        __syncthreads();
    }
}

__device__ void row_item(const Params& p, int item) {
    const int wid = threadIdx.x >> 6, lane = threadIdx.x & 63, m = item * 8 + wid;
    float* hrow = p.h + (size_t)m * D; bf16_t* hbrow = p.hb + (size_t)m * D;
    if (m < M) { const int b = m / L, t = m - b * L;
        const float* src = t < NMETA ? p.meta + (size_t)t * D : p.x + ((size_t)b * SEQ + t - NMETA) * D;
        float ss = 0.f;
#pragma unroll
        for (int i = 0; i < 8; ++i) { const int c = (lane + 64 * i) * 4; const f32x4 v = *(const f32x4*)(src + c);
            ss += (v[0] * v[0] + v[1] * v[1]) + (v[2] * v[2] + v[3] * v[3]);
            *(f32x4*)(hrow + c) = v; u32x2v w; w[0] = pk2(v[0], v[1]); w[1] = pk2(v[2], v[3]); *(u32x2v*)(hbrow + c) = w; }
        ss = wave_sum(ss);
        if (lane < 32) p.rowss[(size_t)m * 32 + lane] = lane == 0 ? ss : 0.f;
    } else {
#pragma unroll
        for (int i = 0; i < 8; ++i) { const int c = (lane + 64 * i) * 4; *(f32x4*)(hrow + c) = (f32x4){0.f, 0.f, 0.f, 0.f}; u32x2v w; w[0] = 0u; w[1] = 0u; *(u32x2v*)(hbrow + c) = w; }
        if (lane < 32) p.rowss[(size_t)m * 32 + lane] = 0.f;
    }
}

__device__ void z2_item(const Params& p, int item) {
    const int wid = threadIdx.x >> 6, lane = threadIdx.x & 63, j = item * 8 + wid;
    if (j >= L) return;
    float feat = 0.f;
    const float w = (float)(2.0 * 3.14159265358979323846 / L) * (float)j;
    if (lane == 0) feat = (float)j * (1.0f / (float)(L - 1));
    else if (lane <= 32) { const int bi = (lane - 1) & 15; const float band = 1e-4f + (float)bi * ((15.0f - 1e-4f) / 15.0f); const float ang = w * band;
        feat = lane <= 16 ? cosf(ang) : -sinf(ang); }
    float a = p.filt_b1[lane];
    for (int i = 0; i < 33; ++i) a += __shfl(feat, i) * p.filt_w1[i * 64 + lane];
    const float fr = p.filt_freq[lane];
    const float z1 = sinf(fr * a);
    float c = p.filt_b2[lane];
    for (int k = 0; k < 64; ++k) c += __shfl(z1, k) * p.filt_w2[k * 64 + lane];
    p.z2[(size_t)j * 64 + lane] = sinf(fr * c);
}

constexpr int HY_G_ELEMS = 8336, HY_G_BYTES = HY_G_ELEMS * 2, HY_USTR = 144, HY_U_BYTES = 65 * HY_USTR, HY_CH_BYTES = HY_G_BYTES + 2 * HY_U_BYTES, HY_ZERO_OFF = 4 * HY_CH_BYTES;
static_assert(HY_ZERO_OFF + 256 <= LDS_BYTES, "lds");
static_assert(HY_CH_BYTES % 16 == 0 && HY_G_BYTES % 16 == 0, "align");
__device__ void hyu_item(const Params& p, int item, unsigned char* sm) {
    const int cb = item & 3, bt = item >> 2, b = bt / 65, tile = bt - b * 65, t0 = tile * 64;
    const int tid = threadIdx.x, tl = tid & 63, qg = tid >> 6, t = t0 + tl;
    bf16_t* LT = (bf16_t*)sm;
#pragma unroll
    for (int x = 0; x < 4; ++x) { const int q = qg * 4 + x, c8 = cb * 256 + q * 8;
        float a1[8], a2[8];
#pragma unroll
        for (int h2 = 0; h2 < 2; ++h2) { const f32x4 b1 = *(const f32x4*)(p.conv_b + 1024 + c8 + 4 * h2), b2v = *(const f32x4*)(p.conv_b + 2048 + c8 + 4 * h2);
#pragma unroll
            for (int e = 0; e < 4; ++e) { a1[4 * h2 + e] = b1[e]; a2[4 * h2 + e] = b2v[e]; } }
        if (t < L) {
#pragma unroll
            for (int jj = 0; jj < 3; ++jj) { const int t2 = t + jj - 1;
                if (t2 >= 0 && t2 < L) { const bf16_t* row = p.big + (size_t)(b * L + t2) * INCP + c8;
                    const u32x4v x1 = *(const u32x4v*)(row + 1024), vh = *(const u32x4v*)(row + 2048);
#pragma unroll
                    for (int h2 = 0; h2 < 2; ++h2) { const f32x4 w1 = *(const f32x4*)(p.conv_w + jj * 3072 + 1024 + c8 + 4 * h2), w2 = *(const f32x4*)(p.conv_w + jj * 3072 + 2048 + c8 + 4 * h2);
                        a1[4 * h2] += __uint_as_float(x1[2 * h2] << 16) * w1[0]; a1[4 * h2 + 1] += __uint_as_float(x1[2 * h2] & 0xffff0000u) * w1[1];
                        a1[4 * h2 + 2] += __uint_as_float(x1[2 * h2 + 1] << 16) * w1[2]; a1[4 * h2 + 3] += __uint_as_float(x1[2 * h2 + 1] & 0xffff0000u) * w1[3];
                        a2[4 * h2] += __uint_as_float(vh[2 * h2] << 16) * w2[0]; a2[4 * h2 + 1] += __uint_as_float(vh[2 * h2] & 0xffff0000u) * w2[1];
                        a2[4 * h2 + 2] += __uint_as_float(vh[2 * h2 + 1] << 16) * w2[2]; a2[4 * h2 + 3] += __uint_as_float(vh[2 * h2 + 1] & 0xffff0000u) * w2[3]; } } }
        }
#pragma unroll
        for (int e = 0; e < 8; ++e) LT[(q * 8 + e) * 72 + tl] = t < L ? (bf16_t)(pk2(a1[e] * a2[e], 0.f) & 0xffffu) : (bf16_t)0;
    }
    __syncthreads();
    { const int row = tid >> 1, half = tid & 1; bf16_t* dst = p.uT + ((size_t)(cb * 256 + row) * 2 + b) * 4160 + t0 + half * 32;
#pragma unroll
      for (int i = 0; i < 4; ++i) *(u32x4v*)(dst + 8 * i) = *(const u32x4v*)(LT + row * 72 + half * 32 + 8 * i); }
    __syncthreads();
}
__device__ void hyena_group(const Params& p, int grp_, unsigned char* sm, unsigned long long& tsec) {
    unsigned long long ts0_ = PROBE_MASK ? wall_clock64() : 0ull;
#define HSEC(i) do { if (PROBE_MASK) { const unsigned long long t_ = wall_clock64(); if ((PROBE_MASK >> (i)) & 1u) tsec += t_ - ts0_; ts0_ = t_; } } while (0)
    const int grp = __builtin_amdgcn_readfirstlane(grp_);
    const int tid = threadIdx.x, wid = tid >> 6, lane = tid & 63, c0 = grp * 4;
    { const unsigned char* src = (const unsigned char*)(p.uT + (size_t)c0 * 2 * 4160);
      for (int idx = tid; idx < 8 * 520; idx += 512) { const int r = idx / 520, i = idx - r * 520;
          *(u32x4v*)(sm + (r >> 1) * HY_CH_BYTES + HY_G_BYTES + (r & 1) * HY_U_BYTES + (i >> 3) * HY_USTR + (i & 7) * 16) = *(const u32x4v*)(src + (size_t)idx * 16); } }
    if (tid < 36) ((unsigned*)(sm + HY_ZERO_OFF))[tid] = 0u;
    for (int i = tid; i < 4 * 113; i += 512) { const int ch = i / 113, q = i - ch * 113; const int idx = q < 49 ? q : 8272 + (q - 49);
        *(unsigned short*)(sm + ch * HY_CH_BYTES + 2 * idx) = 0; }
    {
        int wv[8];
#pragma unroll
        for (int f = 0; f < 8; ++f) wv[f] = __float_as_int(p.filt_w3[(size_t)lane * 2048 + (f >> 2) * 1024 + c0 + (f & 3)]);
        const float la = -3.0701134573253945f, lb = -15.350567286626973f;
        float delta[4];
#pragma unroll
        for (int ch = 0; ch < 4; ++ch) delta[ch] = fabsf(la + (float)(c0 + ch) * ((lb - la) / 1023.0f));
        for (int j0 = 0; j0 < L; j0 += 512) { const int j = j0 + tid; const int jc = j < L ? j : L - 1;
            const f32x4* zp = (const f32x4*)(p.z2 + (size_t)jc * 64);
            f32x4 z[16];
#pragma unroll
            for (int k4 = 0; k4 < 16; ++k4) z[k4] = zp[k4];
            float hv[8];
#pragma unroll
            for (int f = 0; f < 8; ++f) { float a = 0.f;
#pragma unroll
                for (int k = 0; k < 64; ++k) a = fmaf(z[k >> 2][k & 3], __int_as_float(__builtin_amdgcn_readlane(wv[f], k)), a);
                hv[f] = a; }
            if (j < L) { const float t = (float)j * (1.0f / (float)(L - 1));
#pragma unroll
                for (int ch = 0; ch < 4; ++ch) { const float win = expf(-t * delta[ch]); const float f = hv[ch] * win, bk = hv[4 + ch] * win;
                    unsigned short* gb = (unsigned short*)(sm + ch * HY_CH_BYTES);
                    if (j == 0) gb[4160] = (unsigned short)(pk2(f + bk, 0.f) & 0xffffu);
                    else { gb[4160 - j] = (unsigned short)(pk2(f, 0.f) & 0xffffu); gb[4160 + j] = (unsigned short)(pk2(bk, 0.f) & 0xffffu); } } }
        }
    }
    __syncthreads();
    HSEC(12);
    const int ch = wid >> 1, b = wid & 1, li = lane & 15, kq = lane >> 4;
    unsigned char* Ub = sm + ch * HY_CH_BYTES + HY_G_BYTES + b * HY_U_BYTES;
    const unsigned char* Zb = sm + HY_ZERO_OFF + kq * 16;
    f32x4 acc[4][5];
#pragma unroll
    for (int rb = 0; rb < 4; ++rb)
#pragma unroll
        for (int nb = 0; nb < 5; ++nb) acc[rb][nb] = (f32x4){0.f, 0.f, 0.f, 0.f};
    const unsigned shl = (li & 1) ? 16u : 0u;
    unsigned gq[5];
#pragma unroll
    for (int w = 0; w < 5; ++w) { unsigned t_ = (unsigned)(ch * HY_CH_BYTES + 4 * (((4160 + 8 * kq - li) >> 1) + w)); asm volatile("" : "+v"(t_)); gq[w] = t_; }
    PG8_LAS const unsigned char* sml = (PG8_LAS const unsigned char*)sm;
    auto gfrag = [&](int mp) -> pg8::bf16x8 {
        unsigned e[5];
#pragma unroll
        for (int w = 0; w < 5; ++w) e[w] = *(PG8_LAS const unsigned*)(sml + (gq[w] - 32 * mp));
        u32x4v r;
#pragma unroll
        for (int w = 0; w < 4; ++w) r[w] = __builtin_amdgcn_alignbit(e[w + 1], e[w], shl);
        return __builtin_bit_cast(pg8::bf16x8, r);
    };
    pg8::bf16x8 F[6];
    F[4] = gfrag(4 * (-64) - 2); F[5] = gfrag(4 * (-64) - 1);
    for (int d = -64; d <= 64; ++d) {
        F[0] = F[4]; F[1] = F[5];
#pragma unroll
        for (int q = 2; q < 6; ++q) F[q] = gfrag(4 * d - 2 + q);
        const int nb_lo = d > 0 ? (d >> 4) : 0, nb_hi = (d + 64) >> 4;
#pragma unroll
        for (int nb = 0; nb < 5; ++nb) {
            if (nb >= nb_lo && nb <= nb_hi) {
                const int sblk = 16 * nb + li - d;
                const unsigned char* up = ((unsigned)sblk < 65u) ? (Ub + sblk * HY_USTR + kq * 16) : Zb;
                const pg8::bf16x8 B0 = *(const pg8::bf16x8*)up, B1 = *(const pg8::bf16x8*)(up + 64);
#pragma unroll
                for (int rb = 0; rb < 4; ++rb) {
                    acc[rb][nb] = __builtin_amdgcn_mfma_f32_16x16x32_bf16(F[rb + 2], B0, acc[rb][nb], 0, 0, 0);
                    acc[rb][nb] = __builtin_amdgcn_mfma_f32_16x16x32_bf16(F[rb], B1, acc[rb][nb], 0, 0, 0);
                }
            }
        }
    }
    HSEC(13);
    {
        const float dc = p.hyena_d[c0 + ch];
#pragma unroll
        for (int nb = 0; nb < 5; ++nb) { const int t1 = 16 * nb + li;
            if (t1 < 65) {
#pragma unroll
                for (int rb = 0; rb < 4; ++rb) { unsigned char* up = Ub + t1 * HY_USTR + (16 * rb + 4 * kq) * 2;
                    const u32x2v uu = *(const u32x2v*)up; const f32x4 a = acc[rb][nb];
                    u32x2v w; w[0] = pk2(a[0] + dc * __uint_as_float(uu[0] << 16), a[1] + dc * __uint_as_float(uu[0] & 0xffff0000u));
                    w[1] = pk2(a[2] + dc * __uint_as_float(uu[1] << 16), a[3] + dc * __uint_as_float(uu[1] & 0xffff0000u));
                    *(u32x2v*)up = w; } } }
    }
    __syncthreads();
    for (int tt = tid; tt < 2 * L; tt += 512) { const int bb = tt >= L ? 1 : 0, t = tt - bb * L;
        const unsigned char* up = sm + HY_G_BYTES + bb * HY_U_BYTES + (t >> 6) * HY_USTR + (t & 63) * 2;
        const unsigned v0 = *(const unsigned short*)up, v1 = *(const unsigned short*)(up + HY_CH_BYTES), v2 = *(const unsigned short*)(up + 2 * HY_CH_BYTES), v3 = *(const unsigned short*)(up + 3 * HY_CH_BYTES);
        u32x2v w; w[0] = v0 | (v1 << 16); w[1] = v2 | (v3 << 16);
        *(u32x2v*)(p.yc + (size_t)(bb * L + t) * 1024 + c0) = w; }
    __syncthreads();
    HSEC(14);
}

constexpr int GP_QT = 0, GP_KT = 16384, GP_AM = 32768, GP_DEC = 40960, GP_STRIDE = 41472;
__device__ __forceinline__ bf16_t f2bf(float v) { return (bf16_t)(pk2(v, 0.f) & 0xffffu); }
__device__ void gla_pre(const Params& p, int item, unsigned char* sm) {
    const int n = item % 65, bdh = item / 65, hh = bdh & 3, dir = (bdh >> 2) & 1, b = bdh >> 3;
    const int tid = threadIdx.x, d = tid & 127, seg = tid >> 7, lane = tid & 63, wid = tid >> 6, li = lane & 15, kq = lane >> 4;
    float* LR = (float*)sm; float* SEGT = LR + 1024; bf16_t* QS = (bf16_t*)(sm + 8192); bf16_t* KS = QS + 64 * 136;
    unsigned char* gp = p.gp + (size_t)item * GP_STRIDE;
    { const int i = tid >> 3, r2 = (tid & 7) * 2; const int tau = dir ? 4159 - (64 * n + i) : 64 * n + i; float v0 = 0.f, v1 = 0.f;
      if (tau >= 48) { const unsigned w = *(const unsigned*)(p.big + (size_t)(b * L + tau - 48) * INCP + C_LR + dir * 16 + r2); v0 = __uint_as_float(w << 16); v1 = __uint_as_float(w & 0xffff0000u); }
      LR[i * 16 + r2] = v0; LR[i * 16 + r2 + 1] = v1; }
    float w2[16];
#pragma unroll
    for (int r = 0; r < 16; ++r) w2[r] = p.gk_w2[(size_t)(dir * 16 + r) * 512 + hh * 128 + d];
    const float b2 = p.gk_b2[dir * 512 + hh * 128 + d];
    __syncthreads();
    float cs[16]; float run = 0.f;
#pragma unroll
    for (int ii = 0; ii < 16; ++ii) { const int i = seg * 16 + ii; const int tau = dir ? 4159 - (64 * n + i) : 64 * n + i;
        float xg = b2;
#pragma unroll
        for (int r4 = 0; r4 < 4; ++r4) { const f32x4 l4 = *(const f32x4*)(LR + i * 16 + 4 * r4); xg += l4[0] * w2[4 * r4] + l4[1] * w2[4 * r4 + 1] + l4[2] * w2[4 * r4 + 2] + l4[3] * w2[4 * r4 + 3]; }
        const float lg = tau >= 48 ? (fminf(xg, 0.f) - __logf(1.0f + __expf(-fabsf(xg)))) * (1.0f / 16.0f) : 0.f;
        run += lg; cs[ii] = run; }
    SEGT[seg * 128 + d] = run;
    __syncthreads();
    float off = 0.f, tot = 0.f;
#pragma unroll
    for (int s = 0; s < 4; ++s) { const float v = SEGT[s * 128 + d]; if (s < seg) off += v; tot += v; }
    unsigned kt[8];
#pragma unroll
    for (int ii = 0; ii < 16; ii += 2) { float kh[2];
#pragma unroll
        for (int x = 0; x < 2; ++x) { const int i = seg * 16 + ii + x; const int tau = dir ? 4159 - (64 * n + i) : 64 * n + i; float q = 0.f, k = 0.f;
            if (tau >= 48) { const bf16_t* row = p.big + (size_t)(b * L + tau - 48) * INCP + hh * 128 + d; q = bf2f(row[C_Q]); k = bf2f(row[C_K]); }
            const float bi = off + cs[ii + x]; const bf16_t qv = f2bf(q * 0.08838834764831845f * __expf(bi));
            QS[i * 136 + d] = qv; KS[i * 136 + d] = f2bf(k * __expf(-bi)); *(bf16_t*)(gp + GP_QT + (i * 128 + d) * 2) = qv; kh[x] = k * __expf(tot - bi); }
        kt[ii >> 1] = pk2(kh[0], kh[1]); }
    { u32x4v w0, w1; w0[0] = kt[0]; w0[1] = kt[1]; w0[2] = kt[2]; w0[3] = kt[3]; w1[0] = kt[4]; w1[1] = kt[5]; w1[2] = kt[6]; w1[3] = kt[7];
      *(u32x4v*)(gp + GP_KT + (d * 64 + seg * 16) * 2) = w0; *(u32x4v*)(gp + GP_KT + (d * 64 + seg * 16 + 8) * 2) = w1; }
    if (seg == 0) *(float*)(gp + GP_DEC + d * 4) = __expf(tot);
    __syncthreads();
    { const int it = wid >> 1;
#pragma unroll
      for (int x = 0; x < 2; ++x) { const int jt = (wid & 1) * 2 + x; f32x4 acc = {0.f, 0.f, 0.f, 0.f};
#pragma unroll
          for (int ks = 0; ks < 4; ++ks) { const pg8::bf16x8 a = *(const pg8::bf16x8*)(QS + (16 * it + li) * 136 + 32 * ks + 8 * kq), bb = *(const pg8::bf16x8*)(KS + (16 * jt + li) * 136 + 32 * ks + 8 * kq);
              acc = __builtin_amdgcn_mfma_f32_16x16x32_bf16(a, bb, acc, 0, 0, 0); }
#pragma unroll
          for (int r = 0; r < 4; ++r) { const int i = 16 * it + 4 * kq + r, j = 16 * jt + li; *(bf16_t*)(gp + GP_AM + (i * 64 + j) * 2) = f2bf(j <= i ? acc[r] : 0.f); } } }
    __syncthreads();
}

__device__ void gla_scan(const Params& p, int item, unsigned char* sm) {
    const int s = item & 3, bdh = item >> 2, hh = bdh & 3, dir = (bdh >> 2) & 1, b = bdh >> 3;
    const int tid = threadIdx.x, lane = tid & 63, wid = tid >> 6, li = lane & 15, kq = lane >> 4;
    constexpr int O_QS = 0, O_KT = 17408, O_AS = O_KT + 18432, O_VT = O_AS + 9216, O_DEC = O_VT + 9216, BUF = O_DEC + 512, O_ST = 2 * BUF;
    static_assert(O_ST + 17408 <= HY_ZERO_OFF, "lds");
    float* outp = dir ? p.ob : p.of;
    const unsigned char* gbase = p.gp + (size_t)(bdh * 65) * GP_STRIDE;
    struct RS { u32x4v rq[2], rk[2], ra, rv, rd; };
    auto LOAD = [&](int n, RS& R) {
        const unsigned char* g = gbase + (size_t)n * GP_STRIDE;
        R.rq[0] = *(const u32x4v*)(g + GP_QT + tid * 16); R.rq[1] = *(const u32x4v*)(g + GP_QT + (tid + 512) * 16);
        R.rk[0] = *(const u32x4v*)(g + GP_KT + tid * 16); R.rk[1] = *(const u32x4v*)(g + GP_KT + (tid + 512) * 16);
        R.ra = *(const u32x4v*)(g + GP_AM + tid * 16);
        R.rd = (u32x4v){0u, 0u, 0u, 0u};
        if (tid < 32) R.rd = *(const u32x4v*)(g + GP_DEC + tid * 16);
        const int tau = dir ? 4159 - (64 * n + lane) : 64 * n + lane;
        R.rv = (u32x4v){0u, 0u, 0u, 0u};
        if (tau >= 48) R.rv = *(const u32x4v*)(p.big + (size_t)(b * L + tau - 48) * INCP + C_V + hh * 256 + s * 64 + wid * 8);
    };
    auto STORE = [&](int buf, const RS& R) {
        unsigned char* base = sm + buf * BUF;
#pragma unroll
        for (int k = 0; k < 2; ++k) { const int c = tid + 512 * k;
            *(u32x4v*)(base + O_QS + ((c >> 4) * 136 + (c & 15) * 8) * 2) = R.rq[k];
            *(u32x4v*)(base + O_KT + ((c >> 3) * 72 + (c & 7) * 8) * 2) = R.rk[k]; }
        *(u32x4v*)(base + O_AS + ((tid >> 3) * 72 + (tid & 7) * 8) * 2) = R.ra;
        if (tid < 32) *(u32x4v*)(base + O_DEC + tid * 16) = R.rd;
        bf16_t* vt = (bf16_t*)(base + O_VT);
#pragma unroll
        for (int x = 0; x < 4; ++x) { vt[(wid * 8 + 2 * x) * 72 + lane] = (bf16_t)(R.rv[x] & 0xffffu); vt[(wid * 8 + 2 * x + 1) * 72 + lane] = (bf16_t)(R.rv[x] >> 16); }
    };
    f32x4 S[4];
#pragma unroll
    for (int e = 0; e < 4; ++e) S[e] = (f32x4){0.f, 0.f, 0.f, 0.f};
    for (int i = tid; i < 17408 / 16; i += 512) *(u32x4v*)(sm + O_ST + i * 16) = (u32x4v){0u, 0u, 0u, 0u};
    const bf16_t* ST = (const bf16_t*)(sm + O_ST);
    auto COMPUTE = [&](int n, int buf) {
        const unsigned char* base = sm + buf * BUF;
        const bf16_t* QS = (const bf16_t*)(base + O_QS); const bf16_t* KTS = (const bf16_t*)(base + O_KT); const bf16_t* AS = (const bf16_t*)(base + O_AS); const bf16_t* VT = (const bf16_t*)(base + O_VT);
        const int it = wid >> 1;
        pg8::bf16x8 fa[2], fq[4];
#pragma unroll
        for (int ks = 0; ks < 2; ++ks) fa[ks] = *(const pg8::bf16x8*)(AS + (16 * it + li) * 72 + 32 * ks + 8 * kq);
#pragma unroll
        for (int ks = 0; ks < 4; ++ks) fq[ks] = *(const pg8::bf16x8*)(QS + (16 * it + li) * 136 + 32 * ks + 8 * kq);
#pragma unroll
        for (int x = 0; x < 2; ++x) { const int et = (wid & 1) * 2 + x; f32x4 o = {0.f, 0.f, 0.f, 0.f};
#pragma unroll
            for (int ks = 0; ks < 2; ++ks) { const pg8::bf16x8 bb = *(const pg8::bf16x8*)(VT + (16 * et + li) * 72 + 32 * ks + 8 * kq);
                o = __builtin_amdgcn_mfma_f32_16x16x32_bf16(fa[ks], bb, o, 0, 0, 0); }
#pragma unroll
            for (int ks = 0; ks < 4; ++ks) { const pg8::bf16x8 bb = *(const pg8::bf16x8*)(ST + (16 * et + li) * 136 + 32 * ks + 8 * kq);
                o = __builtin_amdgcn_mfma_f32_16x16x32_bf16(fq[ks], bb, o, 0, 0, 0); }
#pragma unroll
            for (int r = 0; r < 4; ++r) { const int i = 16 * it + 4 * kq + r; const int tau = dir ? 4159 - (64 * n + i) : 64 * n + i;
                if (tau >= 48) outp[(size_t)(b * L + tau - 48) * 1024 + hh * 256 + s * 64 + 16 * et + li] = o[r]; } }
        { const f32x4 dec4 = *(const f32x4*)(base + O_DEC + (16 * wid + 4 * kq) * 4);
          pg8::bf16x8 fk[2];
#pragma unroll
          for (int ks = 0; ks < 2; ++ks) fk[ks] = *(const pg8::bf16x8*)(KTS + (16 * wid + li) * 72 + 32 * ks + 8 * kq);
#pragma unroll
          for (int et = 0; et < 4; ++et) { S[et] *= dec4;
#pragma unroll
              for (int ks = 0; ks < 2; ++ks) { const pg8::bf16x8 bb = *(const pg8::bf16x8*)(VT + (16 * et + li) * 72 + 32 * ks + 8 * kq);
                  S[et] = __builtin_amdgcn_mfma_f32_16x16x32_bf16(fk[ks], bb, S[et], 0, 0, 0); } } }
    };
    auto WRITE_ST = [&]() {
#pragma unroll
        for (int et = 0; et < 4; ++et) { u32x2v w; w[0] = pk2(S[et][0], S[et][1]); w[1] = pk2(S[et][2], S[et][3]);
            *(u32x2v*)(sm + O_ST + ((16 * et + li) * 136 + 16 * wid + 4 * kq) * 2) = w; }
    };
    RS R0, R1;
    LOAD(0, R0); STORE(0, R0); LOAD(1, R1);
    __syncthreads();
    for (int n = 0; n < 65; n += 2) {
        if (n + 2 < 65) LOAD(n + 2, R0);
        COMPUTE(n, 0);
        __syncthreads();
        WRITE_ST(); if (n + 1 < 65) STORE(1, R1);
        __syncthreads();
        if (n + 1 >= 65) break;
        if (n + 3 < 65) LOAD(n + 3, R1);
        COMPUTE(n + 1, 1);
        __syncthreads();
        WRITE_ST(); if (n + 2 < 65) STORE(0, R0);
        __syncthreads();
    }
}

__device__ void fin_item(const Params& p, int item) {
    const int wid = threadIdx.x >> 6, lane = threadIdx.x & 63, m = item * 8 + wid;
    bf16_t* yrow = p.y + (size_t)m * D;
    if (m >= M) { const u32x4v z = {0u, 0u, 0u, 0u};
#pragma unroll
        for (int i = 0; i < 4; ++i) *(u32x4v*)(yrow + (lane + 64 * i) * 8) = z;
        return; }
    const int c0 = lane * 16;
    {
      const int b = m >= L ? 1 : 0, t = m - b * L;
      float x0[16];
#pragma unroll
      for (int i = 0; i < 4; ++i) { const f32x4 cb = *(const f32x4*)(p.conv_b + c0 + 4 * i); x0[4 * i] = cb[0]; x0[4 * i + 1] = cb[1]; x0[4 * i + 2] = cb[2]; x0[4 * i + 3] = cb[3]; }
#pragma unroll
      for (int jj = 0; jj < 3; ++jj) { const int t2 = t + jj - 1;
          if (t2 >= 0 && t2 < L) { const bf16_t* row = p.big + (size_t)(b * L + t2) * INCP + c0; const u32x4v r0 = *(const u32x4v*)row, r1 = *(const u32x4v*)(row + 8);
#pragma unroll
              for (int i = 0; i < 4; ++i) { const f32x4 cw = *(const f32x4*)(p.conv_w + jj * 3072 + c0 + 4 * i); const unsigned lo = i < 2 ? r0[2 * i] : r1[2 * i - 4], hi = i < 2 ? r0[2 * i + 1] : r1[2 * i - 3];
                  x0[4 * i] += __uint_as_float(lo << 16) * cw[0]; x0[4 * i + 1] += __uint_as_float(lo & 0xffff0000u) * cw[1]; x0[4 * i + 2] += __uint_as_float(hi << 16) * cw[2]; x0[4 * i + 3] += __uint_as_float(hi & 0xffff0000u) * cw[3]; } } }
      const bf16_t* src = p.yc + (size_t)m * 1024 + c0; const u32x4v y0 = *(const u32x4v*)src, y1 = *(const u32x4v*)(src + 8);
      f32x4 v[4]; float ss = 0.f;
#pragma unroll
      for (int i = 0; i < 4; ++i) { const unsigned lo = i < 2 ? y0[2 * i] : y1[2 * i - 4], hi = i < 2 ? y0[2 * i + 1] : y1[2 * i - 3];
          v[i][0] = __uint_as_float(lo << 16) * x0[4 * i]; v[i][1] = __uint_as_float(lo & 0xffff0000u) * x0[4 * i + 1]; v[i][2] = __uint_as_float(hi << 16) * x0[4 * i + 2]; v[i][3] = __uint_as_float(hi & 0xffff0000u) * x0[4 * i + 3];
          ss += (v[i][0] * v[i][0] + v[i][1] * v[i][1]) + (v[i][2] * v[i][2] + v[i][3] * v[i][3]); }
      ss += __shfl_xor(ss, 1); ss += __shfl_xor(ss, 2); ss += __shfl_xor(ss, 4);
      const float r = rsqrtf(ss * (1.0f / 128.0f) + EPS);
      u32x4v w0, w1;
#pragma unroll
      for (int i = 0; i < 4; ++i) { const f32x4 g = *(const f32x4*)(p.hyena_norm + c0 + 4 * i); const f32x4 o = v[i] * r * g;
          if (i < 2) { w0[2 * i] = pk2(o[0], o[1]); w0[2 * i + 1] = pk2(o[2], o[3]); } else { w1[2 * i - 4] = pk2(o[0], o[1]); w1[2 * i - 3] = pk2(o[2], o[3]); } }
      *(u32x4v*)(yrow + c0) = w0; *(u32x4v*)(yrow + c0 + 8) = w1; }
    { const float* s1 = p.of + (size_t)m * 1024 + c0; const float* s2 = p.ob + (size_t)m * 1024 + c0; f32x4 v[4]; float ss = 0.f;
#pragma unroll
      for (int i = 0; i < 4; ++i) { v[i] = *(const f32x4*)(s1 + 4 * i) + *(const f32x4*)(s2 + 4 * i); ss += (v[i][0] * v[i][0] + v[i][1] * v[i][1]) + (v[i][2] * v[i][2] + v[i][3] * v[i][3]); }
      ss += __shfl_xor(ss, 1); ss += __shfl_xor(ss, 2); ss += __shfl_xor(ss, 4); ss += __shfl_xor(ss, 8);
      const float r = rsqrtf(ss * (1.0f / 256.0f) + EPS);
      const bf16_t* og = p.big + (size_t)m * INCP + C_OG + c0;
      const u32x4v g0 = *(const u32x4v*)og, g1 = *(const u32x4v*)(og + 8);
      float ogf[16];
#pragma unroll
      for (int i = 0; i < 4; ++i) { ogf[2 * i] = __uint_as_float(g0[i] << 16); ogf[2 * i + 1] = __uint_as_float(g0[i] & 0xffff0000u); ogf[8 + 2 * i] = __uint_as_float(g1[i] << 16); ogf[8 + 2 * i + 1] = __uint_as_float(g1[i] & 0xffff0000u); }
      u32x4v w0, w1;
#pragma unroll
      for (int i = 0; i < 4; ++i) { const f32x4 g = *(const f32x4*)(p.gla_norm + ((c0 + 4 * i) & 255)); f32x4 o = v[i] * r * g;
          o[0] *= silu_f(ogf[4 * i]); o[1] *= silu_f(ogf[4 * i + 1]); o[2] *= silu_f(ogf[4 * i + 2]); o[3] *= silu_f(ogf[4 * i + 3]);
          if (i < 2) { w0[2 * i] = pk2(o[0], o[1]); w0[2 * i + 1] = pk2(o[2], o[3]); } else { w1[2 * i - 4] = pk2(o[0], o[1]); w1[2 * i - 3] = pk2(o[2], o[3]); } }
      *(u32x4v*)(yrow + 1024 + c0) = w0; *(u32x4v*)(yrow + 1024 + c0 + 8) = w1; }
}

__device__ void final_item(const Params& p, int item) {
    const int wid = threadIdx.x >> 6, lane = threadIdx.x & 63, row = item * 8 + wid, b = row >> 12, s = row & 4095, m = b * L + NMETA + s;
    const float* hrow = p.h + (size_t)m * D; float* orow = p.out + (size_t)row * D; f32x4 v[8]; float ss = 0.f;
#pragma unroll
    for (int i = 0; i < 8; ++i) { v[i] = *(const f32x4*)(hrow + (lane + 64 * i) * 4); ss += (v[i][0] * v[i][0] + v[i][1] * v[i][1]) + (v[i][2] * v[i][2] + v[i][3] * v[i][3]); }
    ss = wave_sum(ss); const float r = rsqrtf(ss * (1.0f / D) + EPS);
#pragma unroll
    for (int i = 0; i < 8; ++i) { const int c = (lane + 64 * i) * 4; *(f32x4*)(orow + c) = v[i] * r * *(const f32x4*)(p.final_norm + c); }
}

template <class TEpi> __device__ __forceinline__ void tail_tile(const bf16_t* A, int arow0, const bf16_t* Bt, int brow0, int brow1, const int K, float* red, const TEpi& E, int c) {
    const int tid = threadIdx.x, wid = tid >> 6, lane = tid & 63, li = lane & 15, kq = lane >> 4;
    const int kw = K >> 3, k0 = wid * kw;
    const bf16_t* ap = A + (size_t)(arow0 + li) * K + k0 + 8 * kq;
    const bf16_t* bp0 = Bt + (size_t)(brow0 + li) * K + k0 + 8 * kq;
    const bf16_t* bp1 = Bt + (size_t)(brow1 + li) * K + k0 + 8 * kq;
    f32x4 acc[2][4];
#pragma unroll
    for (int x = 0; x < 2; ++x)
#pragma unroll
        for (int y = 0; y < 4; ++y) acc[x][y] = (f32x4){0.f, 0.f, 0.f, 0.f};
#pragma unroll 4
    for (int k = 0; k < kw; k += 32) {
        pg8::bf16x8 a[2], bfr[4];
        a[0] = *(const pg8::bf16x8*)(ap + k); a[1] = *(const pg8::bf16x8*)(ap + (size_t)16 * K + k);
        bfr[0] = *(const pg8::bf16x8*)(bp0 + k); bfr[1] = *(const pg8::bf16x8*)(bp0 + (size_t)16 * K + k);
        bfr[2] = *(const pg8::bf16x8*)(bp1 + k); bfr[3] = *(const pg8::bf16x8*)(bp1 + (size_t)16 * K + k);
#pragma unroll
        for (int x = 0; x < 2; ++x)
#pragma unroll
            for (int y = 0; y < 4; ++y) acc[x][y] = __builtin_amdgcn_mfma_f32_16x16x32_bf16(bfr[y], a[x], acc[x][y], 0, 0, 0);
    }
#pragma unroll
    for (int x = 0; x < 2; ++x)
#pragma unroll
        for (int y = 0; y < 4; ++y) *(f32x4*)(red + wid * 2048 + (16 * x + li) * 64 + 16 * y + 4 * kq) = acc[x][y];
    __syncthreads();
    { const int row = tid >> 4, col4 = (tid & 15) * 4; f32x4 v = {0.f, 0.f, 0.f, 0.f};
#pragma unroll
      for (int w = 0; w < 8; ++w) v += *(const f32x4*)(red + w * 2048 + row * 64 + col4);
      E(arow0 + row, c, col4, v); }
    __syncthreads();
}
struct TEpiResid {
    float* H; bf16_t* HB; float* rowss; float scale;
    __device__ __forceinline__ void operator()(int r, int c, int col4, f32x4 v) const {
        float* hp = H + (size_t)r * D + c * 64 + col4; f32x4 a = *(const f32x4*)hp; a += v * scale; *(f32x4*)hp = a;
        float ss = (a[0] * a[0] + a[1] * a[1]) + (a[2] * a[2] + a[3] * a[3]);
        ss += __shfl_xor(ss, 1); ss += __shfl_xor(ss, 2); ss += __shfl_xor(ss, 4); ss += __shfl_xor(ss, 8);
        if (HB) { u32x2v w; w[0] = pk2(a[0], a[1]); w[1] = pk2(a[2], a[3]); *(u32x2v*)(HB + (size_t)r * D + c * 64 + col4) = w; }
        if (rowss && (threadIdx.x & 15) == 0) rowss[(size_t)r * 32 + c] = ss;
    }
};
struct TEpiScale {
    bf16_t* O; int ldc; const float* rowss;
    __device__ __forceinline__ void operator()(int r, int c, int col4, f32x4 v) const {
        const int l = threadIdx.x & 15; float s = rowss[(size_t)r * 32 + 2 * l] + rowss[(size_t)r * 32 + 2 * l + 1];
        s += __shfl_xor(s, 1); s += __shfl_xor(s, 2); s += __shfl_xor(s, 4); s += __shfl_xor(s, 8);
        const float rs = rsqrtf(s * (1.0f / D) + EPS);
        u32x2v w; w[0] = pk2(v[0] * rs, v[1] * rs); w[1] = pk2(v[2] * rs, v[3] * rs); *(u32x2v*)(O + (size_t)r * ldc + c * 64 + col4) = w;
    }
};

template <class Epi> __device__ __forceinline__ void run_gemm(PG8_LAS unsigned char* lds, const bf16_t* A, const bf16_t* Bt, int Mr, int N, int K, const Epi& E) {
    pg8::Gemm g; g.A = A; g.Bt = Bt; g.M = Mr; g.N = N; g.K = K;
    pg8::StaticOrder S; S.init(Mr, N, (int)gridDim.x, (int)blockIdx.x);
    pg8::gemm_phase<Epi, pg8::StaticOrder>(lds, g, S, E);
}

typedef const __attribute__((address_space(4))) Params* KParams;
#if defined(__HIP_DEVICE_COMPILE__)
#define LOADP() Params p; { KParams q_ = kp; asm volatile("" : "+s"(q_)); p = *q_; }
#else
#define LOADP() Params p = p_unused; (void)kp;
#endif
#define MARK(i) do { if (PROBE_MASK) { const unsigned long long t_ = wall_clock64(); if ((PROBE_MASK >> (i)) & 1u) t_acc += t_ - t_last; t_last = t_; } } while (0)
__global__ __launch_bounds__(512, 2) void mega(Params p_unused) {
    KParams kp = (KParams)__builtin_amdgcn_kernarg_segment_ptr();
    unsigned long long t_acc = 0ull, t_last = PROBE_MASK ? wall_clock64() : 0ull;
    extern __shared__ __attribute__((aligned(16))) unsigned char smem[];
    cg::grid_group grid = cg::this_grid();
    PG8_LAS unsigned char* lds = (PG8_LAS unsigned char*)smem;
    float* smf = (float*)smem;
    const int G = gridDim.x, bid = blockIdx.x;
    { LOADP();
      transpose_mat(p.ffn1_wg, p.Wgu1, p.ffn1_norm, D, DFF, DFF, DFF, 1, smf);
      transpose_mat(p.ffn1_wu, p.Wgu1, p.ffn1_norm, D, DFF, DFF, DFF, 2, smf);
      transpose_mat(p.ffn1_wd, p.Wd1, nullptr, DFF, D, D, D, 0, smf); }
    { LOADP();
      transpose_mat(p.w_in, p.Win, p.mix_norm, D, INCP, INC, INC, 0, smf);
      transpose_mat(p.w_out, p.Wout, nullptr, D, D, D, D, 0, smf); }
    { LOADP();
      transpose_mat(p.ffn2_wg, p.Wgu2, p.ffn2_norm, D, DFF, DFF, DFF, 1, smf);
      transpose_mat(p.ffn2_wu, p.Wgu2, p.ffn2_norm, D, DFF, DFF, DFF, 2, smf);
      transpose_mat(p.ffn2_wd, p.Wd2, nullptr, DFF, D, D, D, 0, smf); }
    { LOADP();
      if (bid == 0 && threadIdx.x == 0) *p.ctr = 0u;
      for (int it = bid; it < NT_ROWS + NT_Z2; it += G) { if (it < NT_ROWS) row_item(p, it); else z2_item(p, it - NT_ROWS); } }
    grid.sync(); MARK(0);
    { LOADP(); EpiSwiglu E; E.O = p.big; E.rowss = p.rowss; run_gemm(lds, p.hb, p.Wgu1, MP, 2 * DFF, D, E); }
    grid.sync(); MARK(1);
    { LOADP(); EpiResid<true> E; E.H = p.h; E.HB = p.hb; E.rowss = p.rowss; E.scale = 0.5f; run_gemm(lds, p.big, p.Wd1, 8192, D, DFF, E); }
    { LOADP(); TEpiResid T; T.H = p.h; T.HB = p.hb; T.rowss = p.rowss; T.scale = 0.5f;
      for (int c = bid; c < 32; c += G) tail_tile(p.big, 8192, p.Wd1, 64 * c, 64 * c + 32, DFF, smf, T, c); }
    grid.sync(); MARK(2);
    { LOADP(); EpiScale E; E.O = p.big; E.ldc = INCP; E.rowss = p.rowss; run_gemm(lds, p.hb, p.Win, 8192, 6144, D, E); }
    { LOADP(); TEpiScale T; T.O = p.big; T.ldc = INCP; T.rowss = p.rowss;
      for (int it = bid; it < 97 + 256; it += G) { if (it < 97) tail_tile(p.hb, 8192, p.Win, 64 * it, 64 * it + 32, D, smf, T, it); else tail_tile(p.hb, 32 * (it - 97), p.Win, 6144, 6176, D, smf, T, 96); } }
    grid.sync(); MARK(3);
    { LOADP(); for (int it = bid; it < 1040 + 520; it += G) { if (it < 1040) gla_pre(p, it, smem); else hyu_item(p, it - 1040, smem); } }
    grid.sync(); MARK(4);
    { LOADP(); if (bid < 64) gla_scan(p, bid, smem); }
    { LOADP();
      for (;;) {
        if (threadIdx.x == 0) *(int*)(smem + HY_ZERO_OFF + 192) = (int)atomicAdd(p.ctr, 1u);
        __syncthreads();
        const int g = *(const int*)(smem + HY_ZERO_OFF + 192);
        __syncthreads();
        if (g >= 256) break;
        hyena_group(p, (g & 7) * 32 + (g >> 3), smem, t_acc);
      } }
    grid.sync(); MARK(5);
    { LOADP(); for (int it = bid; it < MP / 8; it += G) fin_item(p, it); }
    grid.sync(); MARK(6);
    { LOADP(); EpiResid<true> E; E.H = p.h; E.HB = p.hb; E.rowss = p.rowss; E.scale = 1.0f; run_gemm(lds, p.y, p.Wout, 8192, D, D, E); }
    { LOADP(); TEpiResid T; T.H = p.h; T.HB = p.hb; T.rowss = p.rowss; T.scale = 1.0f;
      for (int c = bid; c < 32; c += G) tail_tile(p.y, 8192, p.Wout, 64 * c, 64 * c + 32, D, smf, T, c); }
    grid.sync(); MARK(7);
    { LOADP(); EpiSwiglu E; E.O = p.big; E.rowss = p.rowss; run_gemm(lds, p.hb, p.Wgu2, MP, 2 * DFF, D, E); }
    grid.sync(); MARK(8);
    { LOADP(); EpiResid<false> E; E.H = p.h; E.HB = nullptr; E.rowss = nullptr; E.scale = 0.5f; run_gemm(lds, p.big, p.Wd2, 8192, D, DFF, E); }
    { LOADP(); TEpiResid T; T.H = p.h; T.HB = nullptr; T.rowss = nullptr; T.scale = 0.5f;
      for (int c = bid; c < 32; c += G) tail_tile(p.big, 8192, p.Wd2, 64 * c, 64 * c + 32, DFF, smf, T, c); }
    grid.sync(); MARK(9);
    { LOADP(); for (int it = bid; it < 1024; it += G) final_item(p, it); }
    MARK(10);
    if (PROBE_MASK && bid == 0) { const unsigned long long t0_ = wall_clock64(); while (wall_clock64() - t0_ < (unsigned long long)PROBE_K * t_acc) __builtin_amdgcn_s_sleep(8); }
}

extern "C" void kernel_launch(void* const* d_in, const int* in_sizes, int n_in, void* d_out, int out_size, void* d_ws, size_t ws_size, hipStream_t stream) {
    static int grid_blocks = 0;
    if (!grid_blocks) {
        (void)hipFuncSetAttribute((const void*)mega, hipFuncAttributeMaxDynamicSharedMemorySize, LDS_BYTES);
        int dev = 0, cus = 0, per_cu = 0;
        (void)hipGetDevice(&dev);
        (void)hipDeviceGetAttribute(&cus, hipDeviceAttributeMultiprocessorCount, dev);
        (void)hipOccupancyMaxActiveBlocksPerMultiprocessor(&per_cu, mega, 512, LDS_BYTES);
        if (per_cu > 1) per_cu = 1;
        if (per_cu < 1) { fprintf(stderr, "occupancy query returned %d\n", per_cu); per_cu = 1; }
        grid_blocks = cus * per_cu;
    }
    Params p{};
    const float* const* in = (const float* const*)d_in;
    p.x = in[0]; p.meta = in[1]; p.ffn1_norm = in[2]; p.ffn1_wg = in[3]; p.ffn1_wu = in[4]; p.ffn1_wd = in[5]; p.mix_norm = in[6]; p.w_in = in[7];
    p.conv_w = in[8]; p.conv_b = in[9]; p.filt_w1 = in[10]; p.filt_b1 = in[11]; p.filt_w2 = in[12]; p.filt_b2 = in[13]; p.filt_w3 = in[14]; p.filt_freq = in[15];
    p.hyena_d = in[16]; p.hyena_norm = in[17]; p.gk_w2 = in[18]; p.gk_b2 = in[19]; p.gla_norm = in[20]; p.w_out = in[21];
    p.ffn2_norm = in[22]; p.ffn2_wg = in[23]; p.ffn2_wu = in[24]; p.ffn2_wd = in[25]; p.final_norm = in[26];
    p.out = (float*)d_out;
    unsigned char* ws = (unsigned char*)d_ws;
    constexpr size_t SZ_WGU = (size_t)2 * DFF * D * 2, SZ_WD = (size_t)D * DFF * 2, SZ_WIN = (size_t)INCP * D * 2, SZ_WOUT = (size_t)D * D * 2;
    constexpr size_t SZ_H = (size_t)MP * D * 4, SZ_HB = (size_t)MP * D * 2, SZ_BIG = (size_t)MP * INCP * 2, SZ_RS = (size_t)MP * 32 * 4, SZ_Z2 = (size_t)L * 64 * 4;
    size_t o = 0;
    p.Wgu1 = (bf16_t*)(ws + o); o += SZ_WGU; p.Wd1 = (bf16_t*)(ws + o); o += SZ_WD; p.Win = (bf16_t*)(ws + o); o += SZ_WIN; p.Wout = (bf16_t*)(ws + o); o += SZ_WOUT;
    p.Wgu2 = (bf16_t*)(ws + o); o += SZ_WGU; p.Wd2 = (bf16_t*)(ws + o); o += SZ_WD;
    p.h = (float*)(ws + o); o += SZ_H; p.hb = (bf16_t*)(ws + o); o += SZ_HB; p.big = (bf16_t*)(ws + o); o += SZ_BIG; p.rowss = (float*)(ws + o); o += SZ_RS; p.z2 = (float*)(ws + o); o += SZ_Z2; p.ctr = (unsigned*)(ws + o); o += 256;
    p.yc = (bf16_t*)ws; p.y = (bf16_t*)(ws + (size_t)M * 1024 * 2); p.of = (float*)p.hb; p.ob = (float*)d_out; p.gp = ws + (size_t)M * 1024 * 2; p.uT = (bf16_t*)((unsigned char*)d_out + (size_t)M * 1024 * 4);
    if (o > ws_size) fprintf(stderr, "workspace too small: need %zu have %zu\n", o, ws_size);
    void* args[] = {&p};
    hipError_t e = hipLaunchCooperativeKernel((void*)mega, dim3(grid_blocks), dim3(512), args, LDS_BYTES, stream);
    if (e != hipSuccess) fprintf(stderr, "cooperative launch failed: %s (grid %d)\n", hipGetErrorString(e), grid_blocks);
}
```

```cpp
#include <hip/hip_runtime.h>
#include <hip/hip_cooperative_groups.h>
#include <cstdio>
namespace cg = cooperative_groups;
namespace pg8 {
#define PG8_LAS __attribute__((address_space(3)))
typedef unsigned short bf16_t;
typedef short bf16x8 __attribute__((ext_vector_type(8)));
typedef float f32x4 __attribute__((ext_vector_type(4)));
typedef unsigned u32x4 __attribute__((ext_vector_type(4)));
constexpr int BM = 256, BK = 64, HALF = 128, HTB = HALF * BK * 2  , STAGE_BYTES = 8 * HTB, NXCD = 8, WGM = 8;

__host__ __device__ __forceinline__ int lds_byte(int r, int c) { const int st = (r >> 4) * 2 + (c >> 5), rr = r & 15, cc = c & 31, ob = rr * 64 + cc * 2; return st * 1024 + (ob ^ (((ob >> 9) & 1) << 5)); }
__host__ __device__ __forceinline__ void stage_rc(int b, int& R, int& C) { const int st = b / 1024, sb = b % 1024, swz = sb ^ (((sb >> 9) & 1) << 5); R = (st >> 1) * 16 + swz / 64; C = (st & 1) * 32 + (swz % 64) / 2; }
__host__ __device__ __forceinline__ int perm32(int rho) { const int n = rho >> 4, i = rho & 15; return 8 * (i >> 2) + 4 * n + (i & 3); }

struct Unit { int pm, pn; };
struct Gemm { const bf16_t* A; const bf16_t* Bt; int M, N, K; };

struct StaticOrder {
    int nM, nN, nwg, G, c;
    __host__ __device__ void init(int M, int N, int G_, int c_) { nM = M / BM; nN = N / BM; nwg = nM * nN; G = G_; c = c_; }
    __host__ __device__ bool next(int i, Unit& u) const {
        const long L = (long)i * G + c; if (L >= nwg) return false;
        int wgid = (int)L; { const int q = nwg / NXCD, r = nwg % NXCD, xcd = wgid % NXCD, off = wgid / NXCD; wgid = (xcd < r ? xcd * (q + 1) : r * (q + 1) + (xcd - r) * q) + off; }
        const int nig = WGM * nN, gid = wgid / nig, fm = gid * WGM, gsz = (nM - fm) < WGM ? (nM - fm) : WGM;
        u.pm = fm + ((wgid % nig) % gsz); u.pn = (wgid % nig) / gsz; return true;
    }
    __device__ __forceinline__ void a_ready(const Unit&) const {}
    __device__ __forceinline__ void done(const Unit&) const {}
};
__device__ __forceinline__ unsigned cvt_pk_bf16(float lo, float hi) { unsigned r; asm volatile("v_cvt_pk_bf16_f32 %0, %1, %2" : "=v"(r) : "v"(lo), "v"(hi)); return r; }
template <class Epi, class Sched>
__device__ __forceinline__ void gemm_phase(PG8_LAS unsigned char* lds, const Gemm g, const Sched& S, const Epi& E, const int tid_in) {
    const int tid = tid_in, wid = __builtin_amdgcn_readfirstlane(tid >> 6), lane = tid & 63, wr = wid >> 2, wc = wid & 3, fr = lane & 15, fq = lane >> 4;
    const int K = g.K, nt = K / BK;
    unsigned voffA[2], voffB[2];
#pragma unroll
    for (int i = 0; i < 2; ++i) { int R, C; stage_rc(tid * 16 + i * 8192, R, C); const int Rb = Epi::PERM ? ((R & ~31) + perm32(R & 31)) : R;
        voffA[i] = (unsigned)(R * K + C) * 2u; voffB[i] = (unsigned)(Rb * K + C) * 2u; }
    const size_t kstep = (size_t)(BK * 2);
    const size_t hstep = (size_t)HALF * K * 2;
    const size_t tstep = 2 * hstep;
    const unsigned ldsw = (unsigned)wid * 1024u;
    const int aoff = lds_byte(wr * 64 + fr, fq * 8), boff = lds_byte(wc * 32 + fr, fq * 8);
#define PG8_SA(b, h) (((b) * 2 + (h)) * HTB)
#define PG8_SB(b, h) ((4 + (b) * 2 + (h)) * HTB)
#define PG8_STAGE(bufoff, gbase, voff) do { _Pragma("unroll") for (int _i = 0; _i < 2; ++_i) \
        __builtin_amdgcn_global_load_lds((const unsigned*)((const char*)(gbase) + (voff)[_i]), (PG8_LAS unsigned*)(lds + (bufoff) + ldsw + _i * 8192), 16, 0, 0); } while (0)
#define PG8_LDA(dst, b, h) do { _Pragma("unroll") for (int m = 0; m < 4; ++m) _Pragma("unroll") for (int k = 0; k < 2; ++k) dst[m][k] = *(const PG8_LAS bf16x8*)(lds + PG8_SA(b, h) + aoff + m * 2048 + k * 1024); } while (0)
#define PG8_LDB(dst, b, h) do { _Pragma("unroll") for (int n = 0; n < 2; ++n) _Pragma("unroll") for (int k = 0; k < 2; ++k) dst[n][k] = *(const PG8_LAS bf16x8*)(lds + PG8_SB(b, h) + boff + n * 2048 + k * 1024); } while (0)
#define PG8_MMA(ai, bj, At, Bt) do { __builtin_amdgcn_s_setprio(1); _Pragma("unroll") for (int m = 0; m < 4; ++m) _Pragma("unroll") for (int n = 0; n < 2; ++n) _Pragma("unroll") for (int k = 0; k < 2; ++k) \
        acc[ai][bj][m][n] = __builtin_amdgcn_mfma_f32_16x16x32_bf16(Bt[n][k], At[m][k], acc[ai][bj][m][n], 0, 0, 0); __builtin_amdgcn_s_setprio(0); } while (0)
#define PG8_WAIT_V(n) asm volatile("s_waitcnt vmcnt(" #n ")" ::: "memory")
#define PG8_WAIT_L(n) asm volatile("s_waitcnt lgkmcnt(" #n ")" ::: "memory")
#define PG8_BAR __builtin_amdgcn_s_barrier()
#define PG8_SCHED __builtin_amdgcn_sched_barrier(0)
    Unit cur, nxt; int ui = 0;
    if (!S.next(0, cur)) return;
    f32x4 acc[2][2][4][2];
#pragma unroll
    for (int a = 0; a < 2; ++a)
#pragma unroll
        for (int b = 0; b < 2; ++b)
#pragma unroll
            for (int m = 0; m < 4; ++m)
#pragma unroll
                for (int n = 0; n < 2; ++n) acc[a][b][m][n] = (f32x4){0.f, 0.f, 0.f, 0.f};
    bf16x8 At[4][2], B0[2][2], B1[2][2];
    const char* cA = (const char*)g.A + (size_t)cur.pm * tstep; const char* cB = (const char*)g.Bt + (size_t)cur.pn * tstep;
    S.a_ready(cur);
    PG8_STAGE(PG8_SB(0, 0), cB, voffB); PG8_STAGE(PG8_SA(0, 0), cA, voffA); PG8_STAGE(PG8_SB(0, 1), cB + hstep, voffB); PG8_STAGE(PG8_SA(0, 1), cA + hstep, voffA);
    if (wr == 1) PG8_BAR;
    PG8_WAIT_V(4); PG8_BAR;
    PG8_STAGE(PG8_SB(1, 0), cB + kstep, voffB); PG8_STAGE(PG8_SA(1, 0), cA + kstep, voffA); PG8_STAGE(PG8_SB(1, 1), cB + hstep + kstep, voffB);
    PG8_WAIT_V(6); PG8_BAR;
    for (;;) {
        const bool has_next = S.next(ui + 1, nxt);
        const char* nA = has_next ? (const char*)g.A + (size_t)nxt.pm * tstep : cA; const char* nB = has_next ? (const char*)g.Bt + (size_t)nxt.pn * tstep : cB;
        for (int t = 0; t < nt; t += 2) {
            const bool last = (t == nt - 2);
            const char* a1 = cA + (size_t)(t + 1) * kstep;
            const char* a2 = last ? nA : cA + (size_t)(t + 2) * kstep; const char* b2 = last ? nB : cB + (size_t)(t + 2) * kstep;
            const char* a3 = a2 + kstep; const char* b3 = b2 + kstep;
            if (last && has_next) S.a_ready(nxt);
            PG8_LDB(B0, 0, 0); PG8_SCHED; PG8_LDA(At, 0, 0); PG8_STAGE(PG8_SA(1, 1), a1 + hstep, voffA);
            PG8_WAIT_L(8); PG8_BAR; PG8_WAIT_L(0); PG8_MMA(0, 0, At, B0); PG8_BAR; PG8_SCHED;
            PG8_LDB(B1, 0, 1); PG8_STAGE(PG8_SB(0, 0), b2, voffB);
            PG8_BAR; PG8_WAIT_L(0); PG8_MMA(0, 1, At, B1); PG8_BAR;
            PG8_LDA(At, 0, 1); PG8_STAGE(PG8_SA(0, 0), a2, voffA);
            PG8_BAR; PG8_WAIT_L(0); PG8_MMA(1, 0, At, B0); PG8_BAR; PG8_SCHED;
            PG8_STAGE(PG8_SB(0, 1), b2 + hstep, voffB);
            PG8_WAIT_V(6); PG8_BAR; PG8_MMA(1, 1, At, B1); PG8_BAR;
            PG8_LDB(B0, 1, 0); PG8_SCHED; PG8_LDA(At, 1, 0); PG8_STAGE(PG8_SA(0, 1), a2 + hstep, voffA);
            PG8_WAIT_L(8); PG8_BAR; PG8_WAIT_L(0); PG8_MMA(0, 0, At, B0); PG8_BAR; PG8_SCHED;
            PG8_LDB(B1, 1, 1); PG8_STAGE(PG8_SB(1, 0), b3, voffB);
            PG8_BAR; PG8_WAIT_L(0); PG8_MMA(0, 1, At, B1); PG8_BAR;
            PG8_LDA(At, 1, 1); PG8_STAGE(PG8_SA(1, 0), a3, voffA);
            PG8_BAR; PG8_WAIT_L(0); PG8_MMA(1, 0, At, B0); PG8_BAR; PG8_SCHED;
            PG8_STAGE(PG8_SB(1, 1), b3 + hstep, voffB);
            PG8_WAIT_V(6); PG8_BAR; PG8_MMA(1, 1, At, B1); PG8_BAR;
        }
        if constexpr (!Epi::AFTER_DRAIN) { E(acc, cur, wr, wc, fr, fq); S.done(cur); }
        if (!has_next) break;
#pragma unroll
        for (int a = 0; a < 2; ++a)
#pragma unroll
            for (int b = 0; b < 2; ++b)
#pragma unroll
                for (int m = 0; m < 4; ++m)
#pragma unroll
                    for (int n = 0; n < 2; ++n) acc[a][b][m][n] = (f32x4){0.f, 0.f, 0.f, 0.f};
        cur = nxt; cA = nA; cB = nB; ++ui;
    }
    PG8_WAIT_V(0);
    if (wr == 0) PG8_BAR;
    PG8_BAR;
    if constexpr (Epi::AFTER_DRAIN) { E.fused(acc, cur, wr, wc, fr, fq, lds, wid, lane); S.done(cur); }
#undef PG8_SA
#undef PG8_SB
#undef PG8_STAGE
#undef PG8_LDA
#undef PG8_LDB
#undef PG8_MMA
#undef PG8_WAIT_V
#undef PG8_WAIT_L
#undef PG8_BAR
#undef PG8_SCHED
}
}

#include <cstdio>
#include <ctime>
#include <cstdlib>
#include <cstring>
#include <cmath>
#include <vector>
#include <algorithm>

using pg8::bf16_t; using pg8::f32x4; using pg8::Unit;
typedef unsigned u32x2v __attribute__((ext_vector_type(2)));
typedef unsigned u32x4v __attribute__((ext_vector_type(4)));

constexpr int D = 2048, SEQ = 4096, NMETA = 16, L = 4112, M = 8224, MP = 8448, DFF = 5632, INC = 6176, INCP = 6400;
constexpr float EPS = 1e-6f;
constexpr int LDS_BYTES = 4 * (8336 * 2 + 2 * 65 * 144) + 256;
constexpr unsigned PROBE_MASK = 0u; constexpr int PROBE_K = 8;
constexpr int C_Q = 3072, C_K = 3584, C_V = 4096, C_OG = 5120, C_LR = 6144;

struct Params {
    const float *x, *meta, *ffn1_norm, *ffn1_wg, *ffn1_wu, *ffn1_wd, *mix_norm, *w_in, *conv_w, *conv_b,
        *filt_w1, *filt_b1, *filt_w2, *filt_b2, *filt_w3, *filt_freq, *hyena_d, *hyena_norm, *gk_w2, *gk_b2, *gla_norm, *w_out,
        *ffn2_norm, *ffn2_wg, *ffn2_wu, *ffn2_wd, *final_norm;
    float* out;
    bf16_t *Wgu1, *Wd1, *Win, *Wout, *Wgu2, *Wd2;
    float* h; bf16_t* hb; bf16_t* big; float* rowss; float* z2;
    bf16_t* y; bf16_t* yc; float* of; float* ob; unsigned char* gp; unsigned* ctr; bf16_t* uT; bf16_t* ZA; bf16_t* WB; bf16_t* GF; float* G0; unsigned* bar; int wave; int pad_;
};

__device__ __forceinline__ int lane_id() { return (int)__builtin_amdgcn_mbcnt_hi(~0u, __builtin_amdgcn_mbcnt_lo(~0u, 0u)); }
__device__ __forceinline__ int ltid_w(int wave) { int t = (wave << 6) | lane_id(); asm volatile("" : "+v"(t)); return t; }
__device__ __forceinline__ void lds_barrier() { asm volatile("s_waitcnt lgkmcnt(0)" ::: "memory"); __builtin_amdgcn_s_barrier(); asm volatile("" ::: "memory"); }
__device__ __forceinline__ float bf2f(bf16_t b) { return __uint_as_float(((unsigned)b) << 16); }
__device__ __forceinline__ unsigned pk2(float lo, float hi) { return pg8::cvt_pk_bf16(lo, hi); }
__device__ __forceinline__ bf16_t f2bf(float v) { return (bf16_t)(pk2(v, 0.f) & 0xffffu); }
template <int MSK> __device__ __forceinline__ float shx(float v) {
    if constexpr (MSK < 32) return __int_as_float(__builtin_amdgcn_ds_swizzle(__float_as_int(v), 0x1f | (MSK << 10)));
    else { int l = lane_id(); asm volatile("" : "+v"(l)); return __int_as_float(__builtin_amdgcn_ds_bpermute((l ^ 32) << 2, __float_as_int(v))); }
}
__device__ __forceinline__ float wave_sum(float v) { v += shx<32>(v); v += shx<16>(v); v += shx<8>(v); v += shx<4>(v); v += shx<2>(v); v += shx<1>(v); return v; }
__device__ __forceinline__ float silu_f(float x) { return x * __builtin_amdgcn_rcpf(1.0f + __expf(-x)); }

__device__ __forceinline__ float row_rscale(const float* rowss, int r, int fq) {
    const f32x4* q = (const f32x4*)(rowss + (size_t)r * 32 + fq * 8);
    const f32x4 a = q[0], b = q[1];
    float s = ((a[0] + a[1]) + (a[2] + a[3])) + ((b[0] + b[1]) + (b[2] + b[3]));
    s += shx<16>(s); s += shx<32>(s);
    return rsqrtf(s * (1.0f / D) + EPS);
}

struct EpiSwiglu {
    static constexpr bool PERM = true, AFTER_DRAIN = false;
    bf16_t* O; const float* rowss;
    __device__ __forceinline__ void operator()(const f32x4 (&acc)[2][2][4][2], const Unit& u, int wr, int wc, int fr, int fq) const {
        const int row0 = u.pm * 256 + wr * 64 + fr, col0 = u.pn * 128 + wc * 32 + 8 * fq;
#pragma unroll
        for (int ai = 0; ai < 2; ++ai)
#pragma unroll
            for (int m = 0; m < 4; ++m) {
                const int r = row0 + ai * 128 + m * 16; const float rs = row_rscale(rowss, r, fq);
                u32x4v w;
#pragma unroll
                for (int n = 0; n < 2; ++n) { const f32x4 g = acc[ai][0][m][n] * rs, uu = acc[ai][1][m][n] * rs;
                    w[2 * n] = pk2(silu_f(g[0]) * uu[0], silu_f(g[1]) * uu[1]); w[2 * n + 1] = pk2(silu_f(g[2]) * uu[2], silu_f(g[3]) * uu[3]); }
                *(u32x4v*)(O + (size_t)r * DFF + col0) = w;
            }
    }
};
struct EpiScale {
    static constexpr bool PERM = true, AFTER_DRAIN = false;
    bf16_t* O; int ldc; const float* rowss;
    __device__ __forceinline__ void operator()(const f32x4 (&acc)[2][2][4][2], const Unit& u, int wr, int wc, int fr, int fq) const {
        const int row0 = u.pm * 256 + wr * 64 + fr, col0 = u.pn * 256 + wc * 32 + 8 * fq;
#pragma unroll
        for (int ai = 0; ai < 2; ++ai)
#pragma unroll
            for (int m = 0; m < 4; ++m) {
                const int r = row0 + ai * 128 + m * 16; const float rs = row_rscale(rowss, r, fq);
#pragma unroll
                for (int bj = 0; bj < 2; ++bj) { const f32x4 a = acc[ai][bj][m][0] * rs, b = acc[ai][bj][m][1] * rs;
                    u32x4v w; w[0] = pk2(a[0], a[1]); w[1] = pk2(a[2], a[3]); w[2] = pk2(b[0], b[1]); w[3] = pk2(b[2], b[3]);
                    *(u32x4v*)(O + (size_t)r * ldc + col0 + bj * 128) = w; }
            }
    }
};
template <bool WHB> struct EpiResid {
    static constexpr bool PERM = true, AFTER_DRAIN = false;
    float* H; bf16_t* HB; float* rowss; float scale;
    __device__ __forceinline__ void operator()(const f32x4 (&acc)[2][2][4][2], const Unit& u, int wr, int wc, int fr, int fq) const {
        const int row0 = u.pm * 256 + wr * 64 + fr, col0 = u.pn * 256 + wc * 32 + 8 * fq;
#pragma unroll
        for (int ai = 0; ai < 2; ++ai)
#pragma unroll
            for (int m = 0; m < 4; ++m) {
                const int r = row0 + ai * 128 + m * 16; float ss = 0.f;
#pragma unroll
                for (int bj = 0; bj < 2; ++bj) { float* hp = H + (size_t)r * D + col0 + bj * 128;
                    f32x4 a = *(const f32x4*)hp, b = *(const f32x4*)(hp + 4);
                    a += acc[ai][bj][m][0] * scale; b += acc[ai][bj][m][1] * scale;
                    *(f32x4*)hp = a; *(f32x4*)(hp + 4) = b;
                    ss += (a[0] * a[0] + a[1] * a[1]) + (a[2] * a[2] + a[3] * a[3]) + (b[0] * b[0] + b[1] * b[1]) + (b[2] * b[2] + b[3] * b[3]);
                    if (WHB) { u32x4v w; w[0] = pk2(a[0], a[1]); w[1] = pk2(a[2], a[3]); w[2] = pk2(b[0], b[1]); w[3] = pk2(b[2], b[3]);
                        *(u32x4v*)(HB + (size_t)r * D + col0 + bj * 128) = w; } }
                ss += shx<16>(ss); ss += shx<32>(ss);
                if (WHB && fq == 0) rowss[(size_t)r * 32 + u.pn * 4 + wc] = ss;
            }
    }
};

constexpr int NT_FFN = 2816, NT_WIN = 3200, NT_WOUT = 1024, NT_TR = 6 * NT_FFN + NT_WIN + NT_WOUT, NT_ROWS = MP / 8, NT_Z2 = 4352 / 8, P0_ITEMS = NT_TR + NT_ROWS + NT_Z2;

__device__ __forceinline__ void transpose_mat(const float* src, bf16_t* dst, const float* gain, const int K, const int N, const int ld, const int nvalid, const int mode, float* tl, const int wave) {
    const int ntn = N / 64, ntiles = (K / 64) * ntn, tid = ltid_w(wave);
    for (int it = blockIdx.x; it < ntiles; it += gridDim.x) {
        const int kt = it / ntn, nt = it - kt * ntn, k0 = kt * 64, n0 = nt * 64;
        const long drow0 = mode == 0 ? n0 : (n0 / 128) * 256 + (n0 % 128) + (mode == 2 ? 128 : 0);
        { const int r = tid >> 4, c4 = (tid & 15) * 4;
#pragma unroll
          for (int i = 0; i < 2; ++i) { const int row = r + 32 * i, k = k0 + row, n = n0 + c4;
              f32x4 v = {0.f, 0.f, 0.f, 0.f};
              if (n < nvalid) v = *(const f32x4*)(src + (size_t)k * ld + n);
              const float g = gain ? gain[k] : 1.0f;
              float* t = tl + row * 65 + c4; t[0] = v[0] * g; t[1] = v[1] * g; t[2] = v[2] * g; t[3] = v[3] * g; } }
        lds_barrier();
        { const int n = tid >> 3, k8 = (tid & 7) * 8; float v[8];
#pragma unroll
          for (int j = 0; j < 8; ++j) v[j] = tl[(k8 + j) * 65 + n];
          u32x4v w; w[0] = pk2(v[0], v[1]); w[1] = pk2(v[2], v[3]); w[2] = pk2(v[4], v[5]); w[3] = pk2(v[6], v[7]);
          *(u32x4v*)(dst + (size_t)(drow0 + n) * K + k0 + k8) = w; }
        lds_barrier();
    }
}

__device__ void row_item(const Params& p, int item) {
    const int tid__ = ltid_w(p.wave), wid = tid__ >> 6, lane = tid__ & 63, m = item * 8 + wid;
    float* hrow = p.h + (size_t)m * D; bf16_t* hbrow = p.hb + (size_t)m * D;
    if (m < M) { const int b = m / L, t = m - b * L;
        const float* src = t < NMETA ? p.meta + (size_t)t * D : p.x + ((size_t)b * SEQ + t - NMETA) * D;
        float ss = 0.f;
#pragma unroll
        for (int i = 0; i < 8; ++i) { const int c = (lane + 64 * i) * 4; const f32x4 v = *(const f32x4*)(src + c);
            ss += (v[0] * v[0] + v[1] * v[1]) + (v[2] * v[2] + v[3] * v[3]);
            *(f32x4*)(hrow + c) = v; u32x2v w; w[0] = pk2(v[0], v[1]); w[1] = pk2(v[2], v[3]); *(u32x2v*)(hbrow + c) = w; }
        ss = wave_sum(ss);
        if (lane < 32) p.rowss[(size_t)m * 32 + lane] = lane == 0 ? ss : 0.f;
    } else {
#pragma unroll
        for (int i = 0; i < 8; ++i) { const int c = (lane + 64 * i) * 4; *(f32x4*)(hrow + c) = (f32x4){0.f, 0.f, 0.f, 0.f}; u32x2v w; w[0] = 0u; w[1] = 0u; *(u32x2v*)(hbrow + c) = w; }
        if (lane < 32) p.rowss[(size_t)m * 32 + lane] = 0.f;
    }
}

__device__ void z2_item(const Params& p, int item) {
    const int tid__ = ltid_w(p.wave), wid = tid__ >> 6, lane = tid__ & 63, j = item * 8 + wid;
    bf16_t* za = p.ZA + (size_t)j * 256;
    if (j >= L) { za[lane] = 0; za[64 + lane] = 0; za[128 + lane] = 0; za[192 + lane] = 0; return; }
    float feat = 0.f;
    const float w = (float)(2.0 * 3.14159265358979323846 / L) * (float)j;
    if (lane == 0) feat = (float)j * (1.0f / (float)(L - 1));
    else if (lane <= 32) { const int bi = (lane - 1) & 15; const float band = 1e-4f + (float)bi * ((15.0f - 1e-4f) / 15.0f); const float ang = w * band;
        feat = lane <= 16 ? cosf(ang) : -sinf(ang); }
    float a = p.filt_b1[lane];
    for (int i = 0; i < 33; ++i) a += __int_as_float(__builtin_amdgcn_readlane(__float_as_int(feat), i)) * p.filt_w1[i * 64 + lane];
    const float fr = p.filt_freq[lane];
    const float z1 = sinf(fr * a);
    float c = p.filt_b2[lane];
    for (int k = 0; k < 64; ++k) c += __int_as_float(__builtin_amdgcn_readlane(__float_as_int(z1), k)) * p.filt_w2[k * 64 + lane];
    const float z = sinf(fr * c);
    const bf16_t hi = f2bf(z), lo = f2bf(z - bf2f(hi));
    za[lane] = hi; za[64 + lane] = lo; za[128 + lane] = hi; za[192 + lane] = 0;
}
__device__ void wb_items(const Params& p) {
    for (int idx = blockIdx.x * 512 + ltid_w(p.wave); idx < 2048 * 64; idx += gridDim.x * 512) { const int n = idx >> 6, k = idx & 63;
        const float w = p.filt_w3[(size_t)k * 2048 + n]; const bf16_t hi = f2bf(w), lo = f2bf(w - bf2f(hi));
        bf16_t* wb = p.WB + (size_t)n * 256; wb[k] = hi; wb[64 + k] = hi; wb[128 + k] = lo; wb[192 + k] = 0; }
}
struct EpiFilt {
    static constexpr bool PERM = true, AFTER_DRAIN = false;
    bf16_t* GF; float* G0;
    __device__ __forceinline__ void operator()(const f32x4 (&acc)[2][2][4][2], const Unit& u, int wr, int wc, int fr, int fq) const {
        const int row0 = u.pm * 256 + wr * 64 + fr, col0 = u.pn * 256 + wc * 32 + 8 * fq;
        const float la = -3.0701134573253945f, lb = -15.350567286626973f;
#pragma unroll
        for (int ai = 0; ai < 2; ++ai)
#pragma unroll
            for (int m = 0; m < 4; ++m) { const int n = row0 + ai * 128 + m * 16; const float delta = fabsf(la + (float)(n & 1023) * ((lb - la) / 1023.0f)) * (1.0f / (float)(L - 1));
                const float r1 = __expf(-delta), r2 = r1 * r1, r3 = r2 * r1;
                bf16_t* grow = GF + (size_t)n * 4352 + col0;
#pragma unroll
                for (int bj = 0; bj < 2; ++bj)
#pragma unroll
                    for (int nn = 0; nn < 2; ++nn) { const int j0 = col0 + bj * 128 + 4 * nn; const f32x4 a4 = acc[ai][bj][m][nn];
                        const float w0 = __expf(-(float)j0 * delta);
                        const float v0 = a4[0] * w0, v1 = a4[1] * (w0 * r1), v2 = a4[2] * (w0 * r2), v3 = a4[3] * (w0 * r3);
                        u32x2v w; w[0] = pk2(v0, v1); w[1] = pk2(v2, v3);
                        *(u32x2v*)(grow + bj * 128 + 4 * nn) = w;
                        if (j0 == 0) G0[n] = v0; } }

    }
};

constexpr int HY_G_ELEMS = 8336, HY_G_BYTES = HY_G_ELEMS * 2, HY_USTR = 144, HY_U_BYTES = 65 * HY_USTR, HY_CH_BYTES = HY_G_BYTES + 2 * HY_U_BYTES, HY_ZERO_OFF = 4 * HY_CH_BYTES;
static_assert(HY_ZERO_OFF + 256 <= LDS_BYTES, "lds");
static_assert(HY_CH_BYTES % 16 == 0 && HY_G_BYTES % 16 == 0, "align");
__device__ void hyu_item(const Params& p, int item, unsigned char* sm) {
    const int cb = item & 3, bt = item >> 2, b = bt / 65, tile = bt - b * 65, t0 = tile * 64;
    const int tid = ltid_w(p.wave), tl = tid & 63, qg = tid >> 6, t = t0 + tl;
    bf16_t* LT = (bf16_t*)sm;
#pragma unroll 1
    for (int x = 0; x < 4; ++x) { const int q = qg * 4 + x, c8 = cb * 256 + q * 8;
        float a1[8], a2[8];
#pragma unroll
        for (int h2 = 0; h2 < 2; ++h2) { const f32x4 b1 = *(const f32x4*)(p.conv_b + 1024 + c8 + 4 * h2), b2v = *(const f32x4*)(p.conv_b + 2048 + c8 + 4 * h2);
#pragma unroll
            for (int e = 0; e < 4; ++e) { a1[4 * h2 + e] = b1[e]; a2[4 * h2 + e] = b2v[e]; } }
        {
#pragma unroll
            for (int jj = 0; jj < 3; ++jj) { const int t2 = t + jj - 1; const bool ok = t < L && t2 >= 0 && t2 < L; const int t2c = t2 < 0 ? 0 : (t2 >= L ? L - 1 : t2);
                { const bf16_t* row = p.big + (size_t)(b * L + t2c) * INCP + c8;
                    const u32x4v x1 = *(const u32x4v*)(row + 1024), vh = *(const u32x4v*)(row + 2048); const float okf = ok ? 1.f : 0.f;
#pragma unroll
                    for (int h2 = 0; h2 < 2; ++h2) { const f32x4 w1 = *(const f32x4*)(p.conv_w + jj * 3072 + 1024 + c8 + 4 * h2) * okf, w2 = *(const f32x4*)(p.conv_w + jj * 3072 + 2048 + c8 + 4 * h2) * okf;
                        a1[4 * h2] += __uint_as_float(x1[2 * h2] << 16) * w1[0]; a1[4 * h2 + 1] += __uint_as_float(x1[2 * h2] & 0xffff0000u) * w1[1];
                        a1[4 * h2 + 2] += __uint_as_float(x1[2 * h2 + 1] << 16) * w1[2]; a1[4 * h2 + 3] += __uint_as_float(x1[2 * h2 + 1] & 0xffff0000u) * w1[3];
                        a2[4 * h2] += __uint_as_float(vh[2 * h2] << 16) * w2[0]; a2[4 * h2 + 1] += __uint_as_float(vh[2 * h2] & 0xffff0000u) * w2[1];
                        a2[4 * h2 + 2] += __uint_as_float(vh[2 * h2 + 1] << 16) * w2[2]; a2[4 * h2 + 3] += __uint_as_float(vh[2 * h2 + 1] & 0xffff0000u) * w2[3]; } } }
        }
#pragma unroll
        for (int e = 0; e < 8; ++e) LT[(q * 8 + e) * 72 + tl] = t < L ? (bf16_t)(pk2(a1[e] * a2[e], 0.f) & 0xffffu) : (bf16_t)0;
    }
    lds_barrier();
    { const int row = tid >> 1, half = tid & 1; bf16_t* dst = p.uT + ((size_t)(cb * 256 + row) * 2 + b) * 4160 + t0 + half * 32;
#pragma unroll
      for (int i = 0; i < 4; ++i) *(u32x4v*)(dst + 8 * i) = *(const u32x4v*)(LT + row * 72 + half * 32 + 8 * i); }
    lds_barrier();
}
__device__ void hyena_group(const Params& p, int grp_, unsigned char* sm, unsigned long long& tsec) {
    unsigned long long ts0_ = PROBE_MASK ? wall_clock64() : 0ull;
#define HSEC(i) do { if (PROBE_MASK) { const unsigned long long t_ = wall_clock64(); if ((PROBE_MASK >> (i)) & 1u) tsec += t_ - ts0_; ts0_ = t_; } } while (0)
    const int grp = __builtin_amdgcn_readfirstlane(grp_);
    const int tid = ltid_w(p.wave), wid = tid >> 6, lane = tid & 63, c0 = grp * 4;
    { const unsigned char* src = (const unsigned char*)(p.uT + (size_t)c0 * 2 * 4160);
      for (int idx = tid; idx < 8 * 520; idx += 512) { const int r = idx / 520, i = idx - r * 520;
          *(u32x4v*)(sm + (r >> 1) * HY_CH_BYTES + HY_G_BYTES + (r & 1) * HY_U_BYTES + (i >> 3) * HY_USTR + (i & 7) * 16) = *(const u32x4v*)(src + (size_t)idx * 16); } }
    if (tid < 36) ((unsigned*)(sm + HY_ZERO_OFF))[tid] = 0u;
    for (int i = tid; i < 4 * 113; i += 512) { const int ch = i / 113, q = i - ch * 113; const int idx = q < 49 ? q : 8272 + (q - 49);
        *(unsigned short*)(sm + ch * HY_CH_BYTES + 2 * idx) = 0; }
    for (int idx = tid; idx < 4 * 514; idx += 512) { const int ch = idx / 514, pc = idx - ch * 514, j0 = pc * 8;
        unsigned short* gb = (unsigned short*)(sm + ch * HY_CH_BYTES);
        const u32x4v f = *(const u32x4v*)(p.GF + (size_t)(c0 + ch) * 4352 + j0); u32x4v bk = *(const u32x4v*)(p.GF + (size_t)(1024 + c0 + ch) * 4352 + j0);
        if (pc == 0) bk[0] = (bk[0] & 0xffff0000u) | (pk2(p.G0[c0 + ch] + p.G0[1024 + c0 + ch], 0.f) & 0xffffu);
        *(u32x4v*)(gb + 4160 + j0) = bk;
#pragma unroll
        for (int e = 0; e < 8; ++e) if (pc != 0 || e != 0) gb[4160 - j0 - e] = (unsigned short)((e & 1) ? (f[e >> 1] >> 16) : (f[e >> 1] & 0xffffu)); }
    lds_barrier();
    HSEC(12);
    const int ch = wid >> 1, b = wid & 1, li = lane & 15, kq = lane >> 4;
    unsigned char* Ub = sm + ch * HY_CH_BYTES + HY_G_BYTES + b * HY_U_BYTES;
    const unsigned char* Zb = sm + HY_ZERO_OFF + kq * 16;
    f32x4 acc[4][5];
#pragma unroll
    for (int rb = 0; rb < 4; ++rb)
#pragma unroll
        for (int nb = 0; nb < 5; ++nb) acc[rb][nb] = (f32x4){0.f, 0.f, 0.f, 0.f};
    const unsigned shl = (li & 1) ? 16u : 0u;
    unsigned gq[5];
#pragma unroll
    for (int w = 0; w < 5; ++w) { unsigned t_ = (unsigned)(ch * HY_CH_BYTES + 4 * (((4160 + 8 * kq - li) >> 1) + w)); asm volatile("" : "+v"(t_)); gq[w] = t_; }
    PG8_LAS const unsigned char* sml = (PG8_LAS const unsigned char*)sm;
    auto gfrag = [&](int mp) -> pg8::bf16x8 {
        unsigned e[5];
#pragma unroll
        for (int w = 0; w < 5; ++w) e[w] = *(PG8_LAS const unsigned*)(sml + (gq[w] - 32 * mp));
        u32x4v r;
#pragma unroll
        for (int w = 0; w < 4; ++w) r[w] = __builtin_amdgcn_alignbit(e[w + 1], e[w], shl);
        return __builtin_bit_cast(pg8::bf16x8, r);
    };
    pg8::bf16x8 F[6];
    F[4] = gfrag(4 * (-64) - 2); F[5] = gfrag(4 * (-64) - 1);
    for (int d = -64; d <= 64; ++d) {
        F[0] = F[4]; F[1] = F[5];
#pragma unroll
        for (int q = 2; q < 6; ++q) F[q] = gfrag(4 * d - 2 + q);
        const int nb_lo = d > 0 ? (d >> 4) : 0, nb_hi = (d + 64) >> 4;
#pragma unroll
        for (int nb = 0; nb < 5; ++nb) {
            if (nb >= nb_lo && nb <= nb_hi) {
                const int sblk = 16 * nb + li - d;
                const unsigned char* up = ((unsigned)sblk < 65u) ? (Ub + sblk * HY_USTR + kq * 16) : Zb;
                const pg8::bf16x8 B0 = *(const pg8::bf16x8*)up, B1 = *(const pg8::bf16x8*)(up + 64);
#pragma unroll
                for (int rb = 0; rb < 4; ++rb) {
                    acc[rb][nb] = __builtin_amdgcn_mfma_f32_16x16x32_bf16(F[rb + 2], B0, acc[rb][nb], 0, 0, 0);
                    acc[rb][nb] = __builtin_amdgcn_mfma_f32_16x16x32_bf16(F[rb], B1, acc[rb][nb], 0, 0, 0);
                }
            }
        }
    }
    HSEC(13);
    {
        const float dc = p.hyena_d[c0 + ch];
#pragma unroll
        for (int nb = 0; nb < 5; ++nb) { const int t1 = 16 * nb + li;
            if (t1 < 65) {
#pragma unroll
                for (int rb = 0; rb < 4; ++rb) { unsigned char* up = Ub + t1 * HY_USTR + (16 * rb + 4 * kq) * 2;
                    const u32x2v uu = *(const u32x2v*)up; const f32x4 a = acc[rb][nb];
                    u32x2v w; w[0] = pk2(a[0] + dc * __uint_as_float(uu[0] << 16), a[1] + dc * __uint_as_float(uu[0] & 0xffff0000u));
                    w[1] = pk2(a[2] + dc * __uint_as_float(uu[1] << 16), a[3] + dc * __uint_as_float(uu[1] & 0xffff0000u));
                    *(u32x2v*)up = w; } } }
    }
    lds_barrier();
    for (int tt = tid; tt < 2 * L; tt += 512) { const int bb = tt >= L ? 1 : 0, t = tt - bb * L;
        const unsigned char* up = sm + HY_G_BYTES + bb * HY_U_BYTES + (t >> 6) * HY_USTR + (t & 63) * 2;
        const unsigned v0 = *(const unsigned short*)up, v1 = *(const unsigned short*)(up + HY_CH_BYTES), v2 = *(const unsigned short*)(up + 2 * HY_CH_BYTES), v3 = *(const unsigned short*)(up + 3 * HY_CH_BYTES);
        u32x2v w; w[0] = v0 | (v1 << 16); w[1] = v2 | (v3 << 16);
        *(u32x2v*)(p.yc + (size_t)(bb * L + t) * 1024 + c0) = w; }
    lds_barrier();
    HSEC(14);
}

constexpr int GP_QT = 0, GP_KT = 16384, GP_AM = 32768, GP_DEC = 40960, GP_STRIDE = 41472;
__device__ void gla_pre(const Params& p, int item, unsigned char* sm) {
    const int n = item % 65, bdh = item / 65, hh = bdh & 3, dir = (bdh >> 2) & 1, b = bdh >> 3;
    const int tid = ltid_w(p.wave), d = tid & 127, seg = tid >> 7, lane = tid & 63, wid = tid >> 6, li = lane & 15, kq = lane >> 4;
    float* LR = (float*)sm; float* SEGT = LR + 1024; bf16_t* QS = (bf16_t*)(sm + 8192); bf16_t* KS = QS + 64 * 136;
    unsigned char* gp = p.gp + (size_t)item * GP_STRIDE;
    { const int i = tid >> 3, r2 = (tid & 7) * 2; const int tau = dir ? 4159 - (64 * n + i) : 64 * n + i; float v0 = 0.f, v1 = 0.f;
      { const unsigned w = *(const unsigned*)(p.big + (size_t)(b * L + (tau < 48 ? 0 : tau - 48)) * INCP + C_LR + dir * 16 + r2); if (tau >= 48) { v0 = __uint_as_float(w << 16); v1 = __uint_as_float(w & 0xffff0000u); } }
      LR[i * 16 + r2] = v0; LR[i * 16 + r2 + 1] = v1; }
    float w2[16];
#pragma unroll
    for (int r = 0; r < 16; ++r) w2[r] = p.gk_w2[(size_t)(dir * 16 + r) * 512 + hh * 128 + d];
    const float b2 = p.gk_b2[dir * 512 + hh * 128 + d];
    unsigned short qraw[16], kraw[16];
#pragma unroll
    for (int ii = 0; ii < 16; ++ii) { const int i = seg * 16 + ii; const int tau = dir ? 4159 - (64 * n + i) : 64 * n + i; const int tc = tau < 48 ? 0 : tau - 48;
        const bf16_t* row = p.big + (size_t)(b * L + tc) * INCP + hh * 128 + d; qraw[ii] = row[C_Q]; kraw[ii] = row[C_K];
        if (tau < 48) { qraw[ii] = 0; kraw[ii] = 0; } }
    lds_barrier();
    float cs[16]; float run = 0.f;
#pragma unroll
    for (int ii = 0; ii < 16; ++ii) { const int i = seg * 16 + ii; const int tau = dir ? 4159 - (64 * n + i) : 64 * n + i;
        float xg = b2;
#pragma unroll
        for (int r4 = 0; r4 < 4; ++r4) { const f32x4 l4 = *(const f32x4*)(LR + i * 16 + 4 * r4); xg += l4[0] * w2[4 * r4] + l4[1] * w2[4 * r4 + 1] + l4[2] * w2[4 * r4 + 2] + l4[3] * w2[4 * r4 + 3]; }
        const float lg = tau >= 48 ? (fminf(xg, 0.f) - __logf(1.0f + __expf(-fabsf(xg)))) * (1.0f / 16.0f) : 0.f;
        run += lg; cs[ii] = run; }
    SEGT[seg * 128 + d] = run;
    lds_barrier();
    float off = 0.f, tot = 0.f;
#pragma unroll
    for (int s = 0; s < 4; ++s) { const float v = SEGT[s * 128 + d]; if (s < seg) off += v; tot += v; }
    unsigned kt[8];
#pragma unroll
    for (int ii = 0; ii < 16; ii += 2) { float kh[2];
#pragma unroll
        for (int x = 0; x < 2; ++x) { const int i = seg * 16 + ii + x; const float q = bf2f(qraw[ii + x]), k = bf2f(kraw[ii + x]);
            const float bi = off + cs[ii + x]; const bf16_t qv = f2bf(q * 0.08838834764831845f * __expf(bi));
            QS[i * 136 + d] = qv; KS[i * 136 + d] = f2bf(k * __expf(-bi)); *(bf16_t*)(gp + GP_QT + (i * 128 + d) * 2) = qv; kh[x] = k * __expf(tot - bi); }
        kt[ii >> 1] = pk2(kh[0], kh[1]); }
    { u32x4v w0, w1; w0[0] = kt[0]; w0[1] = kt[1]; w0[2] = kt[2]; w0[3] = kt[3]; w1[0] = kt[4]; w1[1] = kt[5]; w1[2] = kt[6]; w1[3] = kt[7];
      *(u32x4v*)(gp + GP_KT + (d * 64 + seg * 16) * 2) = w0; *(u32x4v*)(gp + GP_KT + (d * 64 + seg * 16 + 8) * 2) = w1; }
    if (seg == 0) *(float*)(gp + GP_DEC + d * 4) = __expf(tot);
    lds_barrier();
    { const int it = wid >> 1;
#pragma unroll
      for (int x = 0; x < 2; ++x) { const int jt = (wid & 1) * 2 + x; f32x4 acc = {0.f, 0.f, 0.f, 0.f};
#pragma unroll
          for (int ks = 0; ks < 4; ++ks) { const pg8::bf16x8 a = *(const pg8::bf16x8*)(QS + (16 * it + li) * 136 + 32 * ks + 8 * kq), bb = *(const pg8::bf16x8*)(KS + (16 * jt + li) * 136 + 32 * ks + 8 * kq);
              acc = __builtin_amdgcn_mfma_f32_16x16x32_bf16(a, bb, acc, 0, 0, 0); }
#pragma unroll
          for (int r = 0; r < 4; ++r) { const int i = 16 * it + 4 * kq + r, j = 16 * jt + li; *(bf16_t*)(gp + GP_AM + (i * 64 + j) * 2) = f2bf(j <= i ? acc[r] : 0.f); } } }
    lds_barrier();
}

__device__ void gla_scan(const Params& p, int item, unsigned char* sm) {
    const int s = item & 7, bdh = item >> 3, hh = bdh & 3, dir = (bdh >> 2) & 1, b = bdh >> 3;
    const int tid = ltid_w(p.wave), lane = tid & 63, wid = tid >> 6, li = lane & 15, kq = lane >> 4;
    constexpr int O_VT = 0, SZ_VT = 32 * 72 * 2, O_ST = 2 * SZ_VT;
    float* outp = dir ? p.ob : p.of;
    const unsigned char* gbase = p.gp + (size_t)(bdh * 65) * GP_STRIDE;
    const int it = wid >> 1, eto = wid & 1;
    struct RS { u32x4v fa[2], fq[4], fk[2], v; f32x4 dec; };
    auto LOAD = [&](int n, RS& R) {
        const unsigned char* g = gbase + (size_t)n * GP_STRIDE;
#pragma unroll
        for (int ks = 0; ks < 2; ++ks) R.fa[ks] = *(const u32x4v*)(g + GP_AM + ((16 * it + li) * 64 + 32 * ks + 8 * kq) * 2);
#pragma unroll
        for (int ks = 0; ks < 4; ++ks) R.fq[ks] = *(const u32x4v*)(g + GP_QT + ((16 * it + li) * 128 + 32 * ks + 8 * kq) * 2);
#pragma unroll
        for (int ks = 0; ks < 2; ++ks) R.fk[ks] = *(const u32x4v*)(g + GP_KT + ((16 * wid + li) * 64 + 32 * ks + 8 * kq) * 2);
        R.dec = *(const f32x4*)(g + GP_DEC + (16 * wid + 4 * kq) * 4);
        const int tau = dir ? 4159 - (64 * n + lane) : 64 * n + lane;
        R.v = (u32x4v){0u, 0u, 0u, 0u};
        if (wid < 4) R.v = *(const u32x4v*)(p.big + (size_t)(b * L + (tau < 48 ? 0 : tau - 48)) * INCP + C_V + hh * 256 + s * 32 + wid * 8);
    };
    auto PUTV = [&](int buf, const RS& R) {
        if (wid < 4) { bf16_t* vt = (bf16_t*)(sm + O_VT + buf * SZ_VT);
#pragma unroll
            for (int x = 0; x < 4; ++x) { vt[(wid * 8 + 2 * x) * 72 + lane] = (bf16_t)(R.v[x] & 0xffffu); vt[(wid * 8 + 2 * x + 1) * 72 + lane] = (bf16_t)(R.v[x] >> 16); } }
    };
    f32x4 S[2];
    S[0] = (f32x4){0.f, 0.f, 0.f, 0.f}; S[1] = S[0];
    for (int i = tid; i < 8704 / 16; i += 512) *(u32x4v*)(sm + O_ST + i * 16) = (u32x4v){0u, 0u, 0u, 0u};
    const bf16_t* ST = (const bf16_t*)(sm + O_ST);
    auto STEP = [&](int n, RS& RA, const RS& RB) {
        const bf16_t* VT = (const bf16_t*)(sm + O_VT + (n & 1) * SZ_VT);
        { f32x4 o = {0.f, 0.f, 0.f, 0.f};
#pragma unroll
          for (int ks = 0; ks < 2; ++ks) { const pg8::bf16x8 bb = *(const pg8::bf16x8*)(VT + (16 * eto + li) * 72 + 32 * ks + 8 * kq);
              o = __builtin_amdgcn_mfma_f32_16x16x32_bf16(__builtin_bit_cast(pg8::bf16x8, RA.fa[ks]), bb, o, 0, 0, 0); }
#pragma unroll
          for (int ks = 0; ks < 4; ++ks) { const pg8::bf16x8 bb = *(const pg8::bf16x8*)(ST + (16 * eto + li) * 136 + 32 * ks + 8 * kq);
              o = __builtin_amdgcn_mfma_f32_16x16x32_bf16(__builtin_bit_cast(pg8::bf16x8, RA.fq[ks]), bb, o, 0, 0, 0); }
#pragma unroll
          for (int r = 0; r < 4; ++r) { const int i = 16 * it + 4 * kq + r; const int tau = dir ? 4159 - (64 * n + i) : 64 * n + i;
              if (tau >= 48) outp[(size_t)(b * L + tau - 48) * 1024 + hh * 256 + s * 32 + 16 * eto + li] = o[r]; } }
#pragma unroll
        for (int et = 0; et < 2; ++et) { S[et] *= RA.dec;
#pragma unroll
            for (int ks = 0; ks < 2; ++ks) { const pg8::bf16x8 bb = *(const pg8::bf16x8*)(VT + (16 * et + li) * 72 + 32 * ks + 8 * kq);
                S[et] = __builtin_amdgcn_mfma_f32_16x16x32_bf16(__builtin_bit_cast(pg8::bf16x8, RA.fk[ks]), bb, S[et], 0, 0, 0); } }
        if (n + 2 < 65) LOAD(n + 2, RA);
        lds_barrier();
#pragma unroll
        for (int et = 0; et < 2; ++et) { u32x2v w; w[0] = pk2(S[et][0], S[et][1]); w[1] = pk2(S[et][2], S[et][3]);
            *(u32x2v*)(sm + O_ST + ((16 * et + li) * 136 + 16 * wid + 4 * kq) * 2) = w; }
        if (n + 1 < 65) PUTV((n + 1) & 1, RB);
        lds_barrier();
    };
    RS R0, R1;
    LOAD(0, R0); LOAD(1, R1);
    PUTV(0, R0);
    lds_barrier();
    for (int n = 0; n < 64; n += 2) { STEP(n, R0, R1); STEP(n + 1, R1, R0); }
    STEP(64, R0, R1);
}

__device__ void fin_item(const Params& p, int item) {
    const int tid__ = ltid_w(p.wave), wid = tid__ >> 6, lane = tid__ & 63, m = item * 8 + wid;
    bf16_t* yrow = p.y + (size_t)m * D;
    if (m >= M) { const u32x4v z = {0u, 0u, 0u, 0u};
#pragma unroll
        for (int i = 0; i < 4; ++i) *(u32x4v*)(yrow + (lane + 64 * i) * 8) = z;
        return; }
    const int c0 = lane * 16;
    {
      const int b = m >= L ? 1 : 0, t = m - b * L;
      float x0[16];
#pragma unroll
      for (int i = 0; i < 4; ++i) { const f32x4 cb = *(const f32x4*)(p.conv_b + c0 + 4 * i); x0[4 * i] = cb[0]; x0[4 * i + 1] = cb[1]; x0[4 * i + 2] = cb[2]; x0[4 * i + 3] = cb[3]; }
#pragma unroll
      for (int jj = 0; jj < 3; ++jj) { const int t2 = t + jj - 1; const bool ok = t2 >= 0 && t2 < L; const int t2c = t2 < 0 ? 0 : (t2 >= L ? L - 1 : t2);
          { const bf16_t* row = p.big + (size_t)(b * L + t2c) * INCP + c0; const u32x4v r0 = *(const u32x4v*)row, r1 = *(const u32x4v*)(row + 8); const float okf = ok ? 1.f : 0.f;
#pragma unroll
              for (int i = 0; i < 4; ++i) { const f32x4 cw = *(const f32x4*)(p.conv_w + jj * 3072 + c0 + 4 * i) * okf; const unsigned lo = i < 2 ? r0[2 * i] : r1[2 * i - 4], hi = i < 2 ? r0[2 * i + 1] : r1[2 * i - 3];
                  x0[4 * i] += __uint_as_float(lo << 16) * cw[0]; x0[4 * i + 1] += __uint_as_float(lo & 0xffff0000u) * cw[1]; x0[4 * i + 2] += __uint_as_float(hi << 16) * cw[2]; x0[4 * i + 3] += __uint_as_float(hi & 0xffff0000u) * cw[3]; } } }
      const bf16_t* src = p.yc + (size_t)m * 1024 + c0; const u32x4v y0 = *(const u32x4v*)src, y1 = *(const u32x4v*)(src + 8);
      f32x4 v[4]; float ss = 0.f;
#pragma unroll
      for (int i = 0; i < 4; ++i) { const unsigned lo = i < 2 ? y0[2 * i] : y1[2 * i - 4], hi = i < 2 ? y0[2 * i + 1] : y1[2 * i - 3];
          v[i][0] = __uint_as_float(lo << 16) * x0[4 * i]; v[i][1] = __uint_as_float(lo & 0xffff0000u) * x0[4 * i + 1]; v[i][2] = __uint_as_float(hi << 16) * x0[4 * i + 2]; v[i][3] = __uint_as_float(hi & 0xffff0000u) * x0[4 * i + 3];
          ss += (v[i][0] * v[i][0] + v[i][1] * v[i][1]) + (v[i][2] * v[i][2] + v[i][3] * v[i][3]); }
      ss += shx<1>(ss); ss += shx<2>(ss); ss += shx<4>(ss);
      const float r = rsqrtf(ss * (1.0f / 128.0f) + EPS);
      u32x4v w0, w1;
#pragma unroll
      for (int i = 0; i < 4; ++i) { const f32x4 g = *(const f32x4*)(p.hyena_norm + c0 + 4 * i); const f32x4 o = v[i] * r * g;
          if (i < 2) { w0[2 * i] = pk2(o[0], o[1]); w0[2 * i + 1] = pk2(o[2], o[3]); } else { w1[2 * i - 4] = pk2(o[0], o[1]); w1[2 * i - 3] = pk2(o[2], o[3]); } }
      *(u32x4v*)(yrow + c0) = w0; *(u32x4v*)(yrow + c0 + 8) = w1; }
    { const float* s1 = p.of + (size_t)m * 1024 + c0; const float* s2 = p.ob + (size_t)m * 1024 + c0; f32x4 v[4]; float ss = 0.f;
#pragma unroll
      for (int i = 0; i < 4; ++i) { v[i] = *(const f32x4*)(s1 + 4 * i) + *(const f32x4*)(s2 + 4 * i); ss += (v[i][0] * v[i][0] + v[i][1] * v[i][1]) + (v[i][2] * v[i][2] + v[i][3] * v[i][3]); }
      ss += shx<1>(ss); ss += shx<2>(ss); ss += shx<4>(ss); ss += shx<8>(ss);
      const float r = rsqrtf(ss * (1.0f / 256.0f) + EPS);
      const bf16_t* og = p.big + (size_t)m * INCP + C_OG + c0;
      const u32x4v g0 = *(const u32x4v*)og, g1 = *(const u32x4v*)(og + 8);
      float ogf[16];
#pragma unroll
      for (int i = 0; i < 4; ++i) { ogf[2 * i] = __uint_as_float(g0[i] << 16); ogf[2 * i + 1] = __uint_as_float(g0[i] & 0xffff0000u); ogf[8 + 2 * i] = __uint_as_float(g1[i] << 16); ogf[8 + 2 * i + 1] = __uint_as_float(g1[i] & 0xffff0000u); }
      u32x4v w0, w1;
#pragma unroll
      for (int i = 0; i < 4; ++i) { const f32x4 g = *(const f32x4*)(p.gla_norm + ((c0 + 4 * i) & 255)); f32x4 o = v[i] * r * g;
          o[0] *= silu_f(ogf[4 * i]); o[1] *= silu_f(ogf[4 * i + 1]); o[2] *= silu_f(ogf[4 * i + 2]); o[3] *= silu_f(ogf[4 * i + 3]);
          if (i < 2) { w0[2 * i] = pk2(o[0], o[1]); w0[2 * i + 1] = pk2(o[2], o[3]); } else { w1[2 * i - 4] = pk2(o[0], o[1]); w1[2 * i - 3] = pk2(o[2], o[3]); } }
      *(u32x4v*)(yrow + 1024 + c0) = w0; *(u32x4v*)(yrow + 1024 + c0 + 8) = w1; }
}

__device__ void final_item(const Params& p, int item) {
    const int tid__ = ltid_w(p.wave), wid = tid__ >> 6, lane = tid__ & 63, row = item * 8 + wid, b = row >> 12, s = row & 4095, m = b * L + NMETA + s;
    const float* hrow = p.h + (size_t)m * D; float* orow = p.out + (size_t)row * D; f32x4 v[8]; float ss = 0.f;
#pragma unroll
    for (int i = 0; i < 8; ++i) { v[i] = *(const f32x4*)(hrow + (lane + 64 * i) * 4); ss += (v[i][0] * v[i][0] + v[i][1] * v[i][1]) + (v[i][2] * v[i][2] + v[i][3] * v[i][3]); }
    ss = wave_sum(ss); const float r = rsqrtf(ss * (1.0f / D) + EPS);
#pragma unroll
    for (int i = 0; i < 8; ++i) { const int c = (lane + 64 * i) * 4; *(f32x4*)(orow + c) = v[i] * r * *(const f32x4*)(p.final_norm + c); }
}

template <class TEpi> __device__ __forceinline__ void tail_tile(const bf16_t* A, int arow0, const bf16_t* Bt, int brow0, int brow1, const int K, float* red, const TEpi& E, int c, const int wave) {
    const int tid = ltid_w(wave), wid = tid >> 6, lane = tid & 63, li = lane & 15, kq = lane >> 4;
    const int kw = K >> 3, k0 = wid * kw;
    const bf16_t* ap = A + (size_t)(arow0 + li) * K + k0 + 8 * kq;
    const bf16_t* bp0 = Bt + (size_t)(brow0 + li) * K + k0 + 8 * kq;
    const bf16_t* bp1 = Bt + (size_t)(brow1 + li) * K + k0 + 8 * kq;
    f32x4 acc[2][4];
#pragma unroll
    for (int x = 0; x < 2; ++x)
#pragma unroll
        for (int y = 0; y < 4; ++y) acc[x][y] = (f32x4){0.f, 0.f, 0.f, 0.f};
#pragma unroll 4
    for (int k = 0; k < kw; k += 32) {
        pg8::bf16x8 a[2], bfr[4];
        a[0] = *(const pg8::bf16x8*)(ap + k); a[1] = *(const pg8::bf16x8*)(ap + (size_t)16 * K + k);
        bfr[0] = *(const pg8::bf16x8*)(bp0 + k); bfr[1] = *(const pg8::bf16x8*)(bp0 + (size_t)16 * K + k);
        bfr[2] = *(const pg8::bf16x8*)(bp1 + k); bfr[3] = *(const pg8::bf16x8*)(bp1 + (size_t)16 * K + k);
#pragma unroll
        for (int x = 0; x < 2; ++x)
#pragma unroll
            for (int y = 0; y < 4; ++y) acc[x][y] = __builtin_amdgcn_mfma_f32_16x16x32_bf16(bfr[y], a[x], acc[x][y], 0, 0, 0);
    }
#pragma unroll
    for (int x = 0; x < 2; ++x)
#pragma unroll
        for (int y = 0; y < 4; ++y) *(f32x4*)(red + wid * 2048 + (16 * x + li) * 64 + 16 * y + 4 * kq) = acc[x][y];
    lds_barrier();
    { const int row = tid >> 4, col4 = (tid & 15) * 4; f32x4 v = {0.f, 0.f, 0.f, 0.f};
#pragma unroll
      for (int w = 0; w < 8; ++w) v += *(const f32x4*)(red + w * 2048 + row * 64 + col4);
      E(arow0 + row, c, col4, v); }
    lds_barrier();
}
struct TEpiResid {
    float* H; bf16_t* HB; float* rowss; float scale;
    __device__ __forceinline__ void operator()(int r, int c, int col4, f32x4 v) const {
        float* hp = H + (size_t)r * D + c * 64 + col4; f32x4 a = *(const f32x4*)hp; a += v * scale; *(f32x4*)hp = a;
        float ss = (a[0] * a[0] + a[1] * a[1]) + (a[2] * a[2] + a[3] * a[3]);
        ss += shx<1>(ss); ss += shx<2>(ss); ss += shx<4>(ss); ss += shx<8>(ss);
        if (HB) { u32x2v w; w[0] = pk2(a[0], a[1]); w[1] = pk2(a[2], a[3]); *(u32x2v*)(HB + (size_t)r * D + c * 64 + col4) = w; }
        if (rowss && (lane_id() & 15) == 0) rowss[(size_t)r * 32 + c] = ss;
    }
};
struct TEpiScale {
    bf16_t* O; int ldc; const float* rowss;
    __device__ __forceinline__ void operator()(int r, int c, int col4, f32x4 v) const {
        const int l = lane_id() & 15; float s = rowss[(size_t)r * 32 + 2 * l] + rowss[(size_t)r * 32 + 2 * l + 1];
        s += shx<1>(s); s += shx<2>(s); s += shx<4>(s); s += shx<8>(s);
        const float rs = rsqrtf(s * (1.0f / D) + EPS);
        u32x2v w; w[0] = pk2(v[0] * rs, v[1] * rs); w[1] = pk2(v[2] * rs, v[3] * rs); *(u32x2v*)(O + (size_t)r * ldc + c * 64 + col4) = w;
    }
};

#define run_gemm(...) run_gemm_(__VA_ARGS__, p.wave)
template <class Epi> __device__ __forceinline__ void run_gemm_(PG8_LAS unsigned char* lds, const bf16_t* A, const bf16_t* Bt, int Mr, int N, int K, const Epi& E, const int wave) {
    pg8::Gemm g; g.A = A; g.Bt = Bt; g.M = Mr; g.N = N; g.K = K;
    pg8::StaticOrder S; S.init(Mr, N, (int)gridDim.x, (int)blockIdx.x);
    pg8::gemm_phase<Epi, pg8::StaticOrder>(lds, g, S, E, ltid_w(wave));
}

__device__ __forceinline__ void gbar(const __attribute__((address_space(4))) Params* kp, int wave, int k) {
    __syncthreads();
    if (ltid_w(wave) == 0) {
        unsigned* bar = kp->bar; const unsigned target = (unsigned)k * gridDim.x;
        __threadfence();
        __hip_atomic_fetch_add(bar, 1u, __ATOMIC_RELEASE, __HIP_MEMORY_SCOPE_AGENT);
        while (__hip_atomic_load(bar, __ATOMIC_RELAXED, __HIP_MEMORY_SCOPE_AGENT) < target) __builtin_amdgcn_s_sleep(1);
        __threadfence();
    }
    __syncthreads();
}
typedef const __attribute__((address_space(4))) Params* KParams;
#if defined(__HIP_DEVICE_COMPILE__)
#define LOADP() Params p; { KParams q_ = kp; asm volatile("" : "+s"(q_)); p = *q_; p.wave = wave_s; }
#else
#define LOADP() Params p = p_unused; p.wave = wave_s; (void)kp;
#endif
#define MARK(i) do { if (PROBE_MASK) { const unsigned long long t_ = wall_clock64(); if ((PROBE_MASK >> (i)) & 1u) t_acc += t_ - t_last; t_last = t_; } } while (0)
__global__ __launch_bounds__(512, 2) void mega(Params p_unused) {
    KParams kp = (KParams)__builtin_amdgcn_kernarg_segment_ptr();
    const int wave_s = __builtin_amdgcn_readfirstlane((int)(threadIdx.x >> 6));
    unsigned long long t_acc = 0ull, t_last = PROBE_MASK ? wall_clock64() : 0ull;
    extern __shared__ __attribute__((aligned(16))) unsigned char smem[];
    cg::grid_group grid = cg::this_grid();
    PG8_LAS unsigned char* lds = (PG8_LAS unsigned char*)smem;
    float* smf = (float*)smem;
    const int G = gridDim.x, bid = blockIdx.x;
    { LOADP();
      transpose_mat(p.ffn1_wg, p.Wgu1, p.ffn1_norm, D, DFF, DFF, DFF, 1, smf, p.wave);
      transpose_mat(p.ffn1_wu, p.Wgu1, p.ffn1_norm, D, DFF, DFF, DFF, 2, smf, p.wave);
      transpose_mat(p.ffn1_wd, p.Wd1, nullptr, DFF, D, D, D, 0, smf, p.wave); }
    { LOADP();
      transpose_mat(p.w_in, p.Win, p.mix_norm, D, INCP, INC, INC, 0, smf, p.wave);
      transpose_mat(p.w_out, p.Wout, nullptr, D, D, D, D, 0, smf, p.wave); }
    { LOADP();
      transpose_mat(p.ffn2_wg, p.Wgu2, p.ffn2_norm, D, DFF, DFF, DFF, 1, smf, p.wave);
      transpose_mat(p.ffn2_wu, p.Wgu2, p.ffn2_norm, D, DFF, DFF, DFF, 2, smf, p.wave);
      transpose_mat(p.ffn2_wd, p.Wd2, nullptr, DFF, D, D, D, 0, smf, p.wave); }
    { LOADP();
      if (bid == 0 && ltid_w(p.wave) == 0) *p.ctr = 0u;
      wb_items(p);
      for (int it = bid; it < NT_ROWS + NT_Z2; it += G) { if (it < NT_ROWS) row_item(p, it); else z2_item(p, it - NT_ROWS); } }
    grid.sync(); MARK(0);
    { LOADP(); EpiSwiglu E; E.O = p.big; E.rowss = p.rowss; run_gemm(lds, p.hb, p.Wgu1, MP, 2 * DFF, D, E); }
    gbar(kp, wave_s, 1); MARK(1);
    { LOADP(); EpiResid<true> E; E.H = p.h; E.HB = p.hb; E.rowss = p.rowss; E.scale = 0.5f; run_gemm(lds, p.big, p.Wd1, 8192, D, DFF, E); }
    { LOADP(); TEpiResid T; T.H = p.h; T.HB = p.hb; T.rowss = p.rowss; T.scale = 0.5f;
      for (int c = bid; c < 32; c += G) tail_tile(p.big, 8192, p.Wd1, 64 * c, 64 * c + 32, DFF, smf, T, c, p.wave); }
    gbar(kp, wave_s, 2); MARK(2);
    { LOADP(); EpiScale E; E.O = p.big; E.ldc = INCP; E.rowss = p.rowss; run_gemm(lds, p.hb, p.Win, 8192, 6144, D, E); }
    { LOADP(); TEpiScale T; T.O = p.big; T.ldc = INCP; T.rowss = p.rowss;
      for (int it = bid; it < 97 + 256; it += G) { if (it < 97) tail_tile(p.hb, 8192, p.Win, 64 * it, 64 * it + 32, D, smf, T, it, p.wave); else tail_tile(p.hb, 32 * (it - 97), p.Win, 6144, 6176, D, smf, T, 96, p.wave); } }
    gbar(kp, wave_s, 3); MARK(3);
#define PSEC(i, stmt) do { unsigned long long a_ = PROBE_MASK ? wall_clock64() : 0ull; stmt; if (PROBE_MASK && ((PROBE_MASK >> (i)) & 1u)) t_acc += wall_clock64() - a_; } while (0)
    { LOADP(); EpiFilt E; E.GF = p.GF; E.G0 = p.G0; PSEC(20, run_gemm(lds, p.WB, p.ZA, 2048, 4352, 256, E)); }
    { LOADP(); for (int it = bid; it < 1040 + 520; it += G) { if (it < 1040) PSEC(21, gla_pre(p, it, smem)); else PSEC(22, hyu_item(p, it - 1040, smem)); } }
    gbar(kp, wave_s, 4); MARK(4);
    { LOADP(); if (bid < 128) gla_scan(p, bid, smem); }
    { LOADP();
      for (;;) {
        if (ltid_w(p.wave) == 0) *(int*)(smem + HY_ZERO_OFF + 192) = (int)atomicAdd(p.ctr, 1u);
        lds_barrier();
        const int g = *(const int*)(smem + HY_ZERO_OFF + 192);
        lds_barrier();
        if (g >= 256) break;
        hyena_group(p, (g & 7) * 32 + (g >> 3), smem, t_acc);
      } }
    gbar(kp, wave_s, 5); MARK(5);
    { LOADP(); for (int it = bid; it < MP / 8; it += G) fin_item(p, it); }
    gbar(kp, wave_s, 6); MARK(6);
    { LOADP(); EpiResid<true> E; E.H = p.h; E.HB = p.hb; E.rowss = p.rowss; E.scale = 1.0f; run_gemm(lds, p.y, p.Wout, 8192, D, D, E); }
    { LOADP(); TEpiResid T; T.H = p.h; T.HB = p.hb; T.rowss = p.rowss; T.scale = 1.0f;
      for (int c = bid; c < 32; c += G) tail_tile(p.y, 8192, p.Wout, 64 * c, 64 * c + 32, D, smf, T, c, p.wave); }
    gbar(kp, wave_s, 7); MARK(7);
    { LOADP(); EpiSwiglu E; E.O = p.big; E.rowss = p.rowss; run_gemm(lds, p.hb, p.Wgu2, MP, 2 * DFF, D, E); }
    gbar(kp, wave_s, 8); MARK(8);
    { LOADP(); EpiResid<false> E; E.H = p.h; E.HB = nullptr; E.rowss = nullptr; E.scale = 0.5f; run_gemm(lds, p.big, p.Wd2, 8192, D, DFF, E); }
    { LOADP(); TEpiResid T; T.H = p.h; T.HB = nullptr; T.rowss = nullptr; T.scale = 0.5f;
      for (int c = bid; c < 32; c += G) tail_tile(p.big, 8192, p.Wd2, 64 * c, 64 * c + 32, DFF, smf, T, c, p.wave); }
    gbar(kp, wave_s, 9); MARK(9);
    { LOADP(); for (int it = bid; it < 1024; it += G) final_item(p, it); }
    MARK(10);
    if (PROBE_MASK && bid == 0) { const unsigned long long t0_ = wall_clock64(); while (wall_clock64() - t0_ < (unsigned long long)PROBE_K * t_acc) __builtin_amdgcn_s_sleep(8); }
}

extern "C" void kernel_launch(void* const* d_in, const int* in_sizes, int n_in, void* d_out, int out_size, void* d_ws, size_t ws_size, hipStream_t stream) {
    static int grid_blocks = 0;
    if (!grid_blocks) {
        (void)hipFuncSetAttribute((const void*)mega, hipFuncAttributeMaxDynamicSharedMemorySize, LDS_BYTES);
        int dev = 0, cus = 0, per_cu = 0;
        (void)hipGetDevice(&dev);
        (void)hipDeviceGetAttribute(&cus, hipDeviceAttributeMultiprocessorCount, dev);
        (void)hipOccupancyMaxActiveBlocksPerMultiprocessor(&per_cu, mega, 512, LDS_BYTES);
        if (per_cu > 1) per_cu = 1;
        if (per_cu < 1) { fprintf(stderr, "occupancy query returned %d\n", per_cu); per_cu = 1; }
        grid_blocks = cus * per_cu;
    }
    Params p{};
    const float* const* in = (const float* const*)d_in;
    p.x = in[0]; p.meta = in[1]; p.ffn1_norm = in[2]; p.ffn1_wg = in[3]; p.ffn1_wu = in[4]; p.ffn1_wd = in[5]; p.mix_norm = in[6]; p.w_in = in[7];
    p.conv_w = in[8]; p.conv_b = in[9]; p.filt_w1 = in[10]; p.filt_b1 = in[11]; p.filt_w2 = in[12]; p.filt_b2 = in[13]; p.filt_w3 = in[14]; p.filt_freq = in[15];
    p.hyena_d = in[16]; p.hyena_norm = in[17]; p.gk_w2 = in[18]; p.gk_b2 = in[19]; p.gla_norm = in[20]; p.w_out = in[21];
    p.ffn2_norm = in[22]; p.ffn2_wg = in[23]; p.ffn2_wu = in[24]; p.ffn2_wd = in[25]; p.final_norm = in[26];
    p.out = (float*)d_out;
    unsigned char* ws = (unsigned char*)d_ws;
    constexpr size_t SZ_WGU = (size_t)2 * DFF * D * 2, SZ_WD = (size_t)D * DFF * 2, SZ_WIN = (size_t)INCP * D * 2, SZ_WOUT = (size_t)D * D * 2;
    constexpr size_t SZ_H = (size_t)MP * D * 4, SZ_HB = (size_t)MP * D * 2, SZ_BIG = (size_t)MP * INCP * 2, SZ_RS = (size_t)MP * 32 * 4, SZ_Z2 = (size_t)L * 64 * 4;
    size_t o = 0;
    p.Wgu1 = (bf16_t*)(ws + o); o += SZ_WGU; p.Wd1 = (bf16_t*)(ws + o); o += SZ_WD; p.Win = (bf16_t*)(ws + o); o += SZ_WIN; p.Wout = (bf16_t*)(ws + o); o += SZ_WOUT;
    p.Wgu2 = (bf16_t*)(ws + o); o += SZ_WGU; p.Wd2 = (bf16_t*)(ws + o); o += SZ_WD;
    p.h = (float*)(ws + o); o += SZ_H; p.hb = (bf16_t*)(ws + o); o += SZ_HB; p.big = (bf16_t*)(ws + o); o += SZ_BIG; p.rowss = (float*)(ws + o); o += SZ_RS; p.z2 = (float*)(ws + o); o += SZ_Z2; p.ctr = (unsigned*)(ws + o); o += 256; p.ZA = (bf16_t*)(ws + o); o += (size_t)4352 * 256 * 2; p.WB = (bf16_t*)(ws + o); o += (size_t)2048 * 256 * 2; p.G0 = (float*)(ws + o); o += 2048 * 4; p.bar = (unsigned*)(ws + o); o += 256;
    p.yc = (bf16_t*)ws; p.y = (bf16_t*)(ws + (size_t)M * 1024 * 2); p.of = (float*)p.hb; p.ob = (float*)d_out; p.gp = ws + (size_t)M * 1024 * 2; p.GF = p.Win; p.uT = (bf16_t*)((unsigned char*)d_out + (size_t)M * 1024 * 4);
    if (o > ws_size) fprintf(stderr, "workspace too small: need %zu have %zu\n", o, ws_size);
    (void)hipMemsetAsync(p.bar, 0, 256, stream);
    void* args[] = {&p};
    hipError_t e = hipLaunchCooperativeKernel((void*)mega, dim3(grid_blocks), dim3(512), args, LDS_BYTES, stream);
    if (e != hipSuccess) fprintf(stderr, "cooperative launch failed: %s (grid %d)\n", hipGetErrorString(e), grid_blocks);
}
```

```cpp
#include <hip/hip_runtime.h>
#include <hip/hip_cooperative_groups.h>
#include <cstdio>
namespace cg = cooperative_groups;
namespace pg8 {
#define PG8_LAS __attribute__((address_space(3)))
typedef unsigned short bf16_t;
typedef short bf16x8 __attribute__((ext_vector_type(8)));
typedef float f32x4 __attribute__((ext_vector_type(4)));
typedef unsigned u32x4 __attribute__((ext_vector_type(4)));
constexpr int BM = 256, BK = 64, HALF = 128, HTB = HALF * BK * 2  , STAGE_BYTES = 8 * HTB, NXCD = 8, WGM = 8;

__host__ __device__ __forceinline__ int lds_byte(int r, int c) { const int st = (r >> 4) * 2 + (c >> 5), rr = r & 15, cc = c & 31, ob = rr * 64 + cc * 2; return st * 1024 + (ob ^ (((ob >> 9) & 1) << 5)); }
__host__ __device__ __forceinline__ void stage_rc(int b, int& R, int& C) { const int st = b / 1024, sb = b % 1024, swz = sb ^ (((sb >> 9) & 1) << 5); R = (st >> 1) * 16 + swz / 64; C = (st & 1) * 32 + (swz % 64) / 2; }
__host__ __device__ __forceinline__ int perm32(int rho) { const int n = rho >> 4, i = rho & 15; return 8 * (i >> 2) + 4 * n + (i & 3); }

struct Unit { int pm, pn; };
struct Gemm { const bf16_t* A; const bf16_t* Bt; int M, N, K; };

struct StaticOrder {
    int nM, nN, nwg, G, c;
    __host__ __device__ void init(int M, int N, int G_, int c_) { nM = M / BM; nN = N / BM; nwg = nM * nN; G = G_; c = c_; }
    __host__ __device__ bool next(int i, Unit& u) const {
        const long L = (long)i * G + c; if (L >= nwg) return false;
        int wgid = (int)L; { const int q = nwg / NXCD, r = nwg % NXCD, xcd = wgid % NXCD, off = wgid / NXCD; wgid = (xcd < r ? xcd * (q + 1) : r * (q + 1) + (xcd - r) * q) + off; }
        const int nig = WGM * nN, gid = wgid / nig, fm = gid * WGM, gsz = (nM - fm) < WGM ? (nM - fm) : WGM;
        u.pm = fm + ((wgid % nig) % gsz); u.pn = (wgid % nig) / gsz; return true;
    }
    __device__ __forceinline__ void a_ready(const Unit&) const {}
    __device__ __forceinline__ void done(const Unit&) const {}
};
__device__ __forceinline__ unsigned cvt_pk_bf16(float lo, float hi) { unsigned r; asm volatile("v_cvt_pk_bf16_f32 %0, %1, %2" : "=v"(r) : "v"(lo), "v"(hi)); return r; }
template <class Epi, class Sched>
__device__ __forceinline__ void gemm_phase(PG8_LAS unsigned char* lds, const Gemm g, const Sched& S, const Epi& E, const int tid_in) {
    const int tid = tid_in, wid = __builtin_amdgcn_readfirstlane(tid >> 6), lane = tid & 63, wr = wid >> 2, wc = wid & 3, fr = lane & 15, fq = lane >> 4;
    const int K = g.K, nt = K / BK;
    unsigned voffA[2], voffB[2];
#pragma unroll
    for (int i = 0; i < 2; ++i) { int R, C; stage_rc(tid * 16 + i * 8192, R, C); const int Rb = Epi::PERM ? ((R & ~31) + perm32(R & 31)) : R;
        voffA[i] = (unsigned)(R * K + C) * 2u; voffB[i] = (unsigned)(Rb * K + C) * 2u; }
    const size_t kstep = (size_t)(BK * 2);
    const size_t hstep = (size_t)HALF * K * 2;
    const size_t tstep = 2 * hstep;
    const unsigned ldsw = (unsigned)wid * 1024u;
    const int aoff = lds_byte(wr * 64 + fr, fq * 8), boff = lds_byte(wc * 32 + fr, fq * 8);
#define PG8_SA(b, h) (((b) * 2 + (h)) * HTB)
#define PG8_SB(b, h) ((4 + (b) * 2 + (h)) * HTB)
#define PG8_STAGE(bufoff, gbase, voff) do { _Pragma("unroll") for (int _i = 0; _i < 2; ++_i) \
        __builtin_amdgcn_global_load_lds((const unsigned*)((const char*)(gbase) + (voff)[_i]), (PG8_LAS unsigned*)(lds + (bufoff) + ldsw + _i * 8192), 16, 0, 0); } while (0)
#define PG8_LDA(dst, b, h) do { _Pragma("unroll") for (int m = 0; m < 4; ++m) _Pragma("unroll") for (int k = 0; k < 2; ++k) dst[m][k] = *(const PG8_LAS bf16x8*)(lds + PG8_SA(b, h) + aoff + m * 2048 + k * 1024); } while (0)
#define PG8_LDB(dst, b, h) do { _Pragma("unroll") for (int n = 0; n < 2; ++n) _Pragma("unroll") for (int k = 0; k < 2; ++k) dst[n][k] = *(const PG8_LAS bf16x8*)(lds + PG8_SB(b, h) + boff + n * 2048 + k * 1024); } while (0)
#define PG8_MMA(ai, bj, At, Bt) do { __builtin_amdgcn_s_setprio(1); _Pragma("unroll") for (int m = 0; m < 4; ++m) _Pragma("unroll") for (int n = 0; n < 2; ++n) _Pragma("unroll") for (int k = 0; k < 2; ++k) \
        acc[ai][bj][m][n] = __builtin_amdgcn_mfma_f32_16x16x32_bf16(Bt[n][k], At[m][k], acc[ai][bj][m][n], 0, 0, 0); __builtin_amdgcn_s_setprio(0); } while (0)
#define PG8_WAIT_V(n) asm volatile("s_waitcnt vmcnt(" #n ")" ::: "memory")
#define PG8_WAIT_L(n) asm volatile("s_waitcnt lgkmcnt(" #n ")" ::: "memory")
#define PG8_BAR __builtin_amdgcn_s_barrier()
#define PG8_SCHED __builtin_amdgcn_sched_barrier(0)
    Unit cur, nxt; int ui = 0;
    if (!S.next(0, cur)) return;
    f32x4 acc[2][2][4][2];
#pragma unroll
    for (int a = 0; a < 2; ++a)
#pragma unroll
        for (int b = 0; b < 2; ++b)
#pragma unroll
            for (int m = 0; m < 4; ++m)
#pragma unroll
                for (int n = 0; n < 2; ++n) acc[a][b][m][n] = (f32x4){0.f, 0.f, 0.f, 0.f};
    bf16x8 At[4][2], B0[2][2], B1[2][2];
    const char* cA = (const char*)g.A + (size_t)cur.pm * tstep; const char* cB = (const char*)g.Bt + (size_t)cur.pn * tstep;
    S.a_ready(cur);
    PG8_STAGE(PG8_SB(0, 0), cB, voffB); PG8_STAGE(PG8_SA(0, 0), cA, voffA); PG8_STAGE(PG8_SB(0, 1), cB + hstep, voffB); PG8_STAGE(PG8_SA(0, 1), cA + hstep, voffA);
    if (wr == 1) PG8_BAR;
    PG8_WAIT_V(4); PG8_BAR;
    PG8_STAGE(PG8_SB(1, 0), cB + kstep, voffB); PG8_STAGE(PG8_SA(1, 0), cA + kstep, voffA); PG8_STAGE(PG8_SB(1, 1), cB + hstep + kstep, voffB);
    PG8_WAIT_V(6); PG8_BAR;
    for (;;) {
        const bool has_next = S.next(ui + 1, nxt);
        const char* nA = has_next ? (const char*)g.A + (size_t)nxt.pm * tstep : cA; const char* nB = has_next ? (const char*)g.Bt + (size_t)nxt.pn * tstep : cB;
        for (int t = 0; t < nt; t += 2) {
            const bool last = (t == nt - 2);
            const char* a1 = cA + (size_t)(t + 1) * kstep;
            const char* a2 = last ? nA : cA + (size_t)(t + 2) * kstep; const char* b2 = last ? nB : cB + (size_t)(t + 2) * kstep;
            const char* a3 = a2 + kstep; const char* b3 = b2 + kstep;
            if (last && has_next) S.a_ready(nxt);
            PG8_LDB(B0, 0, 0); PG8_SCHED; PG8_LDA(At, 0, 0); PG8_STAGE(PG8_SA(1, 1), a1 + hstep, voffA);
            PG8_WAIT_L(8); PG8_BAR; PG8_WAIT_L(0); PG8_MMA(0, 0, At, B0); PG8_BAR; PG8_SCHED;
            PG8_LDB(B1, 0, 1); PG8_STAGE(PG8_SB(0, 0), b2, voffB);
            PG8_BAR; PG8_WAIT_L(0); PG8_MMA(0, 1, At, B1); PG8_BAR;
            PG8_LDA(At, 0, 1); PG8_STAGE(PG8_SA(0, 0), a2, voffA);
            PG8_BAR; PG8_WAIT_L(0); PG8_MMA(1, 0, At, B0); PG8_BAR; PG8_SCHED;
            PG8_STAGE(PG8_SB(0, 1), b2 + hstep, voffB);
            PG8_WAIT_V(6); PG8_BAR; PG8_MMA(1, 1, At, B1); PG8_BAR;
            PG8_LDB(B0, 1, 0); PG8_SCHED; PG8_LDA(At, 1, 0); PG8_STAGE(PG8_SA(0, 1), a2 + hstep, voffA);
            PG8_WAIT_L(8); PG8_BAR; PG8_WAIT_L(0); PG8_MMA(0, 0, At, B0); PG8_BAR; PG8_SCHED;
            PG8_LDB(B1, 1, 1); PG8_STAGE(PG8_SB(1, 0), b3, voffB);
            PG8_BAR; PG8_WAIT_L(0); PG8_MMA(0, 1, At, B1); PG8_BAR;
            PG8_LDA(At, 1, 1); PG8_STAGE(PG8_SA(1, 0), a3, voffA);
            PG8_BAR; PG8_WAIT_L(0); PG8_MMA(1, 0, At, B0); PG8_BAR; PG8_SCHED;
            PG8_STAGE(PG8_SB(1, 1), b3 + hstep, voffB);
            PG8_WAIT_V(6); PG8_BAR; PG8_MMA(1, 1, At, B1); PG8_BAR;
        }
        if constexpr (!Epi::AFTER_DRAIN) { E(acc, cur, wr, wc, fr, fq); S.done(cur); }
        if (!has_next) break;
#pragma unroll
        for (int a = 0; a < 2; ++a)
#pragma unroll
            for (int b = 0; b < 2; ++b)
#pragma unroll
                for (int m = 0; m < 4; ++m)
#pragma unroll
                    for (int n = 0; n < 2; ++n) acc[a][b][m][n] = (f32x4){0.f, 0.f, 0.f, 0.f};
        cur = nxt; cA = nA; cB = nB; ++ui;
    }
    PG8_WAIT_V(0);
    if (wr == 0) PG8_BAR;
    PG8_BAR;
    if constexpr (Epi::AFTER_DRAIN) { E.fused(acc, cur, wr, wc, fr, fq, lds, wid, lane); S.done(cur); }
#undef PG8_SA
#undef PG8_SB
#undef PG8_STAGE
#undef PG8_LDA
#undef PG8_LDB
#undef PG8_MMA
#undef PG8_WAIT_V
#undef PG8_WAIT_L
#undef PG8_BAR
#undef PG8_SCHED
}
}

#include <cstdio>
#include <ctime>
#include <cstdlib>
#include <cstring>
#include <cmath>
#include <vector>
#include <algorithm>

using pg8::bf16_t; using pg8::f32x4; using pg8::Unit;
typedef unsigned u32x2v __attribute__((ext_vector_type(2)));
typedef unsigned u32x4v __attribute__((ext_vector_type(4)));

constexpr int D = 2048, SEQ = 4096, NMETA = 16, L = 4112, M = 8224, MP = 8448, DFF = 5632, INC = 6176, INCP = 6400;
constexpr float EPS = 1e-6f;
constexpr int LDS_BYTES = 4 * (8336 * 2 + 2 * 65 * 144) + 256;
constexpr unsigned PROBE_MASK = 0u; constexpr int PROBE_K = 8;
constexpr int C_Q = 3072, C_K = 3584, C_V = 4096, C_OG = 5120, C_LR = 6144;

struct Params {
    const float *x, *meta, *ffn1_norm, *ffn1_wg, *ffn1_wu, *ffn1_wd, *mix_norm, *w_in, *conv_w, *conv_b,
        *filt_w1, *filt_b1, *filt_w2, *filt_b2, *filt_w3, *filt_freq, *hyena_d, *hyena_norm, *gk_w2, *gk_b2, *gla_norm, *w_out,
        *ffn2_norm, *ffn2_wg, *ffn2_wu, *ffn2_wd, *final_norm;
    float* out;
    bf16_t *Wgu1, *Wd1, *Win, *Wout, *Wgu2, *Wd2;
    float* h; bf16_t* hb; bf16_t* big; float* rowss; float* z2;
    bf16_t* y; bf16_t* yc; float* of; float* ob; unsigned char* gp; unsigned* ctr; bf16_t* uT; bf16_t* ZA; bf16_t* WB; bf16_t* GF; float* G0; unsigned* bar; int wave; int pad_;
};

__device__ __forceinline__ int lane_id() { return (int)__builtin_amdgcn_mbcnt_hi(~0u, __builtin_amdgcn_mbcnt_lo(~0u, 0u)); }
__device__ __forceinline__ int ltid_w(int wave) { int t = (wave << 6) | lane_id(); asm volatile("" : "+v"(t)); return t; }
__device__ __forceinline__ void lds_barrier() { asm volatile("s_waitcnt lgkmcnt(0)" ::: "memory"); __builtin_amdgcn_s_barrier(); asm volatile("" ::: "memory"); }
__device__ __forceinline__ float bf2f(bf16_t b) { return __uint_as_float(((unsigned)b) << 16); }
__device__ __forceinline__ unsigned pk2(float lo, float hi) { return pg8::cvt_pk_bf16(lo, hi); }
__device__ __forceinline__ bf16_t f2bf(float v) { return (bf16_t)(pk2(v, 0.f) & 0xffffu); }
template <int MSK> __device__ __forceinline__ float shx(float v) {
    if constexpr (MSK < 32) return __int_as_float(__builtin_amdgcn_ds_swizzle(__float_as_int(v), 0x1f | (MSK << 10)));
    else { int l = lane_id(); asm volatile("" : "+v"(l)); return __int_as_float(__builtin_amdgcn_ds_bpermute((l ^ 32) << 2, __float_as_int(v))); }
}
__device__ __forceinline__ float wave_sum(float v) { v += shx<32>(v); v += shx<16>(v); v += shx<8>(v); v += shx<4>(v); v += shx<2>(v); v += shx<1>(v); return v; }
__device__ __forceinline__ float silu_f(float x) { return x * __builtin_amdgcn_rcpf(1.0f + __expf(-x)); }

__device__ __forceinline__ float row_rscale(const float* rowss, int r, int fq) {
    const f32x4* q = (const f32x4*)(rowss + (size_t)r * 32 + fq * 8);
    const f32x4 a = q[0], b = q[1];
    float s = ((a[0] + a[1]) + (a[2] + a[3])) + ((b[0] + b[1]) + (b[2] + b[3]));
    s += shx<16>(s); s += shx<32>(s);
    return rsqrtf(s * (1.0f / D) + EPS);
}

struct EpiSwiglu {
    static constexpr bool PERM = true, AFTER_DRAIN = false;
    bf16_t* O; const float* rowss;
    __device__ __forceinline__ void operator()(const f32x4 (&acc)[2][2][4][2], const Unit& u, int wr, int wc, int fr, int fq) const {
        const int row0 = u.pm * 256 + wr * 64 + fr, col0 = u.pn * 128 + wc * 32 + 8 * fq;
#pragma unroll
        for (int ai = 0; ai < 2; ++ai)
#pragma unroll
            for (int m = 0; m < 4; ++m) {
                const int r = row0 + ai * 128 + m * 16; const float rs = row_rscale(rowss, r, fq);
                u32x4v w;
#pragma unroll
                for (int n = 0; n < 2; ++n) { const f32x4 g = acc[ai][0][m][n] * rs, uu = acc[ai][1][m][n] * rs;
                    w[2 * n] = pk2(silu_f(g[0]) * uu[0], silu_f(g[1]) * uu[1]); w[2 * n + 1] = pk2(silu_f(g[2]) * uu[2], silu_f(g[3]) * uu[3]); }
                *(u32x4v*)(O + (size_t)r * DFF + col0) = w;
            }
    }
};
struct EpiScale {
    static constexpr bool PERM = true, AFTER_DRAIN = false;
    bf16_t* O; int ldc; const float* rowss;
    __device__ __forceinline__ void operator()(const f32x4 (&acc)[2][2][4][2], const Unit& u, int wr, int wc, int fr, int fq) const {
        const int row0 = u.pm * 256 + wr * 64 + fr, col0 = u.pn * 256 + wc * 32 + 8 * fq;
#pragma unroll
        for (int ai = 0; ai < 2; ++ai)
#pragma unroll
            for (int m = 0; m < 4; ++m) {
                const int r = row0 + ai * 128 + m * 16; const float rs = row_rscale(rowss, r, fq);
#pragma unroll
                for (int bj = 0; bj < 2; ++bj) { const f32x4 a = acc[ai][bj][m][0] * rs, b = acc[ai][bj][m][1] * rs;
                    u32x4v w; w[0] = pk2(a[0], a[1]); w[1] = pk2(a[2], a[3]); w[2] = pk2(b[0], b[1]); w[3] = pk2(b[2], b[3]);
                    *(u32x4v*)(O + (size_t)r * ldc + col0 + bj * 128) = w; }
            }
    }
};
template <bool WHB> struct EpiResid {
    static constexpr bool PERM = true, AFTER_DRAIN = false;
    float* H; bf16_t* HB; float* rowss; float scale;
    __device__ __forceinline__ void operator()(const f32x4 (&acc)[2][2][4][2], const Unit& u, int wr, int wc, int fr, int fq) const {
        const int row0 = u.pm * 256 + wr * 64 + fr, col0 = u.pn * 256 + wc * 32 + 8 * fq;
#pragma unroll
        for (int ai = 0; ai < 2; ++ai)
#pragma unroll
            for (int m = 0; m < 4; ++m) {
                const int r = row0 + ai * 128 + m * 16; float ss = 0.f;
#pragma unroll
                for (int bj = 0; bj < 2; ++bj) { float* hp = H + (size_t)r * D + col0 + bj * 128;
                    f32x4 a = *(const f32x4*)hp, b = *(const f32x4*)(hp + 4);
                    a += acc[ai][bj][m][0] * scale; b += acc[ai][bj][m][1] * scale;
                    *(f32x4*)hp = a; *(f32x4*)(hp + 4) = b;
                    ss += (a[0] * a[0] + a[1] * a[1]) + (a[2] * a[2] + a[3] * a[3]) + (b[0] * b[0] + b[1] * b[1]) + (b[2] * b[2] + b[3] * b[3]);
                    if (WHB) { u32x4v w; w[0] = pk2(a[0], a[1]); w[1] = pk2(a[2], a[3]); w[2] = pk2(b[0], b[1]); w[3] = pk2(b[2], b[3]);
                        *(u32x4v*)(HB + (size_t)r * D + col0 + bj * 128) = w; } }
                ss += shx<16>(ss); ss += shx<32>(ss);
                if (WHB && fq == 0) rowss[(size_t)r * 32 + u.pn * 4 + wc] = ss;
            }
    }
};

constexpr int NT_FFN = 2816, NT_WIN = 3200, NT_WOUT = 1024, NT_TR = 6 * NT_FFN + NT_WIN + NT_WOUT, NT_ROWS = MP / 8, NT_Z2 = 4352 / 8, P0_ITEMS = NT_TR + NT_ROWS + NT_Z2;

__device__ __forceinline__ void transpose_mat(const float* src, bf16_t* dst, const float* gain, const int K, const int N, const int ld, const int nvalid, const int mode, float* tl, const int wave) {
    const int ntn = N / 64, ntiles = (K / 64) * ntn, tid = ltid_w(wave);
    for (int it = blockIdx.x; it < ntiles; it += gridDim.x) {
        const int kt = it / ntn, nt = it - kt * ntn, k0 = kt * 64, n0 = nt * 64;
        const long drow0 = mode == 0 ? n0 : (n0 / 128) * 256 + (n0 % 128) + (mode == 2 ? 128 : 0);
        { const int r = tid >> 4, c4 = (tid & 15) * 4;
#pragma unroll
          for (int i = 0; i < 2; ++i) { const int row = r + 32 * i, k = k0 + row, n = n0 + c4;
              f32x4 v = {0.f, 0.f, 0.f, 0.f};
              if (n < nvalid) v = *(const f32x4*)(src + (size_t)k * ld + n);
              const float g = gain ? gain[k] : 1.0f;
              float* t = tl + row * 65 + c4; t[0] = v[0] * g; t[1] = v[1] * g; t[2] = v[2] * g; t[3] = v[3] * g; } }
        lds_barrier();
        { const int n = tid >> 3, k8 = (tid & 7) * 8; float v[8];
#pragma unroll
          for (int j = 0; j < 8; ++j) v[j] = tl[(k8 + j) * 65 + n];
          u32x4v w; w[0] = pk2(v[0], v[1]); w[1] = pk2(v[2], v[3]); w[2] = pk2(v[4], v[5]); w[3] = pk2(v[6], v[7]);
          *(u32x4v*)(dst + (size_t)(drow0 + n) * K + k0 + k8) = w; }
        lds_barrier();
    }
}

__device__ void row_item(const Params& p, int item) {
    const int tid__ = ltid_w(p.wave), wid = tid__ >> 6, lane = tid__ & 63, m = item * 8 + wid;
    float* hrow = p.h + (size_t)m * D; bf16_t* hbrow = p.hb + (size_t)m * D;
    if (m < M) { const int b = m / L, t = m - b * L;
        const float* src = t < NMETA ? p.meta + (size_t)t * D : p.x + ((size_t)b * SEQ + t - NMETA) * D;
        float ss = 0.f;
#pragma unroll
        for (int i = 0; i < 8; ++i) { const int c = (lane + 64 * i) * 4; const f32x4 v = *(const f32x4*)(src + c);
            ss += (v[0] * v[0] + v[1] * v[1]) + (v[2] * v[2] + v[3] * v[3]);
            *(f32x4*)(hrow + c) = v; u32x2v w; w[0] = pk2(v[0], v[1]); w[1] = pk2(v[2], v[3]); *(u32x2v*)(hbrow + c) = w; }
        ss = wave_sum(ss);
        if (lane < 32) p.rowss[(size_t)m * 32 + lane] = lane == 0 ? ss : 0.f;
    } else {
#pragma unroll
        for (int i = 0; i < 8; ++i) { const int c = (lane + 64 * i) * 4; *(f32x4*)(hrow + c) = (f32x4){0.f, 0.f, 0.f, 0.f}; u32x2v w; w[0] = 0u; w[1] = 0u; *(u32x2v*)(hbrow + c) = w; }
        if (lane < 32) p.rowss[(size_t)m * 32 + lane] = 0.f;
    }
}

__device__ void z2_item(const Params& p, int item) {
    const int tid__ = ltid_w(p.wave), wid = tid__ >> 6, lane = tid__ & 63, j = item * 8 + wid;
    bf16_t* za = p.ZA + (size_t)j * 256;
    if (j >= L) { za[lane] = 0; za[64 + lane] = 0; za[128 + lane] = 0; za[192 + lane] = 0; return; }
    float feat = 0.f;
    const float w = (float)(2.0 * 3.14159265358979323846 / L) * (float)j;
    if (lane == 0) feat = (float)j * (1.0f / (float)(L - 1));
    else if (lane <= 32) { const int bi = (lane - 1) & 15; const float band = 1e-4f + (float)bi * ((15.0f - 1e-4f) / 15.0f); const float ang = w * band;
        feat = lane <= 16 ? cosf(ang) : -sinf(ang); }
    float a = p.filt_b1[lane];
    for (int i = 0; i < 33; ++i) a += __int_as_float(__builtin_amdgcn_readlane(__float_as_int(feat), i)) * p.filt_w1[i * 64 + lane];
    const float fr = p.filt_freq[lane];
    const float z1 = sinf(fr * a);
    float c = p.filt_b2[lane];
    for (int k = 0; k < 64; ++k) c += __int_as_float(__builtin_amdgcn_readlane(__float_as_int(z1), k)) * p.filt_w2[k * 64 + lane];
    const float z = sinf(fr * c);
    const bf16_t hi = f2bf(z), lo = f2bf(z - bf2f(hi));
    za[lane] = hi; za[64 + lane] = lo; za[128 + lane] = hi; za[192 + lane] = 0;
}
__device__ void wb_items(const Params& p) {
    for (int idx = blockIdx.x * 512 + ltid_w(p.wave); idx < 2048 * 64; idx += gridDim.x * 512) { const int n = idx >> 6, k = idx & 63;
        const float w = p.filt_w3[(size_t)k * 2048 + n]; const bf16_t hi = f2bf(w), lo = f2bf(w - bf2f(hi));
        bf16_t* wb = p.WB + (size_t)n * 256; wb[k] = hi; wb[64 + k] = hi; wb[128 + k] = lo; wb[192 + k] = 0; }
}
struct EpiFilt {
    static constexpr bool PERM = true, AFTER_DRAIN = false;
    bf16_t* GF; float* G0;
    __device__ __forceinline__ void operator()(const f32x4 (&acc)[2][2][4][2], const Unit& u, int wr, int wc, int fr, int fq) const {
        const int row0 = u.pm * 256 + wr * 64 + fr, col0 = u.pn * 256 + wc * 32 + 8 * fq;
        const float la = -3.0701134573253945f, lb = -15.350567286626973f;
#pragma unroll
        for (int ai = 0; ai < 2; ++ai)
#pragma unroll
            for (int m = 0; m < 4; ++m) { const int n = row0 + ai * 128 + m * 16; const float delta = fabsf(la + (float)(n & 1023) * ((lb - la) / 1023.0f)) * (1.0f / (float)(L - 1));
                const float r1 = __expf(-delta), r2 = r1 * r1, r3 = r2 * r1;
                bf16_t* grow = GF + (size_t)n * 4352 + col0;
#pragma unroll
                for (int bj = 0; bj < 2; ++bj)
#pragma unroll
                    for (int nn = 0; nn < 2; ++nn) { const int j0 = col0 + bj * 128 + 4 * nn; const f32x4 a4 = acc[ai][bj][m][nn];
                        const float w0 = __expf(-(float)j0 * delta);
                        const float v0 = a4[0] * w0, v1 = a4[1] * (w0 * r1), v2 = a4[2] * (w0 * r2), v3 = a4[3] * (w0 * r3);
                        u32x2v w; w[0] = pk2(v0, v1); w[1] = pk2(v2, v3);
                        *(u32x2v*)(grow + bj * 128 + 4 * nn) = w;
                        if (j0 == 0) G0[n] = v0; } }

    }
};

constexpr int HY_G_ELEMS = 8336, HY_G_BYTES = HY_G_ELEMS * 2, HY_USTR = 144, HY_U_BYTES = 65 * HY_USTR, HY_CH_BYTES = HY_G_BYTES + 2 * HY_U_BYTES, HY_ZERO_OFF = 4 * HY_CH_BYTES;
static_assert(HY_ZERO_OFF + 256 <= LDS_BYTES, "lds");
static_assert(HY_CH_BYTES % 16 == 0 && HY_G_BYTES % 16 == 0, "align");
__device__ void hyu_item(const Params& p, int item, unsigned char* sm) {
    const int cb = item & 3, bt = item >> 2, b = bt / 65, tile = bt - b * 65, t0 = tile * 64;
    const int tid = ltid_w(p.wave), tl = tid & 63, qg = tid >> 6, t = t0 + tl;
    bf16_t* LT = (bf16_t*)sm;
#pragma unroll 1
    for (int x = 0; x < 4; ++x) { const int q = qg * 4 + x, c8 = cb * 256 + q * 8;
        float a1[8], a2[8];
#pragma unroll
        for (int h2 = 0; h2 < 2; ++h2) { const f32x4 b1 = *(const f32x4*)(p.conv_b + 1024 + c8 + 4 * h2), b2v = *(const f32x4*)(p.conv_b + 2048 + c8 + 4 * h2);
#pragma unroll
            for (int e = 0; e < 4; ++e) { a1[4 * h2 + e] = b1[e]; a2[4 * h2 + e] = b2v[e]; } }
        {
#pragma unroll
            for (int jj = 0; jj < 3; ++jj) { const int t2 = t + jj - 1; const bool ok = t < L && t2 >= 0 && t2 < L; const int t2c = t2 < 0 ? 0 : (t2 >= L ? L - 1 : t2);
                { const bf16_t* row = p.big + (size_t)(b * L + t2c) * INCP + c8;
                    const u32x4v x1 = *(const u32x4v*)(row + 1024), vh = *(const u32x4v*)(row + 2048); const float okf = ok ? 1.f : 0.f;
#pragma unroll
                    for (int h2 = 0; h2 < 2; ++h2) { const f32x4 w1 = *(const f32x4*)(p.conv_w + jj * 3072 + 1024 + c8 + 4 * h2) * okf, w2 = *(const f32x4*)(p.conv_w + jj * 3072 + 2048 + c8 + 4 * h2) * okf;
                        a1[4 * h2] += __uint_as_float(x1[2 * h2] << 16) * w1[0]; a1[4 * h2 + 1] += __uint_as_float(x1[2 * h2] & 0xffff0000u) * w1[1];
                        a1[4 * h2 + 2] += __uint_as_float(x1[2 * h2 + 1] << 16) * w1[2]; a1[4 * h2 + 3] += __uint_as_float(x1[2 * h2 + 1] & 0xffff0000u) * w1[3];
                        a2[4 * h2] += __uint_as_float(vh[2 * h2] << 16) * w2[0]; a2[4 * h2 + 1] += __uint_as_float(vh[2 * h2] & 0xffff0000u) * w2[1];
                        a2[4 * h2 + 2] += __uint_as_float(vh[2 * h2 + 1] << 16) * w2[2]; a2[4 * h2 + 3] += __uint_as_float(vh[2 * h2 + 1] & 0xffff0000u) * w2[3]; } } }
        }
#pragma unroll
        for (int e = 0; e < 8; ++e) LT[(q * 8 + e) * 72 + tl] = t < L ? (bf16_t)(pk2(a1[e] * a2[e], 0.f) & 0xffffu) : (bf16_t)0;
    }
    lds_barrier();
    { const int row = tid >> 1, half = tid & 1; bf16_t* dst = p.uT + ((size_t)(cb * 256 + row) * 2 + b) * 4160 + t0 + half * 32;
#pragma unroll
      for (int i = 0; i < 4; ++i) *(u32x4v*)(dst + 8 * i) = *(const u32x4v*)(LT + row * 72 + half * 32 + 8 * i); }
    lds_barrier();
}
__device__ void hyena_group(const Params& p, int grp_, unsigned char* sm, unsigned long long& tsec) {
    unsigned long long ts0_ = PROBE_MASK ? wall_clock64() : 0ull;
#define HSEC(i) do { if (PROBE_MASK) { const unsigned long long t_ = wall_clock64(); if ((PROBE_MASK >> (i)) & 1u) tsec += t_ - ts0_; ts0_ = t_; } } while (0)
    const int grp = __builtin_amdgcn_readfirstlane(grp_);
    const int tid = ltid_w(p.wave), wid = tid >> 6, lane = tid & 63, c0 = grp * 4;
    { const unsigned char* src = (const unsigned char*)(p.uT + (size_t)c0 * 2 * 4160);
      for (int idx = tid; idx < 8 * 520; idx += 512) { const int r = idx / 520, i = idx - r * 520;
          *(u32x4v*)(sm + (r >> 1) * HY_CH_BYTES + HY_G_BYTES + (r & 1) * HY_U_BYTES + (i >> 3) * HY_USTR + (i & 7) * 16) = *(const u32x4v*)(src + (size_t)idx * 16); } }
    if (tid < 36) ((unsigned*)(sm + HY_ZERO_OFF))[tid] = 0u;
    for (int i = tid; i < 4 * 113; i += 512) { const int ch = i / 113, q = i - ch * 113; const int idx = q < 49 ? q : 8272 + (q - 49);
        *(unsigned short*)(sm + ch * HY_CH_BYTES + 2 * idx) = 0; }
    for (int idx = tid; idx < 4 * 514; idx += 512) { const int ch = idx / 514, pc = idx - ch * 514, j0 = pc * 8;
        unsigned short* gb = (unsigned short*)(sm + ch * HY_CH_BYTES);
        const u32x4v f = *(const u32x4v*)(p.GF + (size_t)(c0 + ch) * 4352 + j0); u32x4v bk = *(const u32x4v*)(p.GF + (size_t)(1024 + c0 + ch) * 4352 + j0);
        if (pc == 0) bk[0] = (bk[0] & 0xffff0000u) | (pk2(p.G0[c0 + ch] + p.G0[1024 + c0 + ch], 0.f) & 0xffffu);
        *(u32x4v*)(gb + 4160 + j0) = bk;
#pragma unroll
        for (int e = 0; e < 8; ++e) if (pc != 0 || e != 0) gb[4160 - j0 - e] = (unsigned short)((e & 1) ? (f[e >> 1] >> 16) : (f[e >> 1] & 0xffffu)); }
    lds_barrier();
    HSEC(12);
    const int ch = wid >> 1, b = wid & 1, li = lane & 15, kq = lane >> 4;
    unsigned char* Ub = sm + ch * HY_CH_BYTES + HY_G_BYTES + b * HY_U_BYTES;
    const unsigned char* Zb = sm + HY_ZERO_OFF + kq * 16;
    f32x4 acc[4][5];
#pragma unroll
    for (int rb = 0; rb < 4; ++rb)
#pragma unroll
        for (int nb = 0; nb < 5; ++nb) acc[rb][nb] = (f32x4){0.f, 0.f, 0.f, 0.f};
    const unsigned shl = (li & 1) ? 16u : 0u;
    unsigned gq[5];
#pragma unroll
    for (int w = 0; w < 5; ++w) { unsigned t_ = (unsigned)(ch * HY_CH_BYTES + 4 * (((4160 + 8 * kq - li) >> 1) + w)); asm volatile("" : "+v"(t_)); gq[w] = t_; }
    PG8_LAS const unsigned char* sml = (PG8_LAS const unsigned char*)sm;
    auto gfrag = [&](int mp) -> pg8::bf16x8 {
        unsigned e[5];
#pragma unroll
        for (int w = 0; w < 5; ++w) e[w] = *(PG8_LAS const unsigned*)(sml + (gq[w] - 32 * mp));
        u32x4v r;
#pragma unroll
        for (int w = 0; w < 4; ++w) r[w] = __builtin_amdgcn_alignbit(e[w + 1], e[w], shl);
        return __builtin_bit_cast(pg8::bf16x8, r);
    };
    pg8::bf16x8 F[6];
    F[4] = gfrag(4 * (-64) - 2); F[5] = gfrag(4 * (-64) - 1);
    for (int d = -64; d <= 64; ++d) {
        F[0] = F[4]; F[1] = F[5];
#pragma unroll
        for (int q = 2; q < 6; ++q) F[q] = gfrag(4 * d - 2 + q);
        const int nb_lo = d > 0 ? (d >> 4) : 0, nb_hi = (d + 64) >> 4;
#pragma unroll
        for (int nb = 0; nb < 5; ++nb) {
            if (nb >= nb_lo && nb <= nb_hi) {
                const int sblk = 16 * nb + li - d;
                const unsigned char* up = ((unsigned)sblk < 65u) ? (Ub + sblk * HY_USTR + kq * 16) : Zb;
                const pg8::bf16x8 B0 = *(const pg8::bf16x8*)up, B1 = *(const pg8::bf16x8*)(up + 64);
#pragma unroll
                for (int rb = 0; rb < 4; ++rb) {
                    acc[rb][nb] = __builtin_amdgcn_mfma_f32_16x16x32_bf16(F[rb + 2], B0, acc[rb][nb], 0, 0, 0);
                    acc[rb][nb] = __builtin_amdgcn_mfma_f32_16x16x32_bf16(F[rb], B1, acc[rb][nb], 0, 0, 0);
                }
            }
        }
    }
    HSEC(13);
    {
        const float dc = p.hyena_d[c0 + ch];
#pragma unroll
        for (int nb = 0; nb < 5; ++nb) { const int t1 = 16 * nb + li;
            if (t1 < 65) {
#pragma unroll
                for (int rb = 0; rb < 4; ++rb) { unsigned char* up = Ub + t1 * HY_USTR + (16 * rb + 4 * kq) * 2;
                    const u32x2v uu = *(const u32x2v*)up; const f32x4 a = acc[rb][nb];
                    u32x2v w; w[0] = pk2(a[0] + dc * __uint_as_float(uu[0] << 16), a[1] + dc * __uint_as_float(uu[0] & 0xffff0000u));
                    w[1] = pk2(a[2] + dc * __uint_as_float(uu[1] << 16), a[3] + dc * __uint_as_float(uu[1] & 0xffff0000u));
                    *(u32x2v*)up = w; } } }
    }
    lds_barrier();
    for (int tt = tid; tt < 2 * L; tt += 512) { const int bb = tt >= L ? 1 : 0, t = tt - bb * L;
        const unsigned char* up = sm + HY_G_BYTES + bb * HY_U_BYTES + (t >> 6) * HY_USTR + (t & 63) * 2;
        const unsigned v0 = *(const unsigned short*)up, v1 = *(const unsigned short*)(up + HY_CH_BYTES), v2 = *(const unsigned short*)(up + 2 * HY_CH_BYTES), v3 = *(const unsigned short*)(up + 3 * HY_CH_BYTES);
        u32x2v w; w[0] = v0 | (v1 << 16); w[1] = v2 | (v3 << 16);
        *(u32x2v*)(p.yc + (size_t)(bb * L + t) * 1024 + c0) = w; }
    lds_barrier();
    HSEC(14);
}

constexpr int GP_QT = 0, GP_KT = 16384, GP_AM = 32768, GP_DEC = 40960, GP_STRIDE = 41472;
__device__ void gla_pre(const Params& p, int item, unsigned char* sm) {
    const int n = item % 65, bdh = item / 65, hh = bdh & 3, dir = (bdh >> 2) & 1, b = bdh >> 3;
    const int tid = ltid_w(p.wave), d = tid & 127, seg = tid >> 7, lane = tid & 63, wid = tid >> 6, li = lane & 15, kq = lane >> 4;
    float* LR = (float*)sm; float* SEGT = LR + 1024; bf16_t* QS = (bf16_t*)(sm + 8192); bf16_t* KS = QS + 64 * 136;
    unsigned char* gp = p.gp + (size_t)item * GP_STRIDE;
    { const int i = tid >> 3, r2 = (tid & 7) * 2; const int tau = dir ? 4159 - (64 * n + i) : 64 * n + i; float v0 = 0.f, v1 = 0.f;
      { const unsigned w = *(const unsigned*)(p.big + (size_t)(b * L + (tau < 48 ? 0 : tau - 48)) * INCP + C_LR + dir * 16 + r2); if (tau >= 48) { v0 = __uint_as_float(w << 16); v1 = __uint_as_float(w & 0xffff0000u); } }
      LR[i * 16 + r2] = v0; LR[i * 16 + r2 + 1] = v1; }
    float w2[16];
#pragma unroll
    for (int r = 0; r < 16; ++r) w2[r] = p.gk_w2[(size_t)(dir * 16 + r) * 512 + hh * 128 + d];
    const float b2 = p.gk_b2[dir * 512 + hh * 128 + d];
    unsigned short qraw[16], kraw[16];
#pragma unroll
    for (int ii = 0; ii < 16; ++ii) { const int i = seg * 16 + ii; const int tau = dir ? 4159 - (64 * n + i) : 64 * n + i; const int tc = tau < 48 ? 0 : tau - 48;
        const bf16_t* row = p.big + (size_t)(b * L + tc) * INCP + hh * 128 + d; qraw[ii] = row[C_Q]; kraw[ii] = row[C_K];
        if (tau < 48) { qraw[ii] = 0; kraw[ii] = 0; } }
    lds_barrier();
    float cs[16]; float run = 0.f;
#pragma unroll
    for (int ii = 0; ii < 16; ++ii) { const int i = seg * 16 + ii; const int tau = dir ? 4159 - (64 * n + i) : 64 * n + i;
        float xg = b2;
#pragma unroll
        for (int r4 = 0; r4 < 4; ++r4) { const f32x4 l4 = *(const f32x4*)(LR + i * 16 + 4 * r4); xg += l4[0] * w2[4 * r4] + l4[1] * w2[4 * r4 + 1] + l4[2] * w2[4 * r4 + 2] + l4[3] * w2[4 * r4 + 3]; }
        const float lg = tau >= 48 ? (fminf(xg, 0.f) - __logf(1.0f + __expf(-fabsf(xg)))) * (1.0f / 16.0f) : 0.f;
        run += lg; cs[ii] = run; }
    SEGT[seg * 128 + d] = run;
    lds_barrier();
    float off = 0.f, tot = 0.f;
#pragma unroll
    for (int s = 0; s < 4; ++s) { const float v = SEGT[s * 128 + d]; if (s < seg) off += v; tot += v; }
    unsigned kt[8];
#pragma unroll
    for (int ii = 0; ii < 16; ii += 2) { float kh[2];
#pragma unroll
        for (int x = 0; x < 2; ++x) { const int i = seg * 16 + ii + x; const float q = bf2f(qraw[ii + x]), k = bf2f(kraw[ii + x]);
            const float bi = off + cs[ii + x]; const bf16_t qv = f2bf(q * 0.08838834764831845f * __expf(bi));
            QS[i * 136 + d] = qv; KS[i * 136 + d] = f2bf(k * __expf(-bi)); *(bf16_t*)(gp + GP_QT + (i * 128 + d) * 2) = qv; kh[x] = k * __expf(tot - bi); }
        kt[ii >> 1] = pk2(kh[0], kh[1]); }
    { u32x4v w0, w1; w0[0] = kt[0]; w0[1] = kt[1]; w0[2] = kt[2]; w0[3] = kt[3]; w1[0] = kt[4]; w1[1] = kt[5]; w1[2] = kt[6]; w1[3] = kt[7];
      *(u32x4v*)(gp + GP_KT + (d * 64 + seg * 16) * 2) = w0; *(u32x4v*)(gp + GP_KT + (d * 64 + seg * 16 + 8) * 2) = w1; }
    if (seg == 0) *(float*)(gp + GP_DEC + d * 4) = __expf(tot);
    lds_barrier();
    { const int it = wid >> 1;
#pragma unroll
      for (int x = 0; x < 2; ++x) { const int jt = (wid & 1) * 2 + x; f32x4 acc = {0.f, 0.f, 0.f, 0.f};
#pragma unroll
          for (int ks = 0; ks < 4; ++ks) { const pg8::bf16x8 a = *(const pg8::bf16x8*)(QS + (16 * it + li) * 136 + 32 * ks + 8 * kq), bb = *(const pg8::bf16x8*)(KS + (16 * jt + li) * 136 + 32 * ks + 8 * kq);
              acc = __builtin_amdgcn_mfma_f32_16x16x32_bf16(a, bb, acc, 0, 0, 0); }
#pragma unroll
          for (int r = 0; r < 4; ++r) { const int i = 16 * it + 4 * kq + r, j = 16 * jt + li; *(bf16_t*)(gp + GP_AM + (i * 64 + j) * 2) = f2bf(j <= i ? acc[r] : 0.f); } } }
    lds_barrier();
}

__device__ void gla_scan(const Params& p, int item, unsigned char* sm) {
    const int s = item & 7, bdh = item >> 3, hh = bdh & 3, dir = (bdh >> 2) & 1, b = bdh >> 3;
    const int tid = ltid_w(p.wave), lane = tid & 63, wid = tid >> 6, li = lane & 15, kq = lane >> 4;
    constexpr int O_VT = 0, SZ_VT = 32 * 72 * 2, O_ST = 2 * SZ_VT;
    float* outp = dir ? p.ob : p.of;
    const unsigned char* gbase = p.gp + (size_t)(bdh * 65) * GP_STRIDE;
    const int it = wid >> 1, eto = wid & 1;
    struct RS { u32x4v fa[2], fq[4], fk[2], v; f32x4 dec; };
    auto LOAD = [&](int n, RS& R) {
        const unsigned char* g = gbase + (size_t)n * GP_STRIDE;
#pragma unroll
        for (int ks = 0; ks < 2; ++ks) R.fa[ks] = *(const u32x4v*)(g + GP_AM + ((16 * it + li) * 64 + 32 * ks + 8 * kq) * 2);
#pragma unroll
        for (int ks = 0; ks < 4; ++ks) R.fq[ks] = *(const u32x4v*)(g + GP_QT + ((16 * it + li) * 128 + 32 * ks + 8 * kq) * 2);
#pragma unroll
        for (int ks = 0; ks < 2; ++ks) R.fk[ks] = *(const u32x4v*)(g + GP_KT + ((16 * wid + li) * 64 + 32 * ks + 8 * kq) * 2);
        R.dec = *(const f32x4*)(g + GP_DEC + (16 * wid + 4 * kq) * 4);
        const int tau = dir ? 4159 - (64 * n + lane) : 64 * n + lane;
        R.v = (u32x4v){0u, 0u, 0u, 0u};
        if (wid < 4) R.v = *(const u32x4v*)(p.big + (size_t)(b * L + (tau < 48 ? 0 : tau - 48)) * INCP + C_V + hh * 256 + s * 32 + wid * 8);
    };
    auto PUTV = [&](int buf, const RS& R) {
        if (wid < 4) { bf16_t* vt = (bf16_t*)(sm + O_VT + buf * SZ_VT);
#pragma unroll
            for (int x = 0; x < 4; ++x) { vt[(wid * 8 + 2 * x) * 72 + lane] = (bf16_t)(R.v[x] & 0xffffu); vt[(wid * 8 + 2 * x + 1) * 72 + lane] = (bf16_t)(R.v[x] >> 16); } }
    };
    f32x4 S[2];
    S[0] = (f32x4){0.f, 0.f, 0.f, 0.f}; S[1] = S[0];
    for (int i = tid; i < 8704 / 16; i += 512) *(u32x4v*)(sm + O_ST + i * 16) = (u32x4v){0u, 0u, 0u, 0u};
    const bf16_t* ST = (const bf16_t*)(sm + O_ST);
    auto STEP = [&](int n, RS& RA, const RS& RB, RS& RC) {
        if (n + 2 < 65) LOAD(n + 2, RC);
        const bf16_t* VT = (const bf16_t*)(sm + O_VT + (n & 1) * SZ_VT);
        { f32x4 o = {0.f, 0.f, 0.f, 0.f};
#pragma unroll
          for (int ks = 0; ks < 2; ++ks) { const pg8::bf16x8 bb = *(const pg8::bf16x8*)(VT + (16 * eto + li) * 72 + 32 * ks + 8 * kq);
              o = __builtin_amdgcn_mfma_f32_16x16x32_bf16(__builtin_bit_cast(pg8::bf16x8, RA.fa[ks]), bb, o, 0, 0, 0); }
#pragma unroll
          for (int ks = 0; ks < 4; ++ks) { const pg8::bf16x8 bb = *(const pg8::bf16x8*)(ST + (16 * eto + li) * 136 + 32 * ks + 8 * kq);
              o = __builtin_amdgcn_mfma_f32_16x16x32_bf16(__builtin_bit_cast(pg8::bf16x8, RA.fq[ks]), bb, o, 0, 0, 0); }
#pragma unroll
          for (int r = 0; r < 4; ++r) { const int i = 16 * it + 4 * kq + r; const int tau = dir ? 4159 - (64 * n + i) : 64 * n + i;
              if (tau >= 48) outp[(size_t)(b * L + tau - 48) * 1024 + hh * 256 + s * 32 + 16 * eto + li] = o[r]; } }
#pragma unroll
        for (int et = 0; et < 2; ++et) { S[et] *= RA.dec;
#pragma unroll
            for (int ks = 0; ks < 2; ++ks) { const pg8::bf16x8 bb = *(const pg8::bf16x8*)(VT + (16 * et + li) * 72 + 32 * ks + 8 * kq);
                S[et] = __builtin_amdgcn_mfma_f32_16x16x32_bf16(__builtin_bit_cast(pg8::bf16x8, RA.fk[ks]), bb, S[et], 0, 0, 0); } }
        lds_barrier();
#pragma unroll
        for (int et = 0; et < 2; ++et) { u32x2v w; w[0] = pk2(S[et][0], S[et][1]); w[1] = pk2(S[et][2], S[et][3]);
            *(u32x2v*)(sm + O_ST + ((16 * et + li) * 136 + 16 * wid + 4 * kq) * 2) = w; }
        if (n + 1 < 65) PUTV((n + 1) & 1, RB);
        lds_barrier();
    };
    RS R0, R1, R2;
    LOAD(0, R0); LOAD(1, R1);
    PUTV(0, R0);
    lds_barrier();
    for (int n = 0; n < 63; n += 3) { STEP(n, R0, R1, R2); STEP(n + 1, R1, R2, R0); STEP(n + 2, R2, R0, R1); }
    STEP(63, R0, R1, R2); STEP(64, R1, R2, R0);
}

__device__ void fin_item(const Params& p, int item) {
    const int tid__ = ltid_w(p.wave), wid = tid__ >> 6, lane = tid__ & 63, m = item * 8 + wid;
    bf16_t* yrow = p.y + (size_t)m * D;
    if (m >= M) { const u32x4v z = {0u, 0u, 0u, 0u};
#pragma unroll
        for (int i = 0; i < 4; ++i) *(u32x4v*)(yrow + (lane + 64 * i) * 8) = z;
        return; }
    const int c0 = lane * 16;
    {
      const int b = m >= L ? 1 : 0, t = m - b * L;
      float x0[16];
#pragma unroll
      for (int i = 0; i < 4; ++i) { const f32x4 cb = *(const f32x4*)(p.conv_b + c0 + 4 * i); x0[4 * i] = cb[0]; x0[4 * i + 1] = cb[1]; x0[4 * i + 2] = cb[2]; x0[4 * i + 3] = cb[3]; }
#pragma unroll
      for (int jj = 0; jj < 3; ++jj) { const int t2 = t + jj - 1; const bool ok = t2 >= 0 && t2 < L; const int t2c = t2 < 0 ? 0 : (t2 >= L ? L - 1 : t2);
          { const bf16_t* row = p.big + (size_t)(b * L + t2c) * INCP + c0; const u32x4v r0 = *(const u32x4v*)row, r1 = *(const u32x4v*)(row + 8); const float okf = ok ? 1.f : 0.f;
#pragma unroll
              for (int i = 0; i < 4; ++i) { const f32x4 cw = *(const f32x4*)(p.conv_w + jj * 3072 + c0 + 4 * i) * okf; const unsigned lo = i < 2 ? r0[2 * i] : r1[2 * i - 4], hi = i < 2 ? r0[2 * i + 1] : r1[2 * i - 3];
                  x0[4 * i] += __uint_as_float(lo << 16) * cw[0]; x0[4 * i + 1] += __uint_as_float(lo & 0xffff0000u) * cw[1]; x0[4 * i + 2] += __uint_as_float(hi << 16) * cw[2]; x0[4 * i + 3] += __uint_as_float(hi & 0xffff0000u) * cw[3]; } } }
      const bf16_t* src = p.yc + (size_t)m * 1024 + c0; const u32x4v y0 = *(const u32x4v*)src, y1 = *(const u32x4v*)(src + 8);
      f32x4 v[4]; float ss = 0.f;
#pragma unroll
      for (int i = 0; i < 4; ++i) { const unsigned lo = i < 2 ? y0[2 * i] : y1[2 * i - 4], hi = i < 2 ? y0[2 * i + 1] : y1[2 * i - 3];
          v[i][0] = __uint_as_float(lo << 16) * x0[4 * i]; v[i][1] = __uint_as_float(lo & 0xffff0000u) * x0[4 * i + 1]; v[i][2] = __uint_as_float(hi << 16) * x0[4 * i + 2]; v[i][3] = __uint_as_float(hi & 0xffff0000u) * x0[4 * i + 3];
          ss += (v[i][0] * v[i][0] + v[i][1] * v[i][1]) + (v[i][2] * v[i][2] + v[i][3] * v[i][3]); }
      ss += shx<1>(ss); ss += shx<2>(ss); ss += shx<4>(ss);
      const float r = rsqrtf(ss * (1.0f / 128.0f) + EPS);
      u32x4v w0, w1;
#pragma unroll
      for (int i = 0; i < 4; ++i) { const f32x4 g = *(const f32x4*)(p.hyena_norm + c0 + 4 * i); const f32x4 o = v[i] * r * g;
          if (i < 2) { w0[2 * i] = pk2(o[0], o[1]); w0[2 * i + 1] = pk2(o[2], o[3]); } else { w1[2 * i - 4] = pk2(o[0], o[1]); w1[2 * i - 3] = pk2(o[2], o[3]); } }
      *(u32x4v*)(yrow + c0) = w0; *(u32x4v*)(yrow + c0 + 8) = w1; }
    { const float* s1 = p.of + (size_t)m * 1024 + c0; const float* s2 = p.ob + (size_t)m * 1024 + c0; f32x4 v[4]; float ss = 0.f;
#pragma unroll
      for (int i = 0; i < 4; ++i) { v[i] = *(const f32x4*)(s1 + 4 * i) + *(const f32x4*)(s2 + 4 * i); ss += (v[i][0] * v[i][0] + v[i][1] * v[i][1]) + (v[i][2] * v[i][2] + v[i][3] * v[i][3]); }
      ss += shx<1>(ss); ss += shx<2>(ss); ss += shx<4>(ss); ss += shx<8>(ss);
      const float r = rsqrtf(ss * (1.0f / 256.0f) + EPS);
      const bf16_t* og = p.big + (size_t)m * INCP + C_OG + c0;
      const u32x4v g0 = *(const u32x4v*)og, g1 = *(const u32x4v*)(og + 8);
      float ogf[16];
#pragma unroll
      for (int i = 0; i < 4; ++i) { ogf[2 * i] = __uint_as_float(g0[i] << 16); ogf[2 * i + 1] = __uint_as_float(g0[i] & 0xffff0000u); ogf[8 + 2 * i] = __uint_as_float(g1[i] << 16); ogf[8 + 2 * i + 1] = __uint_as_float(g1[i] & 0xffff0000u); }
      u32x4v w0, w1;
#pragma unroll
      for (int i = 0; i < 4; ++i) { const f32x4 g = *(const f32x4*)(p.gla_norm + ((c0 + 4 * i) & 255)); f32x4 o = v[i] * r * g;
          o[0] *= silu_f(ogf[4 * i]); o[1] *= silu_f(ogf[4 * i + 1]); o[2] *= silu_f(ogf[4 * i + 2]); o[3] *= silu_f(ogf[4 * i + 3]);
          if (i < 2) { w0[2 * i] = pk2(o[0], o[1]); w0[2 * i + 1] = pk2(o[2], o[3]); } else { w1[2 * i - 4] = pk2(o[0], o[1]); w1[2 * i - 3] = pk2(o[2], o[3]); } }
      *(u32x4v*)(yrow + 1024 + c0) = w0; *(u32x4v*)(yrow + 1024 + c0 + 8) = w1; }
}

__device__ void final_item(const Params& p, int item) {
    const int tid__ = ltid_w(p.wave), wid = tid__ >> 6, lane = tid__ & 63, row = item * 8 + wid, b = row >> 12, s = row & 4095, m = b * L + NMETA + s;
    const float* hrow = p.h + (size_t)m * D; float* orow = p.out + (size_t)row * D; f32x4 v[8]; float ss = 0.f;
#pragma unroll
    for (int i = 0; i < 8; ++i) { v[i] = *(const f32x4*)(hrow + (lane + 64 * i) * 4); ss += (v[i][0] * v[i][0] + v[i][1] * v[i][1]) + (v[i][2] * v[i][2] + v[i][3] * v[i][3]); }
    ss = wave_sum(ss); const float r = rsqrtf(ss * (1.0f / D) + EPS);
#pragma unroll
    for (int i = 0; i < 8; ++i) { const int c = (lane + 64 * i) * 4; *(f32x4*)(orow + c) = v[i] * r * *(const f32x4*)(p.final_norm + c); }
}

template <class TEpi> __device__ __forceinline__ void tail_tile(const bf16_t* A, int arow0, const bf16_t* Bt, int brow0, int brow1, const int K, float* red, const TEpi& E, int c, const int wave) {
    const int tid = ltid_w(wave), wid = tid >> 6, lane = tid & 63, li = lane & 15, kq = lane >> 4;
    const int kw = K >> 3, k0 = wid * kw;
    const bf16_t* ap = A + (size_t)(arow0 + li) * K + k0 + 8 * kq;
    const bf16_t* bp0 = Bt + (size_t)(brow0 + li) * K + k0 + 8 * kq;
    const bf16_t* bp1 = Bt + (size_t)(brow1 + li) * K + k0 + 8 * kq;
    f32x4 acc[2][4];
#pragma unroll
    for (int x = 0; x < 2; ++x)
#pragma unroll
        for (int y = 0; y < 4; ++y) acc[x][y] = (f32x4){0.f, 0.f, 0.f, 0.f};
#pragma unroll 4
    for (int k = 0; k < kw; k += 32) {
        pg8::bf16x8 a[2], bfr[4];
        a[0] = *(const pg8::bf16x8*)(ap + k); a[1] = *(const pg8::bf16x8*)(ap + (size_t)16 * K + k);
        bfr[0] = *(const pg8::bf16x8*)(bp0 + k); bfr[1] = *(const pg8::bf16x8*)(bp0 + (size_t)16 * K + k);
        bfr[2] = *(const pg8::bf16x8*)(bp1 + k); bfr[3] = *(const pg8::bf16x8*)(bp1 + (size_t)16 * K + k);
#pragma unroll
        for (int x = 0; x < 2; ++x)
#pragma unroll
            for (int y = 0; y < 4; ++y) acc[x][y] = __builtin_amdgcn_mfma_f32_16x16x32_bf16(bfr[y], a[x], acc[x][y], 0, 0, 0);
    }
#pragma unroll
    for (int x = 0; x < 2; ++x)
#pragma unroll
        for (int y = 0; y < 4; ++y) *(f32x4*)(red + wid * 2048 + (16 * x + li) * 64 + 16 * y + 4 * kq) = acc[x][y];
    lds_barrier();
    { const int row = tid >> 4, col4 = (tid & 15) * 4; f32x4 v = {0.f, 0.f, 0.f, 0.f};
#pragma unroll
      for (int w = 0; w < 8; ++w) v += *(const f32x4*)(red + w * 2048 + row * 64 + col4);
      E(arow0 + row, c, col4, v); }
    lds_barrier();
}
struct TEpiResid {
    float* H; bf16_t* HB; float* rowss; float scale;
    __device__ __forceinline__ void operator()(int r, int c, int col4, f32x4 v) const {
        float* hp = H + (size_t)r * D + c * 64 + col4; f32x4 a = *(const f32x4*)hp; a += v * scale; *(f32x4*)hp = a;
        float ss = (a[0] * a[0] + a[1] * a[1]) + (a[2] * a[2] + a[3] * a[3]);
        ss += shx<1>(ss); ss += shx<2>(ss); ss += shx<4>(ss); ss += shx<8>(ss);
        if (HB) { u32x2v w; w[0] = pk2(a[0], a[1]); w[1] = pk2(a[2], a[3]); *(u32x2v*)(HB + (size_t)r * D + c * 64 + col4) = w; }
        if (rowss && (lane_id() & 15) == 0) rowss[(size_t)r * 32 + c] = ss;
    }
};
struct TEpiScale {
    bf16_t* O; int ldc; const float* rowss;
    __device__ __forceinline__ void operator()(int r, int c, int col4, f32x4 v) const {
        const int l = lane_id() & 15; float s = rowss[(size_t)r * 32 + 2 * l] + rowss[(size_t)r * 32 + 2 * l + 1];
        s += shx<1>(s); s += shx<2>(s); s += shx<4>(s); s += shx<8>(s);
        const float rs = rsqrtf(s * (1.0f / D) + EPS);
        u32x2v w; w[0] = pk2(v[0] * rs, v[1] * rs); w[1] = pk2(v[2] * rs, v[3] * rs); *(u32x2v*)(O + (size_t)r * ldc + c * 64 + col4) = w;
    }
};

#define run_gemm(...) run_gemm_(__VA_ARGS__, p.wave)
template <class Epi> __device__ __forceinline__ void run_gemm_(PG8_LAS unsigned char* lds, const bf16_t* A, const bf16_t* Bt, int Mr, int N, int K, const Epi& E, const int wave) {
    pg8::Gemm g; g.A = A; g.Bt = Bt; g.M = Mr; g.N = N; g.K = K;
    pg8::StaticOrder S; S.init(Mr, N, (int)gridDim.x, (int)blockIdx.x);
    pg8::gemm_phase<Epi, pg8::StaticOrder>(lds, g, S, E, ltid_w(wave));
}

__device__ __forceinline__ void gbar(const __attribute__((address_space(4))) Params* kp, int wave, int k) {
    __syncthreads();
    if (ltid_w(wave) == 0) {
        unsigned* bar = kp->bar; const unsigned target = (unsigned)k * gridDim.x;
        __threadfence();
        __hip_atomic_fetch_add(bar, 1u, __ATOMIC_RELEASE, __HIP_MEMORY_SCOPE_AGENT);
        while (__hip_atomic_load(bar, __ATOMIC_RELAXED, __HIP_MEMORY_SCOPE_AGENT) < target) __builtin_amdgcn_s_sleep(1);
        __threadfence();
    }
    __syncthreads();
}
typedef const __attribute__((address_space(4))) Params* KParams;
#if defined(__HIP_DEVICE_COMPILE__)
#define LOADP() Params p; { KParams q_ = kp; asm volatile("" : "+s"(q_)); p = *q_; p.wave = wave_s; }
#else
#define LOADP() Params p = p_unused; p.wave = wave_s; (void)kp;
#endif
#define MARK(i) do { if (PROBE_MASK) { const unsigned long long t_ = wall_clock64(); if ((PROBE_MASK >> (i)) & 1u) t_acc += t_ - t_last; t_last = t_; } } while (0)
__global__ __launch_bounds__(512, 2) void mega(Params p_unused) {
    KParams kp = (KParams)__builtin_amdgcn_kernarg_segment_ptr();
    const int wave_s = __builtin_amdgcn_readfirstlane((int)(threadIdx.x >> 6));
    unsigned long long t_acc = 0ull, t_last = PROBE_MASK ? wall_clock64() : 0ull;
    extern __shared__ __attribute__((aligned(16))) unsigned char smem[];
    cg::grid_group grid = cg::this_grid();
    PG8_LAS unsigned char* lds = (PG8_LAS unsigned char*)smem;
    float* smf = (float*)smem;
    const int G = gridDim.x, bid = blockIdx.x;
    { LOADP();
      transpose_mat(p.ffn1_wg, p.Wgu1, p.ffn1_norm, D, DFF, DFF, DFF, 1, smf, p.wave);
      transpose_mat(p.ffn1_wu, p.Wgu1, p.ffn1_norm, D, DFF, DFF, DFF, 2, smf, p.wave);
      transpose_mat(p.ffn1_wd, p.Wd1, nullptr, DFF, D, D, D, 0, smf, p.wave); }
    { LOADP();
      transpose_mat(p.w_in, p.Win, p.mix_norm, D, INCP, INC, INC, 0, smf, p.wave);
      transpose_mat(p.w_out, p.Wout, nullptr, D, D, D, D, 0, smf, p.wave); }
    { LOADP();
      transpose_mat(p.ffn2_wg, p.Wgu2, p.ffn2_norm, D, DFF, DFF, DFF, 1, smf, p.wave);
      transpose_mat(p.ffn2_wu, p.Wgu2, p.ffn2_norm, D, DFF, DFF, DFF, 2, smf, p.wave);
      transpose_mat(p.ffn2_wd, p.Wd2, nullptr, DFF, D, D, D, 0, smf, p.wave); }
    { LOADP();
      if (bid == 0 && ltid_w(p.wave) == 0) *p.ctr = 0u;
      wb_items(p);
      for (int it = bid; it < NT_ROWS + NT_Z2; it += G) { if (it < NT_ROWS) row_item(p, it); else z2_item(p, it - NT_ROWS); } }
    grid.sync(); MARK(0);
    { LOADP(); EpiSwiglu E; E.O = p.big; E.rowss = p.rowss; run_gemm(lds, p.hb, p.Wgu1, MP, 2 * DFF, D, E); }
    gbar(kp, wave_s, 1); MARK(1);
    { LOADP(); EpiResid<true> E; E.H = p.h; E.HB = p.hb; E.rowss = p.rowss; E.scale = 0.5f; run_gemm(lds, p.big, p.Wd1, 8192, D, DFF, E); }
    { LOADP(); TEpiResid T; T.H = p.h; T.HB = p.hb; T.rowss = p.rowss; T.scale = 0.5f;
      for (int c = bid; c < 32; c += G) tail_tile(p.big, 8192, p.Wd1, 64 * c, 64 * c + 32, DFF, smf, T, c, p.wave); }
    gbar(kp, wave_s, 2); MARK(2);
    { LOADP(); EpiScale E; E.O = p.big; E.ldc = INCP; E.rowss = p.rowss; run_gemm(lds, p.hb, p.Win, 8192, 6144, D, E); }
    { LOADP(); TEpiScale T; T.O = p.big; T.ldc = INCP; T.rowss = p.rowss;
      for (int it = bid; it < 97 + 256; it += G) { if (it < 97) tail_tile(p.hb, 8192, p.Win, 64 * it, 64 * it + 32, D, smf, T, it, p.wave); else tail_tile(p.hb, 32 * (it - 97), p.Win, 6144, 6176, D, smf, T, 96, p.wave); } }
    gbar(kp, wave_s, 3); MARK(3);
#define PSEC(i, stmt) do { unsigned long long a_ = PROBE_MASK ? wall_clock64() : 0ull; stmt; if (PROBE_MASK && ((PROBE_MASK >> (i)) & 1u)) t_acc += wall_clock64() - a_; } while (0)
    { LOADP(); EpiFilt E; E.GF = p.GF; E.G0 = p.G0; PSEC(20, run_gemm(lds, p.WB, p.ZA, 2048, 4352, 256, E)); }
    { LOADP(); for (int it = bid; it < 1040 + 520; it += G) { if (it < 1040) PSEC(21, gla_pre(p, it, smem)); else PSEC(22, hyu_item(p, it - 1040, smem)); } }
    gbar(kp, wave_s, 4); MARK(4);
    { LOADP(); if (bid < 128) gla_scan(p, bid, smem); }
    { LOADP();
      for (;;) {
        if (ltid_w(p.wave) == 0) *(int*)(smem + HY_ZERO_OFF + 192) = (int)atomicAdd(p.ctr, 1u);
        lds_barrier();
        const int g = *(const int*)(smem + HY_ZERO_OFF + 192);
        lds_barrier();
        if (g >= 256) break;
        hyena_group(p, (g & 7) * 32 + (g >> 3), smem, t_acc);
      } }
    gbar(kp, wave_s, 5); MARK(5);
    { LOADP(); for (int it = bid; it < MP / 8; it += G) fin_item(p, it); }
    gbar(kp, wave_s, 6); MARK(6);
    { LOADP(); EpiResid<true> E; E.H = p.h; E.HB = p.hb; E.rowss = p.rowss; E.scale = 1.0f; run_gemm(lds, p.y, p.Wout, 8192, D, D, E); }
    { LOADP(); TEpiResid T; T.H = p.h; T.HB = p.hb; T.rowss = p.rowss; T.scale = 1.0f;
      for (int c = bid; c < 32; c += G) tail_tile(p.y, 8192, p.Wout, 64 * c, 64 * c + 32, D, smf, T, c, p.wave); }
    gbar(kp, wave_s, 7); MARK(7);
    { LOADP(); EpiSwiglu E; E.O = p.big; E.rowss = p.rowss; run_gemm(lds, p.hb, p.Wgu2, MP, 2 * DFF, D, E); }
    gbar(kp, wave_s, 8); MARK(8);
    { LOADP(); EpiResid<false> E; E.H = p.h; E.HB = nullptr; E.rowss = nullptr; E.scale = 0.5f; run_gemm(lds, p.big, p.Wd2, 8192, D, DFF, E); }
    { LOADP(); TEpiResid T; T.H = p.h; T.HB = nullptr; T.rowss = nullptr; T.scale = 0.5f;
      for (int c = bid; c < 32; c += G) tail_tile(p.big, 8192, p.Wd2, 64 * c, 64 * c + 32, DFF, smf, T, c, p.wave); }
    gbar(kp, wave_s, 9); MARK(9);
    { LOADP(); for (int it = bid; it < 1024; it += G) final_item(p, it); }
    MARK(10);
    if (PROBE_MASK && bid == 0) { const unsigned long long t0_ = wall_clock64(); while (wall_clock64() - t0_ < (unsigned long long)PROBE_K * t_acc) __builtin_amdgcn_s_sleep(8); }
}

extern "C" void kernel_launch(void* const* d_in, const int* in_sizes, int n_in, void* d_out, int out_size, void* d_ws, size_t ws_size, hipStream_t stream) {
    static int grid_blocks = 0;
    if (!grid_blocks) {
        (void)hipFuncSetAttribute((const void*)mega, hipFuncAttributeMaxDynamicSharedMemorySize, LDS_BYTES);
        int dev = 0, cus = 0, per_cu = 0;
        (void)hipGetDevice(&dev);
        (void)hipDeviceGetAttribute(&cus, hipDeviceAttributeMultiprocessorCount, dev);
        (void)hipOccupancyMaxActiveBlocksPerMultiprocessor(&per_cu, mega, 512, LDS_BYTES);
        if (per_cu > 1) per_cu = 1;
        if (per_cu < 1) { fprintf(stderr, "occupancy query returned %d\n", per_cu); per_cu = 1; }
        grid_blocks = cus * per_cu;
    }
    Params p{};
    const float* const* in = (const float* const*)d_in;
    p.x = in[0]; p.meta = in[1]; p.ffn1_norm = in[2]; p.ffn1_wg = in[3]; p.ffn1_wu = in[4]; p.ffn1_wd = in[5]; p.mix_norm = in[6]; p.w_in = in[7];
    p.conv_w = in[8]; p.conv_b = in[9]; p.filt_w1 = in[10]; p.filt_b1 = in[11]; p.filt_w2 = in[12]; p.filt_b2 = in[13]; p.filt_w3 = in[14]; p.filt_freq = in[15];
    p.hyena_d = in[16]; p.hyena_norm = in[17]; p.gk_w2 = in[18]; p.gk_b2 = in[19]; p.gla_norm = in[20]; p.w_out = in[21];
    p.ffn2_norm = in[22]; p.ffn2_wg = in[23]; p.ffn2_wu = in[24]; p.ffn2_wd = in[25]; p.final_norm = in[26];
    p.out = (float*)d_out;
    unsigned char* ws = (unsigned char*)d_ws;
    constexpr size_t SZ_WGU = (size_t)2 * DFF * D * 2, SZ_WD = (size_t)D * DFF * 2, SZ_WIN = (size_t)INCP * D * 2, SZ_WOUT = (size_t)D * D * 2;
    constexpr size_t SZ_H = (size_t)MP * D * 4, SZ_HB = (size_t)MP * D * 2, SZ_BIG = (size_t)MP * INCP * 2, SZ_RS = (size_t)MP * 32 * 4, SZ_Z2 = (size_t)L * 64 * 4;
    size_t o = 0;
    p.Wgu1 = (bf16_t*)(ws + o); o += SZ_WGU; p.Wd1 = (bf16_t*)(ws + o); o += SZ_WD; p.Win = (bf16_t*)(ws + o); o += SZ_WIN; p.Wout = (bf16_t*)(ws + o); o += SZ_WOUT;
    p.Wgu2 = (bf16_t*)(ws + o); o += SZ_WGU; p.Wd2 = (bf16_t*)(ws + o); o += SZ_WD;
    p.h = (float*)(ws + o); o += SZ_H; p.hb = (bf16_t*)(ws + o); o += SZ_HB; p.big = (bf16_t*)(ws + o); o += SZ_BIG; p.rowss = (float*)(ws + o); o += SZ_RS; p.z2 = (float*)(ws + o); o += SZ_Z2; p.ctr = (unsigned*)(ws + o); o += 256; p.ZA = (bf16_t*)(ws + o); o += (size_t)4352 * 256 * 2; p.WB = (bf16_t*)(ws + o); o += (size_t)2048 * 256 * 2; p.G0 = (float*)(ws + o); o += 2048 * 4; p.bar = (unsigned*)(ws + o); o += 256;
    p.yc = (bf16_t*)ws; p.y = (bf16_t*)(ws + (size_t)M * 1024 * 2); p.of = (float*)p.hb; p.ob = (float*)d_out; p.gp = ws + (size_t)M * 1024 * 2; p.GF = p.Win; p.uT = (bf16_t*)((unsigned char*)d_out + (size_t)M * 1024 * 4);
    if (o > ws_size) fprintf(stderr, "workspace too small: need %zu have %zu\n", o, ws_size);
    (void)hipMemsetAsync(p.bar, 0, 256, stream);
    void* args[] = {&p};
    hipError_t e = hipLaunchCooperativeKernel((void*)mega, dim3(grid_blocks), dim3(512), args, LDS_BYTES, stream);
    if (e != hipSuccess) fprintf(stderr, "cooperative launch failed: %s (grid %d)\n", hipGetErrorString(e), grid_blocks);
}
```

```cpp
#include <hip/hip_runtime.h>
#include <hip/hip_cooperative_groups.h>
#include <cstdio>
namespace cg = cooperative_groups;
namespace pg8 {
#define PG8_LAS __attribute__((address_space(3)))
typedef unsigned short bf16_t;
typedef short bf16x8 __attribute__((ext_vector_type(8)));
typedef float f32x4 __attribute__((ext_vector_type(4)));
typedef unsigned u32x4 __attribute__((ext_vector_type(4)));
constexpr int BM = 256, BK = 64, HALF = 128, HTB = HALF * BK * 2  , STAGE_BYTES = 8 * HTB, NXCD = 8, WGM = 8;

__host__ __device__ __forceinline__ int lds_byte(int r, int c) { const int st = (r >> 4) * 2 + (c >> 5), rr = r & 15, cc = c & 31, ob = rr * 64 + cc * 2; return st * 1024 + (ob ^ (((ob >> 9) & 1) << 5)); }
__host__ __device__ __forceinline__ void stage_rc(int b, int& R, int& C) { const int st = b / 1024, sb = b % 1024, swz = sb ^ (((sb >> 9) & 1) << 5); R = (st >> 1) * 16 + swz / 64; C = (st & 1) * 32 + (swz % 64) / 2; }
__host__ __device__ __forceinline__ int perm32(int rho) { const int n = rho >> 4, i = rho & 15; return 8 * (i >> 2) + 4 * n + (i & 3); }

struct Unit { int pm, pn; };
struct Gemm { const bf16_t* A; const bf16_t* Bt; int M, N, K; };

struct StaticOrder {
    int nM, nN, nwg, G, c;
    __host__ __device__ void init(int M, int N, int G_, int c_) { nM = M / BM; nN = N / BM; nwg = nM * nN; G = G_; c = c_; }
    __host__ __device__ bool next(int i, Unit& u) const {
        const long L = (long)i * G + c; if (L >= nwg) return false;
        int wgid = (int)L; { const int q = nwg / NXCD, r = nwg % NXCD, xcd = wgid % NXCD, off = wgid / NXCD; wgid = (xcd < r ? xcd * (q + 1) : r * (q + 1) + (xcd - r) * q) + off; }
        const int nig = WGM * nN, gid = wgid / nig, fm = gid * WGM, gsz = (nM - fm) < WGM ? (nM - fm) : WGM;
        u.pm = fm + ((wgid % nig) % gsz); u.pn = (wgid % nig) / gsz; return true;
    }
    __device__ __forceinline__ void a_ready(const Unit&) const {}
    __device__ __forceinline__ void done(const Unit&) const {}
};
__device__ __forceinline__ unsigned cvt_pk_bf16(float lo, float hi) { unsigned r; asm volatile("v_cvt_pk_bf16_f32 %0, %1, %2" : "=v"(r) : "v"(lo), "v"(hi)); return r; }
template <class Epi, class Sched>
__device__ __forceinline__ void gemm_phase(PG8_LAS unsigned char* lds, const Gemm g, const Sched& S, const Epi& E, const int tid_in) {
    const int tid = tid_in, wid = __builtin_amdgcn_readfirstlane(tid >> 6), lane = tid & 63, wr = wid >> 2, wc = wid & 3, fr = lane & 15, fq = lane >> 4;
    const int K = g.K, nt = K / BK;
    unsigned voffA[2], voffB[2];
#pragma unroll
    for (int i = 0; i < 2; ++i) { int R, C; stage_rc(tid * 16 + i * 8192, R, C); const int Rb = Epi::PERM ? ((R & ~31) + perm32(R & 31)) : R;
        voffA[i] = (unsigned)(R * K + C) * 2u; voffB[i] = (unsigned)(Rb * K + C) * 2u; }
    const size_t kstep = (size_t)(BK * 2);
    const size_t hstep = (size_t)HALF * K * 2;
    const size_t tstep = 2 * hstep;
    const unsigned ldsw = (unsigned)wid * 1024u;
    const int aoff = lds_byte(wr * 64 + fr, fq * 8), boff = lds_byte(wc * 32 + fr, fq * 8);
#define PG8_SA(b, h) (((b) * 2 + (h)) * HTB)
#define PG8_SB(b, h) ((4 + (b) * 2 + (h)) * HTB)
#define PG8_STAGE(bufoff, gbase, voff) do { _Pragma("unroll") for (int _i = 0; _i < 2; ++_i) \
        __builtin_amdgcn_global_load_lds((const unsigned*)((const char*)(gbase) + (voff)[_i]), (PG8_LAS unsigned*)(lds + (bufoff) + ldsw + _i * 8192), 16, 0, 0); } while (0)
#define PG8_LDA(dst, b, h) do { _Pragma("unroll") for (int m = 0; m < 4; ++m) _Pragma("unroll") for (int k = 0; k < 2; ++k) dst[m][k] = *(const PG8_LAS bf16x8*)(lds + PG8_SA(b, h) + aoff + m * 2048 + k * 1024); } while (0)
#define PG8_LDB(dst, b, h) do { _Pragma("unroll") for (int n = 0; n < 2; ++n) _Pragma("unroll") for (int k = 0; k < 2; ++k) dst[n][k] = *(const PG8_LAS bf16x8*)(lds + PG8_SB(b, h) + boff + n * 2048 + k * 1024); } while (0)
#define PG8_MMA(ai, bj, At, Bt) do { __builtin_amdgcn_s_setprio(1); _Pragma("unroll") for (int m = 0; m < 4; ++m) _Pragma("unroll") for (int n = 0; n < 2; ++n) _Pragma("unroll") for (int k = 0; k < 2; ++k) \
        acc[ai][bj][m][n] = __builtin_amdgcn_mfma_f32_16x16x32_bf16(Bt[n][k], At[m][k], acc[ai][bj][m][n], 0, 0, 0); __builtin_amdgcn_s_setprio(0); } while (0)
#define PG8_WAIT_V(n) asm volatile("s_waitcnt vmcnt(" #n ")" ::: "memory")
#define PG8_WAIT_L(n) asm volatile("s_waitcnt lgkmcnt(" #n ")" ::: "memory")
#define PG8_BAR __builtin_amdgcn_s_barrier()
#define PG8_SCHED __builtin_amdgcn_sched_barrier(0)
    Unit cur, nxt; int ui = 0;
    if (!S.next(0, cur)) return;
    f32x4 acc[2][2][4][2];
#pragma unroll
    for (int a = 0; a < 2; ++a)
#pragma unroll
        for (int b = 0; b < 2; ++b)
#pragma unroll
            for (int m = 0; m < 4; ++m)
#pragma unroll
                for (int n = 0; n < 2; ++n) acc[a][b][m][n] = (f32x4){0.f, 0.f, 0.f, 0.f};
    bf16x8 At[4][2], B0[2][2], B1[2][2];
    const char* cA = (const char*)g.A + (size_t)cur.pm * tstep; const char* cB = (const char*)g.Bt + (size_t)cur.pn * tstep;
    S.a_ready(cur);
    PG8_STAGE(PG8_SB(0, 0), cB, voffB); PG8_STAGE(PG8_SA(0, 0), cA, voffA); PG8_STAGE(PG8_SB(0, 1), cB + hstep, voffB); PG8_STAGE(PG8_SA(0, 1), cA + hstep, voffA);
    if (wr == 1) PG8_BAR;
    PG8_WAIT_V(4); PG8_BAR;
    PG8_STAGE(PG8_SB(1, 0), cB + kstep, voffB); PG8_STAGE(PG8_SA(1, 0), cA + kstep, voffA); PG8_STAGE(PG8_SB(1, 1), cB + hstep + kstep, voffB);
    PG8_WAIT_V(6); PG8_BAR;
    for (;;) {
        const bool has_next = S.next(ui + 1, nxt);
        const char* nA = has_next ? (const char*)g.A + (size_t)nxt.pm * tstep : cA; const char* nB = has_next ? (const char*)g.Bt + (size_t)nxt.pn * tstep : cB;
        for (int t = 0; t < nt; t += 2) {
            const bool last = (t == nt - 2);
            const char* a1 = cA + (size_t)(t + 1) * kstep;
            const char* a2 = last ? nA : cA + (size_t)(t + 2) * kstep; const char* b2 = last ? nB : cB + (size_t)(t + 2) * kstep;
            const char* a3 = a2 + kstep; const char* b3 = b2 + kstep;
            if (last && has_next) S.a_ready(nxt);
            PG8_LDB(B0, 0, 0); PG8_SCHED; PG8_LDA(At, 0, 0); PG8_STAGE(PG8_SA(1, 1), a1 + hstep, voffA);
            PG8_WAIT_L(8); PG8_BAR; PG8_WAIT_L(0); PG8_MMA(0, 0, At, B0); PG8_BAR; PG8_SCHED;
            PG8_LDB(B1, 0, 1); PG8_STAGE(PG8_SB(0, 0), b2, voffB);
            PG8_BAR; PG8_WAIT_L(0); PG8_MMA(0, 1, At, B1); PG8_BAR;
            PG8_LDA(At, 0, 1); PG8_STAGE(PG8_SA(0, 0), a2, voffA);
            PG8_BAR; PG8_WAIT_L(0); PG8_MMA(1, 0, At, B0); PG8_BAR; PG8_SCHED;
            PG8_STAGE(PG8_SB(0, 1), b2 + hstep, voffB);
            PG8_WAIT_V(6); PG8_BAR; PG8_MMA(1, 1, At, B1); PG8_BAR;
            PG8_LDB(B0, 1, 0); PG8_SCHED; PG8_LDA(At, 1, 0); PG8_STAGE(PG8_SA(0, 1), a2 + hstep, voffA);
            PG8_WAIT_L(8); PG8_BAR; PG8_WAIT_L(0); PG8_MMA(0, 0, At, B0); PG8_BAR; PG8_SCHED;
            PG8_LDB(B1, 1, 1); PG8_STAGE(PG8_SB(1, 0), b3, voffB);
            PG8_BAR; PG8_WAIT_L(0); PG8_MMA(0, 1, At, B1); PG8_BAR;
            PG8_LDA(At, 1, 1); PG8_STAGE(PG8_SA(1, 0), a3, voffA);
            PG8_BAR; PG8_WAIT_L(0); PG8_MMA(1, 0, At, B0); PG8_BAR; PG8_SCHED;
            PG8_STAGE(PG8_SB(1, 1), b3 + hstep, voffB);
            PG8_WAIT_V(6); PG8_BAR; PG8_MMA(1, 1, At, B1); PG8_BAR;
        }
        if constexpr (!Epi::AFTER_DRAIN) { E(acc, cur, wr, wc, fr, fq); S.done(cur); }
        if (!has_next) break;
#pragma unroll
        for (int a = 0; a < 2; ++a)
#pragma unroll
            for (int b = 0; b < 2; ++b)
#pragma unroll
                for (int m = 0; m < 4; ++m)
#pragma unroll
                    for (int n = 0; n < 2; ++n) acc[a][b][m][n] = (f32x4){0.f, 0.f, 0.f, 0.f};
        cur = nxt; cA = nA; cB = nB; ++ui;
    }
    PG8_WAIT_V(0);
    if (wr == 0) PG8_BAR;
    PG8_BAR;
    if constexpr (Epi::AFTER_DRAIN) { E.fused(acc, cur, wr, wc, fr, fq, lds, wid, lane); S.done(cur); }
#undef PG8_SA
#undef PG8_SB
#undef PG8_STAGE
#undef PG8_LDA
#undef PG8_LDB
#undef PG8_MMA
#undef PG8_WAIT_V
#undef PG8_WAIT_L
#undef PG8_BAR
#undef PG8_SCHED
}
}

#include <cstdio>
#include <ctime>
#include <cstdlib>
#include <cstring>
#include <cmath>
#include <vector>
#include <algorithm>

using pg8::bf16_t; using pg8::f32x4; using pg8::Unit;
typedef unsigned u32x2v __attribute__((ext_vector_type(2)));
typedef unsigned u32x4v __attribute__((ext_vector_type(4)));

constexpr int D = 2048, SEQ = 4096, NMETA = 16, L = 4112, M = 8224, MP = 8448, DFF = 5632, INC = 6176, INCP = 6400;
constexpr float EPS = 1e-6f;
constexpr int LDS_BYTES = 4 * (8336 * 2 + 2 * 65 * 144) + 256;
constexpr unsigned PROBE_MASK = 0u; constexpr int PROBE_K = 8;
#define HSEC(i) do { if (PROBE_MASK) { const unsigned long long t_ = wall_clock64(); if ((PROBE_MASK >> (i)) & 1u) tsec += t_ - ts0_; ts0_ = t_; } } while (0)
constexpr int C_Q = 3072, C_K = 3584, C_V = 4096, C_OG = 5120, C_LR = 6144;

struct Params {
    const float *x, *meta, *ffn1_norm, *ffn1_wg, *ffn1_wu, *ffn1_wd, *mix_norm, *w_in, *conv_w, *conv_b,
        *filt_w1, *filt_b1, *filt_w2, *filt_b2, *filt_w3, *filt_freq, *hyena_d, *hyena_norm, *gk_w2, *gk_b2, *gla_norm, *w_out,
        *ffn2_norm, *ffn2_wg, *ffn2_wu, *ffn2_wd, *final_norm;
    float* out;
    bf16_t *Wgu1, *Wd1, *Win, *Wout, *Wgu2, *Wd2;
    float* h; bf16_t* hb; bf16_t* big; float* rowss; float* z2;
    bf16_t* y; bf16_t* yc; float* of; float* ob; unsigned char* gp; unsigned* ctr; bf16_t* uT; bf16_t* ZA; bf16_t* WB; bf16_t* GF; float* G0; unsigned* bar; float* dummy; int wave; int pad_;
};

__device__ __forceinline__ int lane_id() { return (int)__builtin_amdgcn_mbcnt_hi(~0u, __builtin_amdgcn_mbcnt_lo(~0u, 0u)); }
__device__ __forceinline__ int ltid_w(int wave) { int t = (wave << 6) | lane_id(); asm volatile("" : "+v"(t)); return t; }
__device__ __forceinline__ void lds_barrier() { asm volatile("s_waitcnt lgkmcnt(0)" ::: "memory"); __builtin_amdgcn_s_barrier(); asm volatile("" ::: "memory"); }
__device__ __forceinline__ float bf2f(bf16_t b) { return __uint_as_float(((unsigned)b) << 16); }
__device__ __forceinline__ unsigned pk2(float lo, float hi) { return pg8::cvt_pk_bf16(lo, hi); }
__device__ __forceinline__ bf16_t f2bf(float v) { return (bf16_t)(pk2(v, 0.f) & 0xffffu); }
template <int MSK> __device__ __forceinline__ float shx(float v) {
    if constexpr (MSK < 32) return __int_as_float(__builtin_amdgcn_ds_swizzle(__float_as_int(v), 0x1f | (MSK << 10)));
    else { int l = lane_id(); asm volatile("" : "+v"(l)); return __int_as_float(__builtin_amdgcn_ds_bpermute((l ^ 32) << 2, __float_as_int(v))); }
}
__device__ __forceinline__ float wave_sum(float v) { v += shx<32>(v); v += shx<16>(v); v += shx<8>(v); v += shx<4>(v); v += shx<2>(v); v += shx<1>(v); return v; }
__device__ __forceinline__ float silu_f(float x) { return x * __builtin_amdgcn_rcpf(1.0f + __expf(-x)); }

__device__ __forceinline__ float row_rscale(const float* rowss, int r, int fq) {
    const f32x4* q = (const f32x4*)(rowss + (size_t)r * 32 + fq * 8);
    const f32x4 a = q[0], b = q[1];
    float s = ((a[0] + a[1]) + (a[2] + a[3])) + ((b[0] + b[1]) + (b[2] + b[3]));
    s += shx<16>(s); s += shx<32>(s);
    return rsqrtf(s * (1.0f / D) + EPS);
}

struct EpiSwiglu {
    static constexpr bool PERM = true, AFTER_DRAIN = false;
    bf16_t* O; const float* rowss;
    __device__ __forceinline__ void operator()(const f32x4 (&acc)[2][2][4][2], const Unit& u, int wr, int wc, int fr, int fq) const {
        const int row0 = u.pm * 256 + wr * 64 + fr, col0 = u.pn * 128 + wc * 32 + 8 * fq;
#pragma unroll
        for (int ai = 0; ai < 2; ++ai)
#pragma unroll
            for (int m = 0; m < 4; ++m) {
                const int r = row0 + ai * 128 + m * 16; const float rs = row_rscale(rowss, r, fq);
                u32x4v w;
#pragma unroll
                for (int n = 0; n < 2; ++n) { const f32x4 g = acc[ai][0][m][n] * rs, uu = acc[ai][1][m][n] * rs;
                    w[2 * n] = pk2(silu_f(g[0]) * uu[0], silu_f(g[1]) * uu[1]); w[2 * n + 1] = pk2(silu_f(g[2]) * uu[2], silu_f(g[3]) * uu[3]); }
                *(u32x4v*)(O + (size_t)r * DFF + col0) = w;
            }
    }
};
struct EpiScale {
    static constexpr bool PERM = true, AFTER_DRAIN = false;
    bf16_t* O; int ldc; const float* rowss;
    __device__ __forceinline__ void operator()(const f32x4 (&acc)[2][2][4][2], const Unit& u, int wr, int wc, int fr, int fq) const {
        const int row0 = u.pm * 256 + wr * 64 + fr, col0 = u.pn * 256 + wc * 32 + 8 * fq;
#pragma unroll
        for (int ai = 0; ai < 2; ++ai)
#pragma unroll
            for (int m = 0; m < 4; ++m) {
                const int r = row0 + ai * 128 + m * 16; const float rs = row_rscale(rowss, r, fq);
#pragma unroll
                for (int bj = 0; bj < 2; ++bj) { const f32x4 a = acc[ai][bj][m][0] * rs, b = acc[ai][bj][m][1] * rs;
                    u32x4v w; w[0] = pk2(a[0], a[1]); w[1] = pk2(a[2], a[3]); w[2] = pk2(b[0], b[1]); w[3] = pk2(b[2], b[3]);
                    *(u32x4v*)(O + (size_t)r * ldc + col0 + bj * 128) = w; }
            }
    }
};
template <bool WHB> struct EpiResid {
    static constexpr bool PERM = true, AFTER_DRAIN = false;
    float* H; bf16_t* HB; float* rowss; float scale;
    __device__ __forceinline__ void operator()(const f32x4 (&acc)[2][2][4][2], const Unit& u, int wr, int wc, int fr, int fq) const {
        const int row0 = u.pm * 256 + wr * 64 + fr, col0 = u.pn * 256 + wc * 32 + 8 * fq;
#pragma unroll
        for (int ai = 0; ai < 2; ++ai)
#pragma unroll
            for (int m = 0; m < 4; ++m) {
                const int r = row0 + ai * 128 + m * 16; float ss = 0.f;
#pragma unroll
                for (int bj = 0; bj < 2; ++bj) { float* hp = H + (size_t)r * D + col0 + bj * 128;
                    f32x4 a = *(const f32x4*)hp, b = *(const f32x4*)(hp + 4);
                    a += acc[ai][bj][m][0] * scale; b += acc[ai][bj][m][1] * scale;
                    *(f32x4*)hp = a; *(f32x4*)(hp + 4) = b;
                    ss += (a[0] * a[0] + a[1] * a[1]) + (a[2] * a[2] + a[3] * a[3]) + (b[0] * b[0] + b[1] * b[1]) + (b[2] * b[2] + b[3] * b[3]);
                    if (WHB) { u32x4v w; w[0] = pk2(a[0], a[1]); w[1] = pk2(a[2], a[3]); w[2] = pk2(b[0], b[1]); w[3] = pk2(b[2], b[3]);
                        *(u32x4v*)(HB + (size_t)r * D + col0 + bj * 128) = w; } }
                ss += shx<16>(ss); ss += shx<32>(ss);
                if (WHB && fq == 0) rowss[(size_t)r * 32 + u.pn * 4 + wc] = ss;
            }
    }
};

constexpr int NT_FFN = 2816, NT_WIN = 3200, NT_WOUT = 1024, NT_TR = 6 * NT_FFN + NT_WIN + NT_WOUT, NT_ROWS = MP / 8, NT_Z2 = 4352 / 8, P0_ITEMS = NT_TR + NT_ROWS + NT_Z2;

__device__ __forceinline__ void transpose_mat(const float* src, bf16_t* dst, const float* gain, const int K, const int N, const int ld, const int nvalid, const int mode, float* tl, const int wave) {
    const int nst = (N + 511) / 512, nkt = K / 64, nitems = nkt * nst, tid = ltid_w(wave);
    for (int it = blockIdx.x; it < nitems; it += gridDim.x) {
        const int st = it / nkt, kt = it - st * nkt, k0 = kt * 64, nbase = st * 512;
        { const int r = tid >> 4, c4 = (tid & 15) * 4;
          const float g0 = gain ? gain[k0 + r] : 1.0f, g1 = gain ? gain[k0 + r + 32] : 1.0f;
          f32x4 v[8][2];
#pragma unroll
          for (int s8 = 0; s8 < 8; ++s8)
#pragma unroll
              for (int i = 0; i < 2; ++i) { const int n = nbase + s8 * 64 + c4; v[s8][i] = (f32x4){0.f, 0.f, 0.f, 0.f};
                  if (n < nvalid) v[s8][i] = *(const f32x4*)(src + (size_t)(k0 + r + 32 * i) * ld + n); }
#pragma unroll
          for (int s8 = 0; s8 < 8; ++s8)
#pragma unroll
              for (int i = 0; i < 2; ++i) { const float g = i ? g1 : g0; float* t = tl + s8 * 4160 + (r + 32 * i) * 65 + c4;
                  t[0] = v[s8][i][0] * g; t[1] = v[s8][i][1] * g; t[2] = v[s8][i][2] * g; t[3] = v[s8][i][3] * g; } }
        lds_barrier();
        { const int nl = tid >> 3, k8 = (tid & 7) * 8;
#pragma unroll
          for (int s8 = 0; s8 < 8; ++s8) { const int n0 = nbase + s8 * 64;
              if (n0 < N) { float w8[8];
#pragma unroll
                  for (int j = 0; j < 8; ++j) w8[j] = tl[s8 * 4160 + (k8 + j) * 65 + nl];
                  u32x4v w; w[0] = pk2(w8[0], w8[1]); w[1] = pk2(w8[2], w8[3]); w[2] = pk2(w8[4], w8[5]); w[3] = pk2(w8[6], w8[7]);
                  const long drow0 = mode == 0 ? n0 : (n0 / 128) * 256 + (n0 % 128) + (mode == 2 ? 128 : 0);
                  *(u32x4v*)(dst + (size_t)(drow0 + nl) * K + k0 + k8) = w; } } }
        lds_barrier();
    }
}

__device__ void row_item(const Params& p, int item) {
    const int tid__ = ltid_w(p.wave), wid = tid__ >> 6, lane = tid__ & 63, m = item * 8 + wid;
    float* hrow = p.h + (size_t)m * D; bf16_t* hbrow = p.hb + (size_t)m * D;
    if (m < M) { const int b = m / L, t = m - b * L;
        const float* src = t < NMETA ? p.meta + (size_t)t * D : p.x + ((size_t)b * SEQ + t - NMETA) * D;
        float ss = 0.f;
#pragma unroll
        for (int i = 0; i < 8; ++i) { const int c = (lane + 64 * i) * 4; const f32x4 v = *(const f32x4*)(src + c);
            ss += (v[0] * v[0] + v[1] * v[1]) + (v[2] * v[2] + v[3] * v[3]);
            *(f32x4*)(hrow + c) = v; u32x2v w; w[0] = pk2(v[0], v[1]); w[1] = pk2(v[2], v[3]); *(u32x2v*)(hbrow + c) = w; }
        ss = wave_sum(ss);
        if (lane < 32) p.rowss[(size_t)m * 32 + lane] = lane == 0 ? ss : 0.f;
    } else {
#pragma unroll
        for (int i = 0; i < 8; ++i) { const int c = (lane + 64 * i) * 4; *(f32x4*)(hrow + c) = (f32x4){0.f, 0.f, 0.f, 0.f}; u32x2v w; w[0] = 0u; w[1] = 0u; *(u32x2v*)(hbrow + c) = w; }
        if (lane < 32) p.rowss[(size_t)m * 32 + lane] = 0.f;
    }
}

__device__ void z2_item(const Params& p, int item) {
    const int tid__ = ltid_w(p.wave), wid = tid__ >> 6, lane = tid__ & 63, j = item * 8 + wid;
    bf16_t* za = p.ZA + (size_t)j * 256;
    if (j >= L) { za[lane] = 0; za[64 + lane] = 0; za[128 + lane] = 0; za[192 + lane] = 0; return; }
    float feat = 0.f;
    const float w = (float)(2.0 * 3.14159265358979323846 / L) * (float)j;
    if (lane == 0) feat = (float)j * (1.0f / (float)(L - 1));
    else if (lane <= 32) { const int bi = (lane - 1) & 15; const float band = 1e-4f + (float)bi * ((15.0f - 1e-4f) / 15.0f); const float ang = w * band;
        feat = lane <= 16 ? cosf(ang) : -sinf(ang); }
    float a = p.filt_b1[lane];
    for (int i = 0; i < 33; ++i) a += __int_as_float(__builtin_amdgcn_readlane(__float_as_int(feat), i)) * p.filt_w1[i * 64 + lane];
    const float fr = p.filt_freq[lane];
    const float z1 = sinf(fr * a);
    float c = p.filt_b2[lane];
    for (int k = 0; k < 64; ++k) c += __int_as_float(__builtin_amdgcn_readlane(__float_as_int(z1), k)) * p.filt_w2[k * 64 + lane];
    const float z = sinf(fr * c);
    const bf16_t hi = f2bf(z), lo = f2bf(z - bf2f(hi));
    za[lane] = hi; za[64 + lane] = lo; za[128 + lane] = hi; za[192 + lane] = 0;
}
__device__ void wb_items(const Params& p) {
    for (int idx = blockIdx.x * 512 + ltid_w(p.wave); idx < 2048 * 64; idx += gridDim.x * 512) { const int n = idx >> 6, k = idx & 63;
        const float w = p.filt_w3[(size_t)k * 2048 + n]; const bf16_t hi = f2bf(w), lo = f2bf(w - bf2f(hi));
        bf16_t* wb = p.WB + (size_t)n * 256; wb[k] = hi; wb[64 + k] = hi; wb[128 + k] = lo; wb[192 + k] = 0; }
}
struct EpiFilt {
    static constexpr bool PERM = true, AFTER_DRAIN = false;
    bf16_t* GF; float* G0;
    __device__ __forceinline__ void operator()(const f32x4 (&acc)[2][2][4][2], const Unit& u, int wr, int wc, int fr, int fq) const {
        const int row0 = u.pm * 256 + wr * 64 + fr, col0 = u.pn * 256 + wc * 32 + 8 * fq;
        const float la = -3.0701134573253945f, lb = -15.350567286626973f;
#pragma unroll
        for (int ai = 0; ai < 2; ++ai)
#pragma unroll
            for (int m = 0; m < 4; ++m) { const int n = row0 + ai * 128 + m * 16; const float delta = fabsf(la + (float)(n & 1023) * ((lb - la) / 1023.0f)) * (1.0f / (float)(L - 1));
                const float r1 = __expf(-delta), r2 = r1 * r1, r3 = r2 * r1;
                bf16_t* grow = GF + (size_t)n * 4352 + col0;
#pragma unroll
                for (int bj = 0; bj < 2; ++bj)
#pragma unroll
                    for (int nn = 0; nn < 2; ++nn) { const int j0 = col0 + bj * 128 + 4 * nn; const f32x4 a4 = acc[ai][bj][m][nn];
                        const float w0 = __expf(-(float)j0 * delta);
                        const float v0 = a4[0] * w0, v1 = a4[1] * (w0 * r1), v2 = a4[2] * (w0 * r2), v3 = a4[3] * (w0 * r3);
                        u32x2v w; w[0] = pk2(v0, v1); w[1] = pk2(v2, v3);
                        *(u32x2v*)(grow + bj * 128 + 4 * nn) = w;
                        if (j0 == 0) G0[n] = v0; } }

    }
};

constexpr int HY_G_ELEMS = 8336, HY_G_BYTES = HY_G_ELEMS * 2, HY_USTR = 144, HY_U_BYTES = 65 * HY_USTR, HY_CH_BYTES = HY_G_BYTES + 2 * HY_U_BYTES, HY_ZERO_OFF = 4 * HY_CH_BYTES;
static_assert(HY_ZERO_OFF + 256 <= LDS_BYTES, "lds");
static_assert(HY_CH_BYTES % 16 == 0 && HY_G_BYTES % 16 == 0, "align");
__device__ void hyu_item(const Params& p, int item, unsigned char* sm) {
    const int cb = item & 3, bt = item >> 2, b = bt / 65, tile = bt - b * 65, t0 = tile * 64;
    const int tid = ltid_w(p.wave), tl = tid & 63, qg = tid >> 6, t = t0 + tl;
    bf16_t* LT = (bf16_t*)sm;
#pragma unroll 1
    for (int x = 0; x < 4; ++x) { const int q = qg * 4 + x, c8 = cb * 256 + q * 8;
        float a1[8], a2[8];
#pragma unroll
        for (int h2 = 0; h2 < 2; ++h2) { const f32x4 b1 = *(const f32x4*)(p.conv_b + 1024 + c8 + 4 * h2), b2v = *(const f32x4*)(p.conv_b + 2048 + c8 + 4 * h2);
#pragma unroll
            for (int e = 0; e < 4; ++e) { a1[4 * h2 + e] = b1[e]; a2[4 * h2 + e] = b2v[e]; } }
        {
#pragma unroll
            for (int jj = 0; jj < 3; ++jj) { const int t2 = t + jj - 1; const bool ok = t < L && t2 >= 0 && t2 < L; const int t2c = t2 < 0 ? 0 : (t2 >= L ? L - 1 : t2);
                { const bf16_t* row = p.big + (size_t)(b * L + t2c) * INCP + c8;
                    const u32x4v x1 = *(const u32x4v*)(row + 1024), vh = *(const u32x4v*)(row + 2048); const float okf = ok ? 1.f : 0.f;
#pragma unroll
                    for (int h2 = 0; h2 < 2; ++h2) { const f32x4 w1 = *(const f32x4*)(p.conv_w + jj * 3072 + 1024 + c8 + 4 * h2) * okf, w2 = *(const f32x4*)(p.conv_w + jj * 3072 + 2048 + c8 + 4 * h2) * okf;
                        a1[4 * h2] += __uint_as_float(x1[2 * h2] << 16) * w1[0]; a1[4 * h2 + 1] += __uint_as_float(x1[2 * h2] & 0xffff0000u) * w1[1];
                        a1[4 * h2 + 2] += __uint_as_float(x1[2 * h2 + 1] << 16) * w1[2]; a1[4 * h2 + 3] += __uint_as_float(x1[2 * h2 + 1] & 0xffff0000u) * w1[3];
                        a2[4 * h2] += __uint_as_float(vh[2 * h2] << 16) * w2[0]; a2[4 * h2 + 1] += __uint_as_float(vh[2 * h2] & 0xffff0000u) * w2[1];
                        a2[4 * h2 + 2] += __uint_as_float(vh[2 * h2 + 1] << 16) * w2[2]; a2[4 * h2 + 3] += __uint_as_float(vh[2 * h2 + 1] & 0xffff0000u) * w2[3]; } } }
        }
#pragma unroll
        for (int e = 0; e < 8; ++e) LT[(q * 8 + e) * 72 + tl] = t < L ? (bf16_t)(pk2(a1[e] * a2[e], 0.f) & 0xffffu) : (bf16_t)0;
    }
    lds_barrier();
    { const int row = tid >> 1, half = tid & 1; bf16_t* dst = p.uT + ((size_t)(cb * 256 + row) * 2 + b) * 4160 + t0 + half * 32;
#pragma unroll
      for (int i = 0; i < 4; ++i) *(u32x4v*)(dst + 8 * i) = *(const u32x4v*)(LT + row * 72 + half * 32 + 8 * i); }
    lds_barrier();
}
__device__ void hyena_group(const Params& p, int grp_, unsigned char* sm, unsigned long long& tsec) {
    unsigned long long ts0_ = PROBE_MASK ? wall_clock64() : 0ull;
    const int grp = __builtin_amdgcn_readfirstlane(grp_);
    const int tid = ltid_w(p.wave), wid = tid >> 6, lane = tid & 63, c0 = grp * 4;
    { const unsigned char* src = (const unsigned char*)(p.uT + (size_t)c0 * 2 * 4160);
      for (int idx = tid; idx < 8 * 520; idx += 512) { const int r = idx / 520, i = idx - r * 520;
          *(u32x4v*)(sm + (r >> 1) * HY_CH_BYTES + HY_G_BYTES + (r & 1) * HY_U_BYTES + (i >> 3) * HY_USTR + (i & 7) * 16) = *(const u32x4v*)(src + (size_t)idx * 16); } }
    if (tid < 36) ((unsigned*)(sm + HY_ZERO_OFF))[tid] = 0u;
    for (int i = tid; i < 4 * 113; i += 512) { const int ch = i / 113, q = i - ch * 113; const int idx = q < 49 ? q : 8272 + (q - 49);
        *(unsigned short*)(sm + ch * HY_CH_BYTES + 2 * idx) = 0; }
    for (int idx = tid; idx < 4 * 514; idx += 512) { const int ch = idx / 514, pc = idx - ch * 514, j0 = pc * 8;
        unsigned short* gb = (unsigned short*)(sm + ch * HY_CH_BYTES);
        const u32x4v f = *(const u32x4v*)(p.GF + (size_t)(c0 + ch) * 4352 + j0); u32x4v bk = *(const u32x4v*)(p.GF + (size_t)(1024 + c0 + ch) * 4352 + j0);
        if (pc == 0) bk[0] = (bk[0] & 0xffff0000u) | (pk2(p.G0[c0 + ch] + p.G0[1024 + c0 + ch], 0.f) & 0xffffu);
        *(u32x4v*)(gb + 4160 + j0) = bk;
#pragma unroll
        for (int e = 0; e < 8; ++e) if (pc != 0 || e != 0) gb[4160 - j0 - e] = (unsigned short)((e & 1) ? (f[e >> 1] >> 16) : (f[e >> 1] & 0xffffu)); }
    lds_barrier();
    HSEC(12);
    const int ch = wid >> 1, b = wid & 1, li = lane & 15, kq = lane >> 4;
    unsigned char* Ub = sm + ch * HY_CH_BYTES + HY_G_BYTES + b * HY_U_BYTES;
    const unsigned char* Zb = sm + HY_ZERO_OFF + kq * 16;
    f32x4 acc[4][5];
#pragma unroll
    for (int rb = 0; rb < 4; ++rb)
#pragma unroll
        for (int nb = 0; nb < 5; ++nb) acc[rb][nb] = (f32x4){0.f, 0.f, 0.f, 0.f};
    const unsigned shl = (li & 1) ? 16u : 0u;
    unsigned gq[5];
#pragma unroll
    for (int w = 0; w < 5; ++w) { unsigned t_ = (unsigned)(ch * HY_CH_BYTES + 4 * (((4160 + 8 * kq - li) >> 1) + w)); asm volatile("" : "+v"(t_)); gq[w] = t_; }
    PG8_LAS const unsigned char* sml = (PG8_LAS const unsigned char*)sm;
    auto gfrag = [&](int mp) -> pg8::bf16x8 {
        unsigned e[5];
#pragma unroll
        for (int w = 0; w < 5; ++w) e[w] = *(PG8_LAS const unsigned*)(sml + (gq[w] - 32 * mp));
        u32x4v r;
#pragma unroll
        for (int w = 0; w < 4; ++w) r[w] = __builtin_amdgcn_alignbit(e[w + 1], e[w], shl);
        return __builtin_bit_cast(pg8::bf16x8, r);
    };
    pg8::bf16x8 F[6];
    F[4] = gfrag(4 * (-64) - 2); F[5] = gfrag(4 * (-64) - 1);
    for (int d = -64; d <= 64; ++d) {
        F[0] = F[4]; F[1] = F[5];
#pragma unroll
        for (int q = 2; q < 6; ++q) F[q] = gfrag(4 * d - 2 + q);
        const int nb_lo = d > 0 ? (d >> 4) : 0, nb_hi = (d + 64) >> 4;
#pragma unroll
        for (int nb = 0; nb < 5; ++nb) {
            if (nb >= nb_lo && nb <= nb_hi) {
                const int sblk = 16 * nb + li - d;
                const unsigned char* up = ((unsigned)sblk < 65u) ? (Ub + sblk * HY_USTR + kq * 16) : Zb;
                const pg8::bf16x8 B0 = *(const pg8::bf16x8*)up, B1 = *(const pg8::bf16x8*)(up + 64);
#pragma unroll
                for (int rb = 0; rb < 4; ++rb) {
                    acc[rb][nb] = __builtin_amdgcn_mfma_f32_16x16x32_bf16(F[rb + 2], B0, acc[rb][nb], 0, 0, 0);
                    acc[rb][nb] = __builtin_amdgcn_mfma_f32_16x16x32_bf16(F[rb], B1, acc[rb][nb], 0, 0, 0);
                }
            }
        }
    }
    HSEC(13);
    {
        const float dc = p.hyena_d[c0 + ch];
#pragma unroll
        for (int nb = 0; nb < 5; ++nb) { const int t1 = 16 * nb + li;
            if (t1 < 65) {
#pragma unroll
                for (int rb = 0; rb < 4; ++rb) { unsigned char* up = Ub + t1 * HY_USTR + (16 * rb + 4 * kq) * 2;
                    const u32x2v uu = *(const u32x2v*)up; const f32x4 a = acc[rb][nb];
                    u32x2v w; w[0] = pk2(a[0] + dc * __uint_as_float(uu[0] << 16), a[1] + dc * __uint_as_float(uu[0] & 0xffff0000u));
                    w[1] = pk2(a[2] + dc * __uint_as_float(uu[1] << 16), a[3] + dc * __uint_as_float(uu[1] & 0xffff0000u));
                    *(u32x2v*)up = w; } } }
    }
    lds_barrier();
    for (int tt = tid; tt < 2 * L; tt += 512) { const int bb = tt >= L ? 1 : 0, t = tt - bb * L;
        const unsigned char* up = sm + HY_G_BYTES + bb * HY_U_BYTES + (t >> 6) * HY_USTR + (t & 63) * 2;
        const unsigned v0 = *(const unsigned short*)up, v1 = *(const unsigned short*)(up + HY_CH_BYTES), v2 = *(const unsigned short*)(up + 2 * HY_CH_BYTES), v3 = *(const unsigned short*)(up + 3 * HY_CH_BYTES);
        u32x2v w; w[0] = v0 | (v1 << 16); w[1] = v2 | (v3 << 16);
        *(u32x2v*)(p.yc + (size_t)(bb * L + t) * 1024 + c0) = w; }
    lds_barrier();
    HSEC(14);
}

constexpr int GP_QT = 0, GP_KT = 16384, GP_AM = 32768, GP_DEC = 40960, GP_STRIDE = 41472;
__device__ void gla_pre(const Params& p, int item, unsigned char* sm) {
    const int n = item % 65, bdh = item / 65, hh = bdh & 3, dir = (bdh >> 2) & 1, b = bdh >> 3;
    const int tid = ltid_w(p.wave), d = tid & 127, seg = tid >> 7, lane = tid & 63, wid = tid >> 6, li = lane & 15, kq = lane >> 4;
    float* LR = (float*)sm; float* SEGT = LR + 1024; bf16_t* QS = (bf16_t*)(sm + 8192); bf16_t* KS = QS + 64 * 136;
    unsigned char* gp = p.gp + (size_t)item * GP_STRIDE;
    { const int i = tid >> 3, r2 = (tid & 7) * 2; const int tau = dir ? 4159 - (64 * n + i) : 64 * n + i; float v0 = 0.f, v1 = 0.f;
      { const unsigned w = *(const unsigned*)(p.big + (size_t)(b * L + (tau < 48 ? 0 : tau - 48)) * INCP + C_LR + dir * 16 + r2); if (tau >= 48) { v0 = __uint_as_float(w << 16); v1 = __uint_as_float(w & 0xffff0000u); } }
      LR[i * 16 + r2] = v0; LR[i * 16 + r2 + 1] = v1; }
    float w2[16];
#pragma unroll
    for (int r = 0; r < 16; ++r) w2[r] = p.gk_w2[(size_t)(dir * 16 + r) * 512 + hh * 128 + d];
    const float b2 = p.gk_b2[dir * 512 + hh * 128 + d];
    unsigned short qraw[16], kraw[16];
#pragma unroll
    for (int ii = 0; ii < 16; ++ii) { const int i = seg * 16 + ii; const int tau = dir ? 4159 - (64 * n + i) : 64 * n + i; const int tc = tau < 48 ? 0 : tau - 48;
        const bf16_t* row = p.big + (size_t)(b * L + tc) * INCP + hh * 128 + d; qraw[ii] = row[C_Q]; kraw[ii] = row[C_K];
        if (tau < 48) { qraw[ii] = 0; kraw[ii] = 0; } }
    lds_barrier();
    float cs[16]; float run = 0.f;
#pragma unroll
    for (int ii = 0; ii < 16; ++ii) { const int i = seg * 16 + ii; const int tau = dir ? 4159 - (64 * n + i) : 64 * n + i;
        float xg = b2;
#pragma unroll
        for (int r4 = 0; r4 < 4; ++r4) { const f32x4 l4 = *(const f32x4*)(LR + i * 16 + 4 * r4); xg += l4[0] * w2[4 * r4] + l4[1] * w2[4 * r4 + 1] + l4[2] * w2[4 * r4 + 2] + l4[3] * w2[4 * r4 + 3]; }
        const float lg = tau >= 48 ? (fminf(xg, 0.f) - __logf(1.0f + __expf(-fabsf(xg)))) * (1.0f / 16.0f) : 0.f;
        run += lg; cs[ii] = run; }
    SEGT[seg * 128 + d] = run;
    lds_barrier();
    float off = 0.f, tot = 0.f;
#pragma unroll
    for (int s = 0; s < 4; ++s) { const float v = SEGT[s * 128 + d]; if (s < seg) off += v; tot += v; }
    unsigned kt[8];
#pragma unroll
    for (int ii = 0; ii < 16; ii += 2) { float kh[2];
#pragma unroll
        for (int x = 0; x < 2; ++x) { const int i = seg * 16 + ii + x; const float q = bf2f(qraw[ii + x]), k = bf2f(kraw[ii + x]);
            const float bi = off + cs[ii + x]; const bf16_t qv = f2bf(q * 0.08838834764831845f * __expf(bi));
            QS[i * 136 + d] = qv; KS[i * 136 + d] = f2bf(k * __expf(-bi)); *(bf16_t*)(gp + GP_QT + (i * 128 + d) * 2) = qv; kh[x] = k * __expf(tot - bi); }
        kt[ii >> 1] = pk2(kh[0], kh[1]); }
    { u32x4v w0, w1; w0[0] = kt[0]; w0[1] = kt[1]; w0[2] = kt[2]; w0[3] = kt[3]; w1[0] = kt[4]; w1[1] = kt[5]; w1[2] = kt[6]; w1[3] = kt[7];
      *(u32x4v*)(gp + GP_KT + (d * 64 + seg * 16) * 2) = w0; *(u32x4v*)(gp + GP_KT + (d * 64 + seg * 16 + 8) * 2) = w1; }
    if (seg == 0) *(float*)(gp + GP_DEC + d * 4) = __expf(tot);
    lds_barrier();
    { const int it = wid >> 1;
#pragma unroll
      for (int x = 0; x < 2; ++x) { const int jt = (wid & 1) * 2 + x; f32x4 acc = {0.f, 0.f, 0.f, 0.f};
#pragma unroll
          for (int ks = 0; ks < 4; ++ks) { const pg8::bf16x8 a = *(const pg8::bf16x8*)(QS + (16 * it + li) * 136 + 32 * ks + 8 * kq), bb = *(const pg8::bf16x8*)(KS + (16 * jt + li) * 136 + 32 * ks + 8 * kq);
              acc = __builtin_amdgcn_mfma_f32_16x16x32_bf16(a, bb, acc, 0, 0, 0); }
#pragma unroll
          for (int r = 0; r < 4; ++r) { const int i = 16 * it + 4 * kq + r, j = 16 * jt + li; *(bf16_t*)(gp + GP_AM + (i * 64 + j) * 2) = f2bf(j <= i ? acc[r] : 0.f); } } }
    lds_barrier();
}

__device__ void gla_scan(const Params& p, int item, unsigned char* sm, unsigned long long& tsec) {
    const int s = item & 7, bdh = item >> 3, hh = bdh & 3, dir = (bdh >> 2) & 1, b = bdh >> 3;
    const int tid = ltid_w(p.wave), lane = tid & 63, wid = tid >> 6, li = lane & 15, kq = lane >> 4;
    constexpr int O_VT = 0, SZ_VT = 32 * 72 * 2, O_ST = 2 * SZ_VT;
    float* outp = dir ? p.ob : p.of;
    const unsigned char* gbase = p.gp + (size_t)(bdh * 65) * GP_STRIDE;
    const int it = wid >> 1, eto = wid & 1;
    struct RS { u32x4v fa[2], fq[4], fk[2], v; f32x4 dec; };
    auto LOAD = [&](int n, RS& R) {
        const unsigned char* g = gbase + (size_t)n * GP_STRIDE;
#pragma unroll
        for (int ks = 0; ks < 2; ++ks) R.fa[ks] = *(const u32x4v*)(g + GP_AM + ((16 * it + li) * 64 + 32 * ks + 8 * kq) * 2);
#pragma unroll
        for (int ks = 0; ks < 4; ++ks) R.fq[ks] = *(const u32x4v*)(g + GP_QT + ((16 * it + li) * 128 + 32 * ks + 8 * kq) * 2);
#pragma unroll
        for (int ks = 0; ks < 2; ++ks) R.fk[ks] = *(const u32x4v*)(g + GP_KT + ((16 * wid + li) * 64 + 32 * ks + 8 * kq) * 2);
        R.dec = *(const f32x4*)(g + GP_DEC + (16 * wid + 4 * kq) * 4);
        const int tau = dir ? 4159 - (64 * n + lane) : 64 * n + lane;
        R.v = (u32x4v){0u, 0u, 0u, 0u};
        R.v = *(const u32x4v*)(p.big + (size_t)(b * L + (tau < 48 ? 0 : tau - 48)) * INCP + C_V + hh * 256 + s * 32 + (wid & 3) * 8);
    };
    auto PUTV = [&](int buf, const RS& R) {
        if (wid < 4) { bf16_t* vt = (bf16_t*)(sm + O_VT + buf * SZ_VT);
#pragma unroll
            for (int x = 0; x < 4; ++x) { vt[(wid * 8 + 2 * x) * 72 + lane] = (bf16_t)(R.v[x] & 0xffffu); vt[(wid * 8 + 2 * x + 1) * 72 + lane] = (bf16_t)(R.v[x] >> 16); } }
    };
    f32x4 S[2];
    S[0] = (f32x4){0.f, 0.f, 0.f, 0.f}; S[1] = S[0];
    for (int i = tid; i < 8704 / 16; i += 512) *(u32x4v*)(sm + O_ST + i * 16) = (u32x4v){0u, 0u, 0u, 0u};
    const bf16_t* ST = (const bf16_t*)(sm + O_ST);
    auto STEP = [&](int n, RS& RA, const RS& RB, RS& RC) {
        unsigned long long ts0_ = PROBE_MASK ? wall_clock64() : 0ull;
        if (n + 2 < 65) LOAD(n + 2, RC);
        const bf16_t* VT = (const bf16_t*)(sm + O_VT + (n & 1) * SZ_VT);
        { f32x4 o = {0.f, 0.f, 0.f, 0.f};
#pragma unroll
          for (int ks = 0; ks < 2; ++ks) { const pg8::bf16x8 bb = *(const pg8::bf16x8*)(VT + (16 * eto + li) * 72 + 32 * ks + 8 * kq);
              o = __builtin_amdgcn_mfma_f32_16x16x32_bf16(__builtin_bit_cast(pg8::bf16x8, RA.fa[ks]), bb, o, 0, 0, 0); }
#pragma unroll
          for (int ks = 0; ks < 4; ++ks) { const pg8::bf16x8 bb = *(const pg8::bf16x8*)(ST + (16 * eto + li) * 136 + 32 * ks + 8 * kq);
              o = __builtin_amdgcn_mfma_f32_16x16x32_bf16(__builtin_bit_cast(pg8::bf16x8, RA.fq[ks]), bb, o, 0, 0, 0); }
#pragma unroll
          for (int r = 0; r < 4; ++r) { const int i = 16 * it + 4 * kq + r; const int tau = dir ? 4159 - (64 * n + i) : 64 * n + i;
              float* dst = tau >= 48 ? outp + (size_t)(b * L + tau - 48) * 1024 + hh * 256 + s * 32 + 16 * eto + li : p.dummy + tid;
              *dst = o[r]; } }
#pragma unroll
        for (int et = 0; et < 2; ++et) { S[et] *= RA.dec;
#pragma unroll
            for (int ks = 0; ks < 2; ++ks) { const pg8::bf16x8 bb = *(const pg8::bf16x8*)(VT + (16 * et + li) * 72 + 32 * ks + 8 * kq);
                S[et] = __builtin_amdgcn_mfma_f32_16x16x32_bf16(__builtin_bit_cast(pg8::bf16x8, RA.fk[ks]), bb, S[et], 0, 0, 0); } }
        HSEC(25);
        lds_barrier();
        HSEC(26);
#pragma unroll
        for (int et = 0; et < 2; ++et) { u32x2v w; w[0] = pk2(S[et][0], S[et][1]); w[1] = pk2(S[et][2], S[et][3]);
            *(u32x2v*)(sm + O_ST + ((16 * et + li) * 136 + 16 * wid + 4 * kq) * 2) = w; }
        if (n + 1 < 65) PUTV((n + 1) & 1, RB);
        lds_barrier();
        HSEC(27);
    };
    RS R0, R1, R2;
    LOAD(0, R0); LOAD(1, R1);
    PUTV(0, R0);
    lds_barrier();
    for (int n = 0; n < 63; n += 3) { STEP(n, R0, R1, R2); STEP(n + 1, R1, R2, R0); STEP(n + 2, R2, R0, R1); }
    STEP(63, R0, R1, R2); STEP(64, R1, R2, R0);
}

__device__ void fin_item(const Params& p, int item) {
    const int tid__ = ltid_w(p.wave), wid = tid__ >> 6, lane = tid__ & 63, m = item * 8 + wid;
    bf16_t* yrow = p.y + (size_t)m * D;
    if (m >= M) { const u32x4v z = {0u, 0u, 0u, 0u};
#pragma unroll
        for (int i = 0; i < 4; ++i) *(u32x4v*)(yrow + (lane + 64 * i) * 8) = z;
        return; }
    const int c0 = lane * 16;
    {
      const int b = m >= L ? 1 : 0, t = m - b * L;
      float x0[16];
#pragma unroll
      for (int i = 0; i < 4; ++i) { const f32x4 cb = *(const f32x4*)(p.conv_b + c0 + 4 * i); x0[4 * i] = cb[0]; x0[4 * i + 1] = cb[1]; x0[4 * i + 2] = cb[2]; x0[4 * i + 3] = cb[3]; }
#pragma unroll
      for (int jj = 0; jj < 3; ++jj) { const int t2 = t + jj - 1; const bool ok = t2 >= 0 && t2 < L; const int t2c = t2 < 0 ? 0 : (t2 >= L ? L - 1 : t2);
          { const bf16_t* row = p.big + (size_t)(b * L + t2c) * INCP + c0; const u32x4v r0 = *(const u32x4v*)row, r1 = *(const u32x4v*)(row + 8); const float okf = ok ? 1.f : 0.f;
#pragma unroll
              for (int i = 0; i < 4; ++i) { const f32x4 cw = *(const f32x4*)(p.conv_w + jj * 3072 + c0 + 4 * i) * okf; const unsigned lo = i < 2 ? r0[2 * i] : r1[2 * i - 4], hi = i < 2 ? r0[2 * i + 1] : r1[2 * i - 3];
                  x0[4 * i] += __uint_as_float(lo << 16) * cw[0]; x0[4 * i + 1] += __uint_as_float(lo & 0xffff0000u) * cw[1]; x0[4 * i + 2] += __uint_as_float(hi << 16) * cw[2]; x0[4 * i + 3] += __uint_as_float(hi & 0xffff0000u) * cw[3]; } } }
      const bf16_t* src = p.yc + (size_t)m * 1024 + c0; const u32x4v y0 = *(const u32x4v*)src, y1 = *(const u32x4v*)(src + 8);
      f32x4 v[4]; float ss = 0.f;
#pragma unroll
      for (int i = 0; i < 4; ++i) { const unsigned lo = i < 2 ? y0[2 * i] : y1[2 * i - 4], hi = i < 2 ? y0[2 * i + 1] : y1[2 * i - 3];
          v[i][0] = __uint_as_float(lo << 16) * x0[4 * i]; v[i][1] = __uint_as_float(lo & 0xffff0000u) * x0[4 * i + 1]; v[i][2] = __uint_as_float(hi << 16) * x0[4 * i + 2]; v[i][3] = __uint_as_float(hi & 0xffff0000u) * x0[4 * i + 3];
          ss += (v[i][0] * v[i][0] + v[i][1] * v[i][1]) + (v[i][2] * v[i][2] + v[i][3] * v[i][3]); }
      ss += shx<1>(ss); ss += shx<2>(ss); ss += shx<4>(ss);
      const float r = rsqrtf(ss * (1.0f / 128.0f) + EPS);
      u32x4v w0, w1;
#pragma unroll
      for (int i = 0; i < 4; ++i) { const f32x4 g = *(const f32x4*)(p.hyena_norm + c0 + 4 * i); const f32x4 o = v[i] * r * g;
          if (i < 2) { w0[2 * i] = pk2(o[0], o[1]); w0[2 * i + 1] = pk2(o[2], o[3]); } else { w1[2 * i - 4] = pk2(o[0], o[1]); w1[2 * i - 3] = pk2(o[2], o[3]); } }
      *(u32x4v*)(yrow + c0) = w0; *(u32x4v*)(yrow + c0 + 8) = w1; }
    { const float* s1 = p.of + (size_t)m * 1024 + c0; const float* s2 = p.ob + (size_t)m * 1024 + c0; f32x4 v[4]; float ss = 0.f;
#pragma unroll
      for (int i = 0; i < 4; ++i) { v[i] = *(const f32x4*)(s1 + 4 * i) + *(const f32x4*)(s2 + 4 * i); ss += (v[i][0] * v[i][0] + v[i][1] * v[i][1]) + (v[i][2] * v[i][2] + v[i][3] * v[i][3]); }
      ss += shx<1>(ss); ss += shx<2>(ss); ss += shx<4>(ss); ss += shx<8>(ss);
      const float r = rsqrtf(ss * (1.0f / 256.0f) + EPS);
      const bf16_t* og = p.big + (size_t)m * INCP + C_OG + c0;
      const u32x4v g0 = *(const u32x4v*)og, g1 = *(const u32x4v*)(og + 8);
      float ogf[16];
#pragma unroll
      for (int i = 0; i < 4; ++i) { ogf[2 * i] = __uint_as_float(g0[i] << 16); ogf[2 * i + 1] = __uint_as_float(g0[i] & 0xffff0000u); ogf[8 + 2 * i] = __uint_as_float(g1[i] << 16); ogf[8 + 2 * i + 1] = __uint_as_float(g1[i] & 0xffff0000u); }
      u32x4v w0, w1;
#pragma unroll
      for (int i = 0; i < 4; ++i) { const f32x4 g = *(const f32x4*)(p.gla_norm + ((c0 + 4 * i) & 255)); f32x4 o = v[i] * r * g;
          o[0] *= silu_f(ogf[4 * i]); o[1] *= silu_f(ogf[4 * i + 1]); o[2] *= silu_f(ogf[4 * i + 2]); o[3] *= silu_f(ogf[4 * i + 3]);
          if (i < 2) { w0[2 * i] = pk2(o[0], o[1]); w0[2 * i + 1] = pk2(o[2], o[3]); } else { w1[2 * i - 4] = pk2(o[0], o[1]); w1[2 * i - 3] = pk2(o[2], o[3]); } }
      *(u32x4v*)(yrow + 1024 + c0) = w0; *(u32x4v*)(yrow + 1024 + c0 + 8) = w1; }
}

__device__ void final_item(const Params& p, int item) {
    const int tid__ = ltid_w(p.wave), wid = tid__ >> 6, lane = tid__ & 63, row = item * 8 + wid, b = row >> 12, s = row & 4095, m = b * L + NMETA + s;
    const float* hrow = p.h + (size_t)m * D; float* orow = p.out + (size_t)row * D; f32x4 v[8]; float ss = 0.f;
#pragma unroll
    for (int i = 0; i < 8; ++i) { v[i] = *(const f32x4*)(hrow + (lane + 64 * i) * 4); ss += (v[i][0] * v[i][0] + v[i][1] * v[i][1]) + (v[i][2] * v[i][2] + v[i][3] * v[i][3]); }
    ss = wave_sum(ss); const float r = rsqrtf(ss * (1.0f / D) + EPS);
#pragma unroll
    for (int i = 0; i < 8; ++i) { const int c = (lane + 64 * i) * 4; *(f32x4*)(orow + c) = v[i] * r * *(const f32x4*)(p.final_norm + c); }
}

template <class TEpi> __device__ __forceinline__ void tail_tile(const bf16_t* A, int arow0, const bf16_t* Bt, int brow0, int brow1, const int K, float* red, const TEpi& E, int c, const int wave) {
    const int tid = ltid_w(wave), wid = tid >> 6, lane = tid & 63, li = lane & 15, kq = lane >> 4;
    const int kw = K >> 3, k0 = wid * kw;
    const bf16_t* ap = A + (size_t)(arow0 + li) * K + k0 + 8 * kq;
    const bf16_t* bp0 = Bt + (size_t)(brow0 + li) * K + k0 + 8 * kq;
    const bf16_t* bp1 = Bt + (size_t)(brow1 + li) * K + k0 + 8 * kq;
    f32x4 acc[2][4];
#pragma unroll
    for (int x = 0; x < 2; ++x)
#pragma unroll
        for (int y = 0; y < 4; ++y) acc[x][y] = (f32x4){0.f, 0.f, 0.f, 0.f};
#pragma unroll 4
    for (int k = 0; k < kw; k += 32) {
        pg8::bf16x8 a[2], bfr[4];
        a[0] = *(const pg8::bf16x8*)(ap + k); a[1] = *(const pg8::bf16x8*)(ap + (size_t)16 * K + k);
        bfr[0] = *(const pg8::bf16x8*)(bp0 + k); bfr[1] = *(const pg8::bf16x8*)(bp0 + (size_t)16 * K + k);
        bfr[2] = *(const pg8::bf16x8*)(bp1 + k); bfr[3] = *(const pg8::bf16x8*)(bp1 + (size_t)16 * K + k);
#pragma unroll
        for (int x = 0; x < 2; ++x)
#pragma unroll
            for (int y = 0; y < 4; ++y) acc[x][y] = __builtin_amdgcn_mfma_f32_16x16x32_bf16(bfr[y], a[x], acc[x][y], 0, 0, 0);
    }
#pragma unroll
    for (int x = 0; x < 2; ++x)
#pragma unroll
        for (int y = 0; y < 4; ++y) *(f32x4*)(red + wid * 2048 + (16 * x + li) * 64 + 16 * y + 4 * kq) = acc[x][y];
    lds_barrier();
    { const int row = tid >> 4, col4 = (tid & 15) * 4; f32x4 v = {0.f, 0.f, 0.f, 0.f};
#pragma unroll
      for (int w = 0; w < 8; ++w) v += *(const f32x4*)(red + w * 2048 + row * 64 + col4);
      E(arow0 + row, c, col4, v); }
    lds_barrier();
}
struct TEpiResid {
    float* H; bf16_t* HB; float* rowss; float scale;
    __device__ __forceinline__ void operator()(int r, int c, int col4, f32x4 v) const {
        float* hp = H + (size_t)r * D + c * 64 + col4; f32x4 a = *(const f32x4*)hp; a += v * scale; *(f32x4*)hp = a;
        float ss = (a[0] * a[0] + a[1] * a[1]) + (a[2] * a[2] + a[3] * a[3]);
        ss += shx<1>(ss); ss += shx<2>(ss); ss += shx<4>(ss); ss += shx<8>(ss);
        if (HB) { u32x2v w; w[0] = pk2(a[0], a[1]); w[1] = pk2(a[2], a[3]); *(u32x2v*)(HB + (size_t)r * D + c * 64 + col4) = w; }
        if (rowss && (lane_id() & 15) == 0) rowss[(size_t)r * 32 + c] = ss;
    }
};
struct TEpiScale {
    bf16_t* O; int ldc; const float* rowss;
    __device__ __forceinline__ void operator()(int r, int c, int col4, f32x4 v) const {
        const int l = lane_id() & 15; float s = rowss[(size_t)r * 32 + 2 * l] + rowss[(size_t)r * 32 + 2 * l + 1];
        s += shx<1>(s); s += shx<2>(s); s += shx<4>(s); s += shx<8>(s);
        const float rs = rsqrtf(s * (1.0f / D) + EPS);
        u32x2v w; w[0] = pk2(v[0] * rs, v[1] * rs); w[1] = pk2(v[2] * rs, v[3] * rs); *(u32x2v*)(O + (size_t)r * ldc + c * 64 + col4) = w;
    }
};

#define run_gemm(...) run_gemm_(__VA_ARGS__, p.wave)
template <class Epi> __device__ __forceinline__ void run_gemm_(PG8_LAS unsigned char* lds, const bf16_t* A, const bf16_t* Bt, int Mr, int N, int K, const Epi& E, const int wave) {
    pg8::Gemm g; g.A = A; g.Bt = Bt; g.M = Mr; g.N = N; g.K = K;
    pg8::StaticOrder S; S.init(Mr, N, (int)gridDim.x, (int)blockIdx.x);
    pg8::gemm_phase<Epi, pg8::StaticOrder>(lds, g, S, E, ltid_w(wave));
}

__device__ __forceinline__ void gbar(const __attribute__((address_space(4))) Params* kp, int wave, int k) {
    __syncthreads();
    if (ltid_w(wave) == 0) {
        unsigned* bar = kp->bar; const unsigned target = (unsigned)k * gridDim.x;
        __threadfence();
        __hip_atomic_fetch_add(bar, 1u, __ATOMIC_RELEASE, __HIP_MEMORY_SCOPE_AGENT);
        while (__hip_atomic_load(bar, __ATOMIC_RELAXED, __HIP_MEMORY_SCOPE_AGENT) < target) __builtin_amdgcn_s_sleep(1);
        __threadfence();
    }
    __syncthreads();
}
typedef const __attribute__((address_space(4))) Params* KParams;
#if defined(__HIP_DEVICE_COMPILE__)
#define LOADP() Params p; { KParams q_ = kp; asm volatile("" : "+s"(q_)); p = *q_; p.wave = wave_s; }
#else
#define LOADP() Params p = p_unused; p.wave = wave_s; (void)kp;
#endif
#define PSEC(i, stmt) do { unsigned long long a_ = PROBE_MASK ? wall_clock64() : 0ull; stmt; if (PROBE_MASK && ((PROBE_MASK >> (i)) & 1u)) t_acc += wall_clock64() - a_; } while (0)
#define MARK(i) do { if (PROBE_MASK) { const unsigned long long t_ = wall_clock64(); if ((PROBE_MASK >> (i)) & 1u) t_acc += t_ - t_last; t_last = t_; } } while (0)
__global__ __launch_bounds__(512, 2) void mega(Params p_unused) {
    KParams kp = (KParams)__builtin_amdgcn_kernarg_segment_ptr();
    const int wave_s = __builtin_amdgcn_readfirstlane((int)(threadIdx.x >> 6));
    unsigned long long t_acc = 0ull, t_last = PROBE_MASK ? wall_clock64() : 0ull;
    extern __shared__ __attribute__((aligned(16))) unsigned char smem[];
    cg::grid_group grid = cg::this_grid();
    PG8_LAS unsigned char* lds = (PG8_LAS unsigned char*)smem;
    float* smf = (float*)smem;
    const int G = gridDim.x, bid = blockIdx.x;
    { LOADP();
      transpose_mat(p.ffn1_wg, p.Wgu1, p.ffn1_norm, D, DFF, DFF, DFF, 1, smf, p.wave);
      transpose_mat(p.ffn1_wu, p.Wgu1, p.ffn1_norm, D, DFF, DFF, DFF, 2, smf, p.wave);
      transpose_mat(p.ffn1_wd, p.Wd1, nullptr, DFF, D, D, D, 0, smf, p.wave); }
    { LOADP();
      transpose_mat(p.w_in, p.Win, p.mix_norm, D, INCP, INC, INC, 0, smf, p.wave);
      transpose_mat(p.w_out, p.Wout, nullptr, D, D, D, D, 0, smf, p.wave); }
    { LOADP();
      transpose_mat(p.ffn2_wg, p.Wgu2, p.ffn2_norm, D, DFF, DFF, DFF, 1, smf, p.wave);
      transpose_mat(p.ffn2_wu, p.Wgu2, p.ffn2_norm, D, DFF, DFF, DFF, 2, smf, p.wave);
      transpose_mat(p.ffn2_wd, p.Wd2, nullptr, DFF, D, D, D, 0, smf, p.wave); }
    { LOADP();
      if (bid == 0 && ltid_w(p.wave) == 0) *p.ctr = 0u;
      wb_items(p);
      for (int it = bid; it < NT_ROWS + NT_Z2; it += G) { if (it < NT_ROWS) row_item(p, it); else z2_item(p, it - NT_ROWS); } }
    grid.sync(); MARK(0);
    { LOADP(); EpiSwiglu E; E.O = p.big; E.rowss = p.rowss; run_gemm(lds, p.hb, p.Wgu1, MP, 2 * DFF, D, E); }
    gbar(kp, wave_s, 1); MARK(1);
    { LOADP(); EpiResid<true> E; E.H = p.h; E.HB = p.hb; E.rowss = p.rowss; E.scale = 0.5f; run_gemm(lds, p.big, p.Wd1, 8192, D, DFF, E); }
    { LOADP(); TEpiResid T; T.H = p.h; T.HB = p.hb; T.rowss = p.rowss; T.scale = 0.5f;
      for (int c = bid; c < 32; c += G) PSEC(24, tail_tile(p.big, 8192, p.Wd1, 64 * c, 64 * c + 32, DFF, smf, T, c, p.wave)); }
    gbar(kp, wave_s, 2); MARK(2);
    { LOADP(); EpiScale E; E.O = p.big; E.ldc = INCP; E.rowss = p.rowss; run_gemm(lds, p.hb, p.Win, 8192, 6144, D, E); }
    { LOADP(); TEpiScale T; T.O = p.big; T.ldc = INCP; T.rowss = p.rowss;
      for (int it = bid; it < 97 + 256; it += G) { if (it < 97) tail_tile(p.hb, 8192, p.Win, 64 * it, 64 * it + 32, D, smf, T, it, p.wave); else tail_tile(p.hb, 32 * (it - 97), p.Win, 6144, 6176, D, smf, T, 96, p.wave); } }
    gbar(kp, wave_s, 3); MARK(3);
    { LOADP(); EpiFilt E; E.GF = p.GF; E.G0 = p.G0; PSEC(20, run_gemm(lds, p.WB, p.ZA, 2048, 4352, 256, E)); }
    { LOADP(); for (int it = bid; it < 1040 + 520; it += G) { if (it < 1040) PSEC(21, gla_pre(p, it, smem)); else PSEC(22, hyu_item(p, it - 1040, smem)); } }
    gbar(kp, wave_s, 4); MARK(4);
    { LOADP(); if (bid < 128) PSEC(23, gla_scan(p, ((((bid & 7) | (((bid >> 3) & 1) << 3)) << 3) | (bid >> 4)), smem, t_acc)); }
    { LOADP();
      for (;;) {
        if (ltid_w(p.wave) == 0) *(int*)(smem + HY_ZERO_OFF + 192) = (int)atomicAdd(p.ctr, 1u);
        lds_barrier();
        const int g = *(const int*)(smem + HY_ZERO_OFF + 192);
        lds_barrier();
        if (g >= 256) break;
        hyena_group(p, (g & 7) * 32 + (g >> 3), smem, t_acc);
      } }
    gbar(kp, wave_s, 5); MARK(5);
    { LOADP(); for (int it = bid; it < MP / 8; it += G) fin_item(p, it); }
    gbar(kp, wave_s, 6); MARK(6);
    { LOADP(); EpiResid<true> E; E.H = p.h; E.HB = p.hb; E.rowss = p.rowss; E.scale = 1.0f; run_gemm(lds, p.y, p.Wout, 8192, D, D, E); }
    { LOADP(); TEpiResid T; T.H = p.h; T.HB = p.hb; T.rowss = p.rowss; T.scale = 1.0f;
      for (int c = bid; c < 32; c += G) tail_tile(p.y, 8192, p.Wout, 64 * c, 64 * c + 32, D, smf, T, c, p.wave); }
    gbar(kp, wave_s, 7); MARK(7);
    { LOADP(); EpiSwiglu E; E.O = p.big; E.rowss = p.rowss; run_gemm(lds, p.hb, p.Wgu2, MP, 2 * DFF, D, E); }
    gbar(kp, wave_s, 8); MARK(8);
    { LOADP(); EpiResid<false> E; E.H = p.h; E.HB = nullptr; E.rowss = nullptr; E.scale = 0.5f; run_gemm(lds, p.big, p.Wd2, 8192, D, DFF, E); }
    { LOADP(); TEpiResid T; T.H = p.h; T.HB = nullptr; T.rowss = nullptr; T.scale = 0.5f;
      for (int c = bid; c < 32; c += G) tail_tile(p.big, 8192, p.Wd2, 64 * c, 64 * c + 32, DFF, smf, T, c, p.wave); }
    gbar(kp, wave_s, 9); MARK(9);
    { LOADP(); for (int it = bid; it < 1024; it += G) final_item(p, it); }
    MARK(10);
    if (PROBE_MASK && bid == 0) { const unsigned long long t0_ = wall_clock64(); while (wall_clock64() - t0_ < (unsigned long long)PROBE_K * t_acc) __builtin_amdgcn_s_sleep(8); }
}

extern "C" void kernel_launch(void* const* d_in, const int* in_sizes, int n_in, void* d_out, int out_size, void* d_ws, size_t ws_size, hipStream_t stream) {
    static int grid_blocks = 0;
    if (!grid_blocks) {
        (void)hipFuncSetAttribute((const void*)mega, hipFuncAttributeMaxDynamicSharedMemorySize, LDS_BYTES);
        int dev = 0, cus = 0, per_cu = 0;
        (void)hipGetDevice(&dev);
        (void)hipDeviceGetAttribute(&cus, hipDeviceAttributeMultiprocessorCount, dev);
        (void)hipOccupancyMaxActiveBlocksPerMultiprocessor(&per_cu, mega, 512, LDS_BYTES);
        if (per_cu > 1) per_cu = 1;
        if (per_cu < 1) { fprintf(stderr, "occupancy query returned %d\n", per_cu); per_cu = 1; }
        grid_blocks = cus * per_cu;
    }
    Params p{};
    const float* const* in = (const float* const*)d_in;
    p.x = in[0]; p.meta = in[1]; p.ffn1_norm = in[2]; p.ffn1_wg = in[3]; p.ffn1_wu = in[4]; p.ffn1_wd = in[5]; p.mix_norm = in[6]; p.w_in = in[7];
    p.conv_w = in[8]; p.conv_b = in[9]; p.filt_w1 = in[10]; p.filt_b1 = in[11]; p.filt_w2 = in[12]; p.filt_b2 = in[13]; p.filt_w3 = in[14]; p.filt_freq = in[15];
    p.hyena_d = in[16]; p.hyena_norm = in[17]; p.gk_w2 = in[18]; p.gk_b2 = in[19]; p.gla_norm = in[20]; p.w_out = in[21];
    p.ffn2_norm = in[22]; p.ffn2_wg = in[23]; p.ffn2_wu = in[24]; p.ffn2_wd = in[25]; p.final_norm = in[26];
    p.out = (float*)d_out;
    unsigned char* ws = (unsigned char*)d_ws;
    constexpr size_t SZ_WGU = (size_t)2 * DFF * D * 2, SZ_WD = (size_t)D * DFF * 2, SZ_WIN = (size_t)INCP * D * 2, SZ_WOUT = (size_t)D * D * 2;
    constexpr size_t SZ_H = (size_t)MP * D * 4, SZ_HB = (size_t)MP * D * 2, SZ_BIG = (size_t)MP * INCP * 2, SZ_RS = (size_t)MP * 32 * 4, SZ_Z2 = (size_t)L * 64 * 4;
    size_t o = 0;
    p.Wgu1 = (bf16_t*)(ws + o); o += SZ_WGU; p.Wd1 = (bf16_t*)(ws + o); o += SZ_WD; p.Win = (bf16_t*)(ws + o); o += SZ_WIN; p.Wout = (bf16_t*)(ws + o); o += SZ_WOUT;
    p.Wgu2 = (bf16_t*)(ws + o); o += SZ_WGU; p.Wd2 = (bf16_t*)(ws + o); o += SZ_WD;
    p.h = (float*)(ws + o); o += SZ_H; p.hb = (bf16_t*)(ws + o); o += SZ_HB; p.big = (bf16_t*)(ws + o); o += SZ_BIG; p.rowss = (float*)(ws + o); o += SZ_RS; p.z2 = (float*)(ws + o); o += SZ_Z2; p.ctr = (unsigned*)(ws + o); o += 256; p.ZA = (bf16_t*)(ws + o); o += (size_t)4352 * 256 * 2; p.WB = (bf16_t*)(ws + o); o += (size_t)2048 * 256 * 2; p.G0 = (float*)(ws + o); o += 2048 * 4; p.bar = (unsigned*)(ws + o); o += 256; p.dummy = (float*)(ws + o); o += 4096;
    p.yc = (bf16_t*)ws; p.y = (bf16_t*)(ws + (size_t)M * 1024 * 2); p.of = (float*)p.hb; p.ob = (float*)d_out; p.gp = ws + (size_t)M * 1024 * 2; p.GF = p.Win; p.uT = (bf16_t*)((unsigned char*)d_out + (size_t)M * 1024 * 4);
    if (o > ws_size) fprintf(stderr, "workspace too small: need %zu have %zu\n", o, ws_size);
    (void)hipMemsetAsync(p.bar, 0, 256, stream);
    void* args[] = {&p};
    hipError_t e = hipLaunchCooperativeKernel((void*)mega, dim3(grid_blocks), dim3(512), args, LDS_BYTES, stream);
    if (e != hipSuccess) fprintf(stderr, "cooperative launch failed: %s (grid %d)\n", hipGetErrorString(e), grid_blocks);
}
```

```cpp
#include <hip/hip_runtime.h>
#include <hip/hip_cooperative_groups.h>
#include <cstdio>
namespace cg = cooperative_groups;
namespace pg8 {
#define PG8_LAS __attribute__((address_space(3)))
typedef unsigned short bf16_t;
typedef short bf16x8 __attribute__((ext_vector_type(8)));
typedef float f32x4 __attribute__((ext_vector_type(4)));
typedef unsigned u32x4 __attribute__((ext_vector_type(4)));
constexpr int BM = 256, BK = 64, HALF = 128, HTB = HALF * BK * 2  , STAGE_BYTES = 8 * HTB, NXCD = 8, WGM = 8;

__host__ __device__ __forceinline__ int lds_byte(int r, int c) { const int st = (r >> 4) * 2 + (c >> 5), rr = r & 15, cc = c & 31, ob = rr * 64 + cc * 2; return st * 1024 + (ob ^ (((ob >> 9) & 1) << 5)); }
__host__ __device__ __forceinline__ void stage_rc(int b, int& R, int& C) { const int st = b / 1024, sb = b % 1024, swz = sb ^ (((sb >> 9) & 1) << 5); R = (st >> 1) * 16 + swz / 64; C = (st & 1) * 32 + (swz % 64) / 2; }
__host__ __device__ __forceinline__ int perm32(int rho) { const int n = rho >> 4, i = rho & 15; return 8 * (i >> 2) + 4 * n + (i & 3); }

struct Unit { int pm, pn; };
struct Gemm { const bf16_t* A; const bf16_t* Bt; int M, N, K; };

struct StaticOrder {
    int nM, nN, nwg, G, c;
    __host__ __device__ void init(int M, int N, int G_, int c_) { nM = M / BM; nN = N / BM; nwg = nM * nN; G = G_; c = c_; }
    __host__ __device__ bool next(int i, Unit& u) const {
        const long L = (long)i * G + c; if (L >= nwg) return false;
        int wgid = (int)L; { const int q = nwg / NXCD, r = nwg % NXCD, xcd = wgid % NXCD, off = wgid / NXCD; wgid = (xcd < r ? xcd * (q + 1) : r * (q + 1) + (xcd - r) * q) + off; }
        const int nig = WGM * nN, gid = wgid / nig, fm = gid * WGM, gsz = (nM - fm) < WGM ? (nM - fm) : WGM;
        u.pm = fm + ((wgid % nig) % gsz); u.pn = (wgid % nig) / gsz; return true;
    }
    __device__ __forceinline__ void a_ready(const Unit&) const {}
    __device__ __forceinline__ void done(const Unit&) const {}
};
__device__ __forceinline__ unsigned cvt_pk_bf16(float lo, float hi) { unsigned r; asm volatile("v_cvt_pk_bf16_f32 %0, %1, %2" : "=v"(r) : "v"(lo), "v"(hi)); return r; }
template <class Epi, class Sched>
__device__ __forceinline__ void gemm_phase(PG8_LAS unsigned char* lds, const Gemm g, const Sched& S, const Epi& E, const int tid_in) {
    const int tid = tid_in, wid = __builtin_amdgcn_readfirstlane(tid >> 6), lane = tid & 63, wr = wid >> 2, wc = wid & 3, fr = lane & 15, fq = lane >> 4;
    const int K = g.K, nt = K / BK;
    unsigned voffA[2], voffB[2];
#pragma unroll
    for (int i = 0; i < 2; ++i) { int R, C; stage_rc(tid * 16 + i * 8192, R, C); const int Rb = Epi::PERM ? ((R & ~31) + perm32(R & 31)) : R;
        voffA[i] = (unsigned)(R * K + C) * 2u; voffB[i] = (unsigned)(Rb * K + C) * 2u; }
    const size_t kstep = (size_t)(BK * 2);
    const size_t hstep = (size_t)HALF * K * 2;
    const size_t tstep = 2 * hstep;
    const unsigned ldsw = (unsigned)wid * 1024u;
    const int aoff = lds_byte(wr * 64 + fr, fq * 8), boff = lds_byte(wc * 32 + fr, fq * 8);
#define PG8_SA(b, h) (((b) * 2 + (h)) * HTB)
#define PG8_SB(b, h) ((4 + (b) * 2 + (h)) * HTB)
#define PG8_STAGE(bufoff, gbase, voff) do { _Pragma("unroll") for (int _i = 0; _i < 2; ++_i) \
        __builtin_amdgcn_global_load_lds((const unsigned*)((const char*)(gbase) + (voff)[_i]), (PG8_LAS unsigned*)(lds + (bufoff) + ldsw + _i * 8192), 16, 0, 0); } while (0)
#define PG8_LDA(dst, b, h) do { _Pragma("unroll") for (int m = 0; m < 4; ++m) _Pragma("unroll") for (int k = 0; k < 2; ++k) dst[m][k] = *(const PG8_LAS bf16x8*)(lds + PG8_SA(b, h) + aoff + m * 2048 + k * 1024); } while (0)
#define PG8_LDB(dst, b, h) do { _Pragma("unroll") for (int n = 0; n < 2; ++n) _Pragma("unroll") for (int k = 0; k < 2; ++k) dst[n][k] = *(const PG8_LAS bf16x8*)(lds + PG8_SB(b, h) + boff + n * 2048 + k * 1024); } while (0)
#define PG8_MMA(ai, bj, At, Bt) do { __builtin_amdgcn_s_setprio(1); _Pragma("unroll") for (int m = 0; m < 4; ++m) _Pragma("unroll") for (int n = 0; n < 2; ++n) _Pragma("unroll") for (int k = 0; k < 2; ++k) \
        acc[ai][bj][m][n] = __builtin_amdgcn_mfma_f32_16x16x32_bf16(Bt[n][k], At[m][k], acc[ai][bj][m][n], 0, 0, 0); __builtin_amdgcn_s_setprio(0); } while (0)
#define PG8_WAIT_V(n) asm volatile("s_waitcnt vmcnt(" #n ")" ::: "memory")
#define PG8_WAIT_L(n) asm volatile("s_waitcnt lgkmcnt(" #n ")" ::: "memory")
#define PG8_BAR __builtin_amdgcn_s_barrier()
#define PG8_SCHED __builtin_amdgcn_sched_barrier(0)
    Unit cur, nxt; int ui = 0;
    if (!S.next(0, cur)) return;
    f32x4 acc[2][2][4][2];
#pragma unroll
    for (int a = 0; a < 2; ++a)
#pragma unroll
        for (int b = 0; b < 2; ++b)
#pragma unroll
            for (int m = 0; m < 4; ++m)
#pragma unroll
                for (int n = 0; n < 2; ++n) acc[a][b][m][n] = (f32x4){0.f, 0.f, 0.f, 0.f};
    bf16x8 At[4][2], B0[2][2], B1[2][2];
    const char* cA = (const char*)g.A + (size_t)cur.pm * tstep; const char* cB = (const char*)g.Bt + (size_t)cur.pn * tstep;
    S.a_ready(cur);
    PG8_STAGE(PG8_SB(0, 0), cB, voffB); PG8_STAGE(PG8_SA(0, 0), cA, voffA); PG8_STAGE(PG8_SB(0, 1), cB + hstep, voffB); PG8_STAGE(PG8_SA(0, 1), cA + hstep, voffA);
    if (wr == 1) PG8_BAR;
    PG8_WAIT_V(4); PG8_BAR;
    PG8_STAGE(PG8_SB(1, 0), cB + kstep, voffB); PG8_STAGE(PG8_SA(1, 0), cA + kstep, voffA); PG8_STAGE(PG8_SB(1, 1), cB + hstep + kstep, voffB);
    PG8_WAIT_V(6); PG8_BAR;
    for (;;) {
        const bool has_next = S.next(ui + 1, nxt);
        const char* nA = has_next ? (const char*)g.A + (size_t)nxt.pm * tstep : cA; const char* nB = has_next ? (const char*)g.Bt + (size_t)nxt.pn * tstep : cB;
        for (int t = 0; t < nt; t += 2) {
            const bool last = (t == nt - 2);
            const char* a1 = cA + (size_t)(t + 1) * kstep;
            const char* a2 = last ? nA : cA + (size_t)(t + 2) * kstep; const char* b2 = last ? nB : cB + (size_t)(t + 2) * kstep;
            const char* a3 = a2 + kstep; const char* b3 = b2 + kstep;
            if (last && has_next) S.a_ready(nxt);
            PG8_LDB(B0, 0, 0); PG8_SCHED; PG8_LDA(At, 0, 0); PG8_STAGE(PG8_SA(1, 1), a1 + hstep, voffA);
            PG8_WAIT_L(8); PG8_BAR; PG8_WAIT_L(0); PG8_MMA(0, 0, At, B0); PG8_BAR; PG8_SCHED;
            PG8_LDB(B1, 0, 1); PG8_STAGE(PG8_SB(0, 0), b2, voffB);
            PG8_BAR; PG8_WAIT_L(0); PG8_MMA(0, 1, At, B1); PG8_BAR;
            PG8_LDA(At, 0, 1); PG8_STAGE(PG8_SA(0, 0), a2, voffA);
            PG8_BAR; PG8_WAIT_L(0); PG8_MMA(1, 0, At, B0); PG8_BAR; PG8_SCHED;
            PG8_STAGE(PG8_SB(0, 1), b2 + hstep, voffB);
            PG8_WAIT_V(6); PG8_BAR; PG8_MMA(1, 1, At, B1); PG8_BAR;
            PG8_LDB(B0, 1, 0); PG8_SCHED; PG8_LDA(At, 1, 0); PG8_STAGE(PG8_SA(0, 1), a2 + hstep, voffA);
            PG8_WAIT_L(8); PG8_BAR; PG8_WAIT_L(0); PG8_MMA(0, 0, At, B0); PG8_BAR; PG8_SCHED;
            PG8_LDB(B1, 1, 1); PG8_STAGE(PG8_SB(1, 0), b3, voffB);
            PG8_BAR; PG8_WAIT_L(0); PG8_MMA(0, 1, At, B1); PG8_BAR;
            PG8_LDA(At, 1, 1); PG8_STAGE(PG8_SA(1, 0), a3, voffA);
            PG8_BAR; PG8_WAIT_L(0); PG8_MMA(1, 0, At, B0); PG8_BAR; PG8_SCHED;
            PG8_STAGE(PG8_SB(1, 1), b3 + hstep, voffB);
            PG8_WAIT_V(6); PG8_BAR; PG8_MMA(1, 1, At, B1); PG8_BAR;
        }
        if constexpr (!Epi::AFTER_DRAIN) { E(acc, cur, wr, wc, fr, fq); S.done(cur); }
        if (!has_next) break;
#pragma unroll
        for (int a = 0; a < 2; ++a)
#pragma unroll
            for (int b = 0; b < 2; ++b)
#pragma unroll
                for (int m = 0; m < 4; ++m)
#pragma unroll
                    for (int n = 0; n < 2; ++n) acc[a][b][m][n] = (f32x4){0.f, 0.f, 0.f, 0.f};
        cur = nxt; cA = nA; cB = nB; ++ui;
    }
    PG8_WAIT_V(0);
    if (wr == 0) PG8_BAR;
    PG8_BAR;
    if constexpr (Epi::AFTER_DRAIN) { E.fused(acc, cur, wr, wc, fr, fq, lds, wid, lane); S.done(cur); }
#undef PG8_SA
#undef PG8_SB
#undef PG8_STAGE
#undef PG8_LDA
#undef PG8_LDB
#undef PG8_MMA
#undef PG8_WAIT_V
#undef PG8_WAIT_L
#undef PG8_BAR
#undef PG8_SCHED
}
}

#include <cstdio>
#include <ctime>
#include <cstdlib>
#include <cstring>
#include <cmath>
#include <vector>
#include <algorithm>

using pg8::bf16_t; using pg8::f32x4; using pg8::Unit;
typedef unsigned u32x2v __attribute__((ext_vector_type(2)));
typedef unsigned u32x4v __attribute__((ext_vector_type(4)));

constexpr int D = 2048, SEQ = 4096, NMETA = 16, L = 4112, M = 8224, MP = 8448, DFF = 5632, INC = 6176, INCP = 6400;
constexpr float EPS = 1e-6f;
constexpr int LDS_BYTES = 4 * (8336 * 2 + 2 * 65 * 144) + 256;
constexpr unsigned PROBE_MASK = 0u; constexpr int PROBE_K = 8;
#define HSEC(i) do { if (PROBE_MASK) { const unsigned long long t_ = wall_clock64(); if ((PROBE_MASK >> (i)) & 1u) tsec += t_ - ts0_; ts0_ = t_; } } while (0)
constexpr int C_Q = 3072, C_K = 3584, C_V = 4096, C_OG = 5120, C_LR = 6144;

struct Params {
    const float *x, *meta, *ffn1_norm, *ffn1_wg, *ffn1_wu, *ffn1_wd, *mix_norm, *w_in, *conv_w, *conv_b,
        *filt_w1, *filt_b1, *filt_w2, *filt_b2, *filt_w3, *filt_freq, *hyena_d, *hyena_norm, *gk_w2, *gk_b2, *gla_norm, *w_out,
        *ffn2_norm, *ffn2_wg, *ffn2_wu, *ffn2_wd, *final_norm;
    float* out;
    bf16_t *Wgu1, *Wd1, *Win, *Wout, *Wgu2, *Wd2;
    float* h; bf16_t* hb; bf16_t* big; float* rowss; float* z2;
    bf16_t* y; bf16_t* yc; float* of; float* ob; unsigned char* gp; unsigned* ctr; bf16_t* uT; bf16_t* ZA; bf16_t* WB; bf16_t* GF; float* G0; unsigned* bar; float* dummy; int wave; int pad_;
};

__device__ __forceinline__ int lane_id() { return (int)__builtin_amdgcn_mbcnt_hi(~0u, __builtin_amdgcn_mbcnt_lo(~0u, 0u)); }
__device__ __forceinline__ int ltid_w(int wave) { int t = (wave << 6) | lane_id(); asm volatile("" : "+v"(t)); return t; }
__device__ __forceinline__ void lds_barrier() { asm volatile("s_waitcnt lgkmcnt(0)" ::: "memory"); __builtin_amdgcn_s_barrier(); asm volatile("" ::: "memory"); }
__device__ __forceinline__ float bf2f(bf16_t b) { return __uint_as_float(((unsigned)b) << 16); }
__device__ __forceinline__ unsigned pk2(float lo, float hi) { return pg8::cvt_pk_bf16(lo, hi); }
__device__ __forceinline__ bf16_t f2bf(float v) { return (bf16_t)(pk2(v, 0.f) & 0xffffu); }
template <int MSK> __device__ __forceinline__ float shx(float v) {
    if constexpr (MSK < 32) return __int_as_float(__builtin_amdgcn_ds_swizzle(__float_as_int(v), 0x1f | (MSK << 10)));
    else { int l = lane_id(); asm volatile("" : "+v"(l)); return __int_as_float(__builtin_amdgcn_ds_bpermute((l ^ 32) << 2, __float_as_int(v))); }
}
__device__ __forceinline__ float wave_sum(float v) { v += shx<32>(v); v += shx<16>(v); v += shx<8>(v); v += shx<4>(v); v += shx<2>(v); v += shx<1>(v); return v; }
__device__ __forceinline__ float silu_f(float x) { return x * __builtin_amdgcn_rcpf(1.0f + __expf(-x)); }

__device__ __forceinline__ float row_rscale(const float* rowss, int r, int fq) {
    const f32x4* q = (const f32x4*)(rowss + (size_t)r * 32 + fq * 8);
    const f32x4 a = q[0], b = q[1];
    float s = ((a[0] + a[1]) + (a[2] + a[3])) + ((b[0] + b[1]) + (b[2] + b[3]));
    s += shx<16>(s); s += shx<32>(s);
    return rsqrtf(s * (1.0f / D) + EPS);
}

struct EpiSwiglu {
    static constexpr bool PERM = true, AFTER_DRAIN = false;
    bf16_t* O; const float* rowss;
    __device__ __forceinline__ void operator()(const f32x4 (&acc)[2][2][4][2], const Unit& u, int wr, int wc, int fr, int fq) const {
        const int row0 = u.pm * 256 + wr * 64 + fr, col0 = u.pn * 128 + wc * 32 + 8 * fq;
#pragma unroll
        for (int ai = 0; ai < 2; ++ai)
#pragma unroll
            for (int m = 0; m < 4; ++m) {
                const int r = row0 + ai * 128 + m * 16; const float rs = row_rscale(rowss, r, fq);
                u32x4v w;
#pragma unroll
                for (int n = 0; n < 2; ++n) { const f32x4 g = acc[ai][0][m][n] * rs, uu = acc[ai][1][m][n] * rs;
                    w[2 * n] = pk2(silu_f(g[0]) * uu[0], silu_f(g[1]) * uu[1]); w[2 * n + 1] = pk2(silu_f(g[2]) * uu[2], silu_f(g[3]) * uu[3]); }
                *(u32x4v*)(O + (size_t)r * DFF + col0) = w;
            }
    }
};
struct EpiScale {
    static constexpr bool PERM = true, AFTER_DRAIN = false;
    bf16_t* O; int ldc; const float* rowss;
    __device__ __forceinline__ void operator()(const f32x4 (&acc)[2][2][4][2], const Unit& u, int wr, int wc, int fr, int fq) const {
        const int row0 = u.pm * 256 + wr * 64 + fr, col0 = u.pn * 256 + wc * 32 + 8 * fq;
#pragma unroll
        for (int ai = 0; ai < 2; ++ai)
#pragma unroll
            for (int m = 0; m < 4; ++m) {
                const int r = row0 + ai * 128 + m * 16; const float rs = row_rscale(rowss, r, fq);
#pragma unroll
                for (int bj = 0; bj < 2; ++bj) { const f32x4 a = acc[ai][bj][m][0] * rs, b = acc[ai][bj][m][1] * rs;
                    u32x4v w; w[0] = pk2(a[0], a[1]); w[1] = pk2(a[2], a[3]); w[2] = pk2(b[0], b[1]); w[3] = pk2(b[2], b[3]);
                    *(u32x4v*)(O + (size_t)r * ldc + col0 + bj * 128) = w; }
            }
    }
};
template <bool WHB> struct EpiResid {
    static constexpr bool PERM = true, AFTER_DRAIN = false;
    float* H; bf16_t* HB; float* rowss; float scale;
    __device__ __forceinline__ void operator()(const f32x4 (&acc)[2][2][4][2], const Unit& u, int wr, int wc, int fr, int fq) const {
        const int row0 = u.pm * 256 + wr * 64 + fr, col0 = u.pn * 256 + wc * 32 + 8 * fq;
#pragma unroll
        for (int ai = 0; ai < 2; ++ai)
#pragma unroll
            for (int m = 0; m < 4; ++m) {
                const int r = row0 + ai * 128 + m * 16; float ss = 0.f;
#pragma unroll
                for (int bj = 0; bj < 2; ++bj) { float* hp = H + (size_t)r * D + col0 + bj * 128;
                    f32x4 a = *(const f32x4*)hp, b = *(const f32x4*)(hp + 4);
                    a += acc[ai][bj][m][0] * scale; b += acc[ai][bj][m][1] * scale;
                    *(f32x4*)hp = a; *(f32x4*)(hp + 4) = b;
                    ss += (a[0] * a[0] + a[1] * a[1]) + (a[2] * a[2] + a[3] * a[3]) + (b[0] * b[0] + b[1] * b[1]) + (b[2] * b[2] + b[3] * b[3]);
                    if (WHB) { u32x4v w; w[0] = pk2(a[0], a[1]); w[1] = pk2(a[2], a[3]); w[2] = pk2(b[0], b[1]); w[3] = pk2(b[2], b[3]);
                        *(u32x4v*)(HB + (size_t)r * D + col0 + bj * 128) = w; } }
                ss += shx<16>(ss); ss += shx<32>(ss);
                if (WHB && fq == 0) rowss[(size_t)r * 32 + u.pn * 4 + wc] = ss;
            }
    }
};

constexpr int NT_FFN = 2816, NT_WIN = 3200, NT_WOUT = 1024, NT_TR = 6 * NT_FFN + NT_WIN + NT_WOUT, NT_ROWS = MP / 8, NT_Z2 = 4352 / 8, P0_ITEMS = NT_TR + NT_ROWS + NT_Z2;

__device__ __forceinline__ void transpose_mat(const float* src, bf16_t* dst, const float* gain, const int K, const int N, const int ld, const int nvalid, const int mode, float* tl, const int wave) {
    const int nst = (N + 511) / 512, nkt = K / 64, nitems = nkt * nst, tid = ltid_w(wave);
    for (int it = blockIdx.x; it < nitems; it += gridDim.x) {
        const int st = it / nkt, kt = it - st * nkt, k0 = kt * 64, nbase = st * 512;
        { const int r = tid >> 4, c4 = (tid & 15) * 4;
          const float g0 = gain ? gain[k0 + r] : 1.0f, g1 = gain ? gain[k0 + r + 32] : 1.0f;
          f32x4 v[8][2];
#pragma unroll
          for (int s8 = 0; s8 < 8; ++s8)
#pragma unroll
              for (int i = 0; i < 2; ++i) { const int n = nbase + s8 * 64 + c4; v[s8][i] = (f32x4){0.f, 0.f, 0.f, 0.f};
                  if (n < nvalid) v[s8][i] = *(const f32x4*)(src + (size_t)(k0 + r + 32 * i) * ld + n); }
#pragma unroll
          for (int s8 = 0; s8 < 8; ++s8)
#pragma unroll
              for (int i = 0; i < 2; ++i) { const float g = i ? g1 : g0; float* t = tl + s8 * 4160 + (r + 32 * i) * 65 + c4;
                  t[0] = v[s8][i][0] * g; t[1] = v[s8][i][1] * g; t[2] = v[s8][i][2] * g; t[3] = v[s8][i][3] * g; } }
        lds_barrier();
        { const int nl = tid >> 3, k8 = (tid & 7) * 8;
#pragma unroll
          for (int s8 = 0; s8 < 8; ++s8) { const int n0 = nbase + s8 * 64;
              if (n0 < N) { float w8[8];
#pragma unroll
                  for (int j = 0; j < 8; ++j) w8[j] = tl[s8 * 4160 + (k8 + j) * 65 + nl];
                  u32x4v w; w[0] = pk2(w8[0], w8[1]); w[1] = pk2(w8[2], w8[3]); w[2] = pk2(w8[4], w8[5]); w[3] = pk2(w8[6], w8[7]);
                  const long drow0 = mode == 0 ? n0 : (n0 / 128) * 256 + (n0 % 128) + (mode == 2 ? 128 : 0);
                  *(u32x4v*)(dst + (size_t)(drow0 + nl) * K + k0 + k8) = w; } } }
        lds_barrier();
    }
}

__device__ void row_item(const Params& p, int item) {
    const int tid__ = ltid_w(p.wave), wid = tid__ >> 6, lane = tid__ & 63, m = item * 8 + wid;
    float* hrow = p.h + (size_t)m * D; bf16_t* hbrow = p.hb + (size_t)m * D;
    if (m < M) { const int b = m / L, t = m - b * L;
        const float* src = t < NMETA ? p.meta + (size_t)t * D : p.x + ((size_t)b * SEQ + t - NMETA) * D;
        float ss = 0.f;
#pragma unroll
        for (int i = 0; i < 8; ++i) { const int c = (lane + 64 * i) * 4; const f32x4 v = *(const f32x4*)(src + c);
            ss += (v[0] * v[0] + v[1] * v[1]) + (v[2] * v[2] + v[3] * v[3]);
            *(f32x4*)(hrow + c) = v; u32x2v w; w[0] = pk2(v[0], v[1]); w[1] = pk2(v[2], v[3]); *(u32x2v*)(hbrow + c) = w; }
        ss = wave_sum(ss);
        if (lane < 32) p.rowss[(size_t)m * 32 + lane] = lane == 0 ? ss : 0.f;
    } else {
#pragma unroll
        for (int i = 0; i < 8; ++i) { const int c = (lane + 64 * i) * 4; *(f32x4*)(hrow + c) = (f32x4){0.f, 0.f, 0.f, 0.f}; u32x2v w; w[0] = 0u; w[1] = 0u; *(u32x2v*)(hbrow + c) = w; }
        if (lane < 32) p.rowss[(size_t)m * 32 + lane] = 0.f;
    }
}

__device__ void z2_item(const Params& p, int item) {
    const int tid__ = ltid_w(p.wave), wid = tid__ >> 6, lane = tid__ & 63, j = item * 8 + wid;
    bf16_t* za = p.ZA + (size_t)j * 256;
    if (j >= L) { za[lane] = 0; za[64 + lane] = 0; za[128 + lane] = 0; za[192 + lane] = 0; return; }
    float feat = 0.f;
    const float w = (float)(2.0 * 3.14159265358979323846 / L) * (float)j;
    if (lane == 0) feat = (float)j * (1.0f / (float)(L - 1));
    else if (lane <= 32) { const int bi = (lane - 1) & 15; const float band = 1e-4f + (float)bi * ((15.0f - 1e-4f) / 15.0f); const float ang = w * band;
        feat = lane <= 16 ? cosf(ang) : -sinf(ang); }
    float a = p.filt_b1[lane];
    for (int i = 0; i < 33; ++i) a += __int_as_float(__builtin_amdgcn_readlane(__float_as_int(feat), i)) * p.filt_w1[i * 64 + lane];
    const float fr = p.filt_freq[lane];
    const float z1 = sinf(fr * a);
    float c = p.filt_b2[lane];
    for (int k = 0; k < 64; ++k) c += __int_as_float(__builtin_amdgcn_readlane(__float_as_int(z1), k)) * p.filt_w2[k * 64 + lane];
    const float z = sinf(fr * c);
    const bf16_t hi = f2bf(z), lo = f2bf(z - bf2f(hi));
    za[lane] = hi; za[64 + lane] = lo; za[128 + lane] = hi; za[192 + lane] = 0;
}
__device__ void wb_items(const Params& p) {
    for (int idx = blockIdx.x * 512 + ltid_w(p.wave); idx < 2048 * 64; idx += gridDim.x * 512) { const int n = idx >> 6, k = idx & 63;
        const float w = p.filt_w3[(size_t)k * 2048 + n]; const bf16_t hi = f2bf(w), lo = f2bf(w - bf2f(hi));
        bf16_t* wb = p.WB + (size_t)n * 256; wb[k] = hi; wb[64 + k] = hi; wb[128 + k] = lo; wb[192 + k] = 0; }
}
struct EpiFilt {
    static constexpr bool PERM = true, AFTER_DRAIN = false;
    bf16_t* GF; float* G0;
    __device__ __forceinline__ void operator()(const f32x4 (&acc)[2][2][4][2], const Unit& u, int wr, int wc, int fr, int fq) const {
        const int row0 = u.pm * 256 + wr * 64 + fr, col0 = u.pn * 256 + wc * 32 + 8 * fq;
        const float la = -3.0701134573253945f, lb = -15.350567286626973f;
#pragma unroll
        for (int ai = 0; ai < 2; ++ai)
#pragma unroll
            for (int m = 0; m < 4; ++m) { const int n = row0 + ai * 128 + m * 16; const float delta = fabsf(la + (float)(n & 1023) * ((lb - la) / 1023.0f)) * (1.0f / (float)(L - 1));
                const float r1 = __expf(-delta), r2 = r1 * r1, r3 = r2 * r1;
                bf16_t* grow = GF + (size_t)n * 4352 + col0;
#pragma unroll
                for (int bj = 0; bj < 2; ++bj)
#pragma unroll
                    for (int nn = 0; nn < 2; ++nn) { const int j0 = col0 + bj * 128 + 4 * nn; const f32x4 a4 = acc[ai][bj][m][nn];
                        const float w0 = __expf(-(float)j0 * delta);
                        const float v0 = a4[0] * w0, v1 = a4[1] * (w0 * r1), v2 = a4[2] * (w0 * r2), v3 = a4[3] * (w0 * r3);
                        u32x2v w; w[0] = pk2(v0, v1); w[1] = pk2(v2, v3);
                        *(u32x2v*)(grow + bj * 128 + 4 * nn) = w;
                        if (j0 == 0) G0[n] = v0; } }

    }
};

constexpr int HY_G_ELEMS = 8336, HY_G_BYTES = HY_G_ELEMS * 2, HY_USTR = 144, HY_U_BYTES = 65 * HY_USTR, HY_CH_BYTES = HY_G_BYTES + 2 * HY_U_BYTES, HY_ZERO_OFF = 4 * HY_CH_BYTES;
static_assert(HY_ZERO_OFF + 256 <= LDS_BYTES, "lds");
static_assert(HY_CH_BYTES % 16 == 0 && HY_G_BYTES % 16 == 0, "align");
__device__ void hyu_item(const Params& p, int item, unsigned char* sm) {
    const int cb = item & 3, bt = item >> 2, b = bt / 65, tile = bt - b * 65, t0 = tile * 64;
    const int tid = ltid_w(p.wave), tl = tid & 63, qg = tid >> 6, t = t0 + tl;
    bf16_t* LT = (bf16_t*)sm;
#pragma unroll 1
    for (int x = 0; x < 4; ++x) { const int q = qg * 4 + x, c8 = cb * 256 + q * 8;
        float a1[8], a2[8];
#pragma unroll
        for (int h2 = 0; h2 < 2; ++h2) { const f32x4 b1 = *(const f32x4*)(p.conv_b + 1024 + c8 + 4 * h2), b2v = *(const f32x4*)(p.conv_b + 2048 + c8 + 4 * h2);
#pragma unroll
            for (int e = 0; e < 4; ++e) { a1[4 * h2 + e] = b1[e]; a2[4 * h2 + e] = b2v[e]; } }
        {
#pragma unroll
            for (int jj = 0; jj < 3; ++jj) { const int t2 = t + jj - 1; const bool ok = t < L && t2 >= 0 && t2 < L; const int t2c = t2 < 0 ? 0 : (t2 >= L ? L - 1 : t2);
                { const bf16_t* row = p.big + (size_t)(b * L + t2c) * INCP + c8;
                    const u32x4v x1 = *(const u32x4v*)(row + 1024), vh = *(const u32x4v*)(row + 2048); const float okf = ok ? 1.f : 0.f;
#pragma unroll
                    for (int h2 = 0; h2 < 2; ++h2) { const f32x4 w1 = *(const f32x4*)(p.conv_w + jj * 3072 + 1024 + c8 + 4 * h2) * okf, w2 = *(const f32x4*)(p.conv_w + jj * 3072 + 2048 + c8 + 4 * h2) * okf;
                        a1[4 * h2] += __uint_as_float(x1[2 * h2] << 16) * w1[0]; a1[4 * h2 + 1] += __uint_as_float(x1[2 * h2] & 0xffff0000u) * w1[1];
                        a1[4 * h2 + 2] += __uint_as_float(x1[2 * h2 + 1] << 16) * w1[2]; a1[4 * h2 + 3] += __uint_as_float(x1[2 * h2 + 1] & 0xffff0000u) * w1[3];
                        a2[4 * h2] += __uint_as_float(vh[2 * h2] << 16) * w2[0]; a2[4 * h2 + 1] += __uint_as_float(vh[2 * h2] & 0xffff0000u) * w2[1];
                        a2[4 * h2 + 2] += __uint_as_float(vh[2 * h2 + 1] << 16) * w2[2]; a2[4 * h2 + 3] += __uint_as_float(vh[2 * h2 + 1] & 0xffff0000u) * w2[3]; } } }
        }
#pragma unroll
        for (int e = 0; e < 8; ++e) LT[(q * 8 + e) * 72 + tl] = t < L ? (bf16_t)(pk2(a1[e] * a2[e], 0.f) & 0xffffu) : (bf16_t)0;
    }
    lds_barrier();
    { const int row = tid >> 1, half = tid & 1; bf16_t* dst = p.uT + ((size_t)(cb * 256 + row) * 2 + b) * 4160 + t0 + half * 32;
#pragma unroll
      for (int i = 0; i < 4; ++i) *(u32x4v*)(dst + 8 * i) = *(const u32x4v*)(LT + row * 72 + half * 32 + 8 * i); }
    lds_barrier();
}
__device__ void hyena_group(const Params& p, int grp_, unsigned char* sm, unsigned long long& tsec) {
    unsigned long long ts0_ = PROBE_MASK ? wall_clock64() : 0ull;
    const int grp = __builtin_amdgcn_readfirstlane(grp_);
    const int tid = ltid_w(p.wave), wid = tid >> 6, lane = tid & 63, c0 = grp * 4;
    { const unsigned char* src = (const unsigned char*)(p.uT + (size_t)c0 * 2 * 4160);
      for (int idx = tid; idx < 8 * 520; idx += 512) { const int r = idx / 520, i = idx - r * 520;
          *(u32x4v*)(sm + (r >> 1) * HY_CH_BYTES + HY_G_BYTES + (r & 1) * HY_U_BYTES + (i >> 3) * HY_USTR + (i & 7) * 16) = *(const u32x4v*)(src + (size_t)idx * 16); } }
    if (tid < 36) ((unsigned*)(sm + HY_ZERO_OFF))[tid] = 0u;
    for (int i = tid; i < 4 * 113; i += 512) { const int ch = i / 113, q = i - ch * 113; const int idx = q < 49 ? q : 8272 + (q - 49);
        *(unsigned short*)(sm + ch * HY_CH_BYTES + 2 * idx) = 0; }
    for (int idx = tid; idx < 4 * 514; idx += 512) { const int ch = idx / 514, pc = idx - ch * 514, j0 = pc * 8;
        unsigned short* gb = (unsigned short*)(sm + ch * HY_CH_BYTES);
        const u32x4v f = *(const u32x4v*)(p.GF + (size_t)(c0 + ch) * 4352 + j0); u32x4v bk = *(const u32x4v*)(p.GF + (size_t)(1024 + c0 + ch) * 4352 + j0);
        if (pc == 0) bk[0] = (bk[0] & 0xffff0000u) | (pk2(p.G0[c0 + ch] + p.G0[1024 + c0 + ch], 0.f) & 0xffffu);
        *(u32x4v*)(gb + 4160 + j0) = bk;
#pragma unroll
        for (int e = 0; e < 8; ++e) if (pc != 0 || e != 0) gb[4160 - j0 - e] = (unsigned short)((e & 1) ? (f[e >> 1] >> 16) : (f[e >> 1] & 0xffffu)); }
    lds_barrier();
    HSEC(12);
    const int ch = wid >> 1, b = wid & 1, li = lane & 15, kq = lane >> 4;
    unsigned char* Ub = sm + ch * HY_CH_BYTES + HY_G_BYTES + b * HY_U_BYTES;
    const unsigned char* Zb = sm + HY_ZERO_OFF + kq * 16;
    f32x4 acc[4][5];
#pragma unroll
    for (int rb = 0; rb < 4; ++rb)
#pragma unroll
        for (int nb = 0; nb < 5; ++nb) acc[rb][nb] = (f32x4){0.f, 0.f, 0.f, 0.f};
    const unsigned shl = (li & 1) ? 16u : 0u;
    unsigned gq[5];
#pragma unroll
    for (int w = 0; w < 5; ++w) { unsigned t_ = (unsigned)(ch * HY_CH_BYTES + 4 * (((4160 + 8 * kq - li) >> 1) + w)); asm volatile("" : "+v"(t_)); gq[w] = t_; }
    PG8_LAS const unsigned char* sml = (PG8_LAS const unsigned char*)sm;
    auto gload = [&](int mp, unsigned (&e)[5]) {
#pragma unroll
        for (int w = 0; w < 5; ++w) e[w] = *(PG8_LAS const unsigned*)(sml + (gq[w] - 32 * mp));
    };
    auto gmake = [&](const unsigned (&e)[5]) -> pg8::bf16x8 {
        u32x4v r;
#pragma unroll
        for (int w = 0; w < 4; ++w) r[w] = __builtin_amdgcn_alignbit(e[w + 1], e[w], shl);
        return __builtin_bit_cast(pg8::bf16x8, r);
    };
    pg8::bf16x8 F[6];
    unsigned E[4][5];
    { unsigned e0[5], e1[5]; gload(4 * (-64) - 2, e0); gload(4 * (-64) - 1, e1); F[4] = gmake(e0); F[5] = gmake(e1); }
#pragma unroll
    for (int q = 0; q < 4; ++q) gload(4 * (-64) + q, E[q]);
    for (int d = -64; d <= 64; ++d) {
        F[0] = F[4]; F[1] = F[5];
#pragma unroll
        for (int q = 2; q < 6; ++q) F[q] = gmake(E[q - 2]);
        if (d < 64) {
#pragma unroll
            for (int q = 0; q < 4; ++q) gload(4 * (d + 1) + q, E[q]);
        }
        const int nb_lo = d > 0 ? (d >> 4) : 0, nb_hi = (d + 64) >> 4;
#pragma unroll
        for (int nb = 0; nb < 5; ++nb) {
            if (nb >= nb_lo && nb <= nb_hi) {
                const int sblk = 16 * nb + li - d;
                const unsigned char* up = ((unsigned)sblk < 65u) ? (Ub + sblk * HY_USTR + kq * 16) : Zb;
                const pg8::bf16x8 B0 = *(const pg8::bf16x8*)up, B1 = *(const pg8::bf16x8*)(up + 64);
#pragma unroll
                for (int rb = 0; rb < 4; ++rb) {
                    acc[rb][nb] = __builtin_amdgcn_mfma_f32_16x16x32_bf16(F[rb + 2], B0, acc[rb][nb], 0, 0, 0);
                    acc[rb][nb] = __builtin_amdgcn_mfma_f32_16x16x32_bf16(F[rb], B1, acc[rb][nb], 0, 0, 0);
                }
            }
        }
    }
    HSEC(13);
    {
        const float dc = p.hyena_d[c0 + ch];
#pragma unroll
        for (int nb = 0; nb < 5; ++nb) { const int t1 = 16 * nb + li;
            if (t1 < 65) {
#pragma unroll
                for (int rb = 0; rb < 4; ++rb) { unsigned char* up = Ub + t1 * HY_USTR + (16 * rb + 4 * kq) * 2;
                    const u32x2v uu = *(const u32x2v*)up; const f32x4 a = acc[rb][nb];
                    u32x2v w; w[0] = pk2(a[0] + dc * __uint_as_float(uu[0] << 16), a[1] + dc * __uint_as_float(uu[0] & 0xffff0000u));
                    w[1] = pk2(a[2] + dc * __uint_as_float(uu[1] << 16), a[3] + dc * __uint_as_float(uu[1] & 0xffff0000u));
                    *(u32x2v*)up = w; } } }
    }
    lds_barrier();
    for (int tt = tid; tt < 2 * L; tt += 512) { const int bb = tt >= L ? 1 : 0, t = tt - bb * L;
        const unsigned char* up = sm + HY_G_BYTES + bb * HY_U_BYTES + (t >> 6) * HY_USTR + (t & 63) * 2;
        const unsigned v0 = *(const unsigned short*)up, v1 = *(const unsigned short*)(up + HY_CH_BYTES), v2 = *(const unsigned short*)(up + 2 * HY_CH_BYTES), v3 = *(const unsigned short*)(up + 3 * HY_CH_BYTES);
        u32x2v w; w[0] = v0 | (v1 << 16); w[1] = v2 | (v3 << 16);
        *(u32x2v*)(p.yc + (size_t)(bb * L + t) * 1024 + c0) = w; }
    lds_barrier();
    HSEC(14);
}

constexpr int GP_QT = 0, GP_KT = 16384, GP_AM = 32768, GP_DEC = 40960, GP_STRIDE = 41472;
__device__ void gla_pre(const Params& p, int item, unsigned char* sm) {
    const int n = item % 65, bdh = item / 65, hh = bdh & 3, dir = (bdh >> 2) & 1, b = bdh >> 3;
    const int tid = ltid_w(p.wave), d = tid & 127, seg = tid >> 7, lane = tid & 63, wid = tid >> 6, li = lane & 15, kq = lane >> 4;
    float* LR = (float*)sm; float* SEGT = LR + 1024; bf16_t* QS = (bf16_t*)(sm + 8192); bf16_t* KS = QS + 64 * 136;
    unsigned char* gp = p.gp + (size_t)item * GP_STRIDE;
    { const int i = tid >> 3, r2 = (tid & 7) * 2; const int tau = dir ? 4159 - (64 * n + i) : 64 * n + i; float v0 = 0.f, v1 = 0.f;
      { const unsigned w = *(const unsigned*)(p.big + (size_t)(b * L + (tau < 48 ? 0 : tau - 48)) * INCP + C_LR + dir * 16 + r2); if (tau >= 48) { v0 = __uint_as_float(w << 16); v1 = __uint_as_float(w & 0xffff0000u); } }
      LR[i * 16 + r2] = v0; LR[i * 16 + r2 + 1] = v1; }
    float w2[16];
#pragma unroll
    for (int r = 0; r < 16; ++r) w2[r] = p.gk_w2[(size_t)(dir * 16 + r) * 512 + hh * 128 + d];
    const float b2 = p.gk_b2[dir * 512 + hh * 128 + d];
    unsigned short qraw[16], kraw[16];
#pragma unroll
    for (int ii = 0; ii < 16; ++ii) { const int i = seg * 16 + ii; const int tau = dir ? 4159 - (64 * n + i) : 64 * n + i; const int tc = tau < 48 ? 0 : tau - 48;
        const bf16_t* row = p.big + (size_t)(b * L + tc) * INCP + hh * 128 + d; qraw[ii] = row[C_Q]; kraw[ii] = row[C_K];
        if (tau < 48) { qraw[ii] = 0; kraw[ii] = 0; } }
    lds_barrier();
    float cs[16]; float run = 0.f;
#pragma unroll
    for (int ii = 0; ii < 16; ++ii) { const int i = seg * 16 + ii; const int tau = dir ? 4159 - (64 * n + i) : 64 * n + i;
        float xg = b2;
#pragma unroll
        for (int r4 = 0; r4 < 4; ++r4) { const f32x4 l4 = *(const f32x4*)(LR + i * 16 + 4 * r4); xg += l4[0] * w2[4 * r4] + l4[1] * w2[4 * r4 + 1] + l4[2] * w2[4 * r4 + 2] + l4[3] * w2[4 * r4 + 3]; }
        const float lg = tau >= 48 ? (fminf(xg, 0.f) - __logf(1.0f + __expf(-fabsf(xg)))) * (1.0f / 16.0f) : 0.f;
        run += lg; cs[ii] = run; }
    SEGT[seg * 128 + d] = run;
    lds_barrier();
    float off = 0.f, tot = 0.f;
#pragma unroll
    for (int s = 0; s < 4; ++s) { const float v = SEGT[s * 128 + d]; if (s < seg) off += v; tot += v; }
    unsigned kt[8];
#pragma unroll
    for (int ii = 0; ii < 16; ii += 2) { float kh[2];
#pragma unroll
        for (int x = 0; x < 2; ++x) { const int i = seg * 16 + ii + x; const float q = bf2f(qraw[ii + x]), k = bf2f(kraw[ii + x]);
            const float bi = off + cs[ii + x]; const bf16_t qv = f2bf(q * 0.08838834764831845f * __expf(bi));
            QS[i * 136 + d] = qv; KS[i * 136 + d] = f2bf(k * __expf(-bi)); *(bf16_t*)(gp + GP_QT + (i * 128 + d) * 2) = qv; kh[x] = k * __expf(tot - bi); }
        kt[ii >> 1] = pk2(kh[0], kh[1]); }
    { u32x4v w0, w1; w0[0] = kt[0]; w0[1] = kt[1]; w0[2] = kt[2]; w0[3] = kt[3]; w1[0] = kt[4]; w1[1] = kt[5]; w1[2] = kt[6]; w1[3] = kt[7];
      *(u32x4v*)(gp + GP_KT + (d * 64 + seg * 16) * 2) = w0; *(u32x4v*)(gp + GP_KT + (d * 64 + seg * 16 + 8) * 2) = w1; }
    if (seg == 0) *(float*)(gp + GP_DEC + d * 4) = __expf(tot);
    lds_barrier();
    { const int it = wid >> 1;
#pragma unroll
      for (int x = 0; x < 2; ++x) { const int jt = (wid & 1) * 2 + x; f32x4 acc = {0.f, 0.f, 0.f, 0.f};
#pragma unroll
          for (int ks = 0; ks < 4; ++ks) { const pg8::bf16x8 a = *(const pg8::bf16x8*)(QS + (16 * it + li) * 136 + 32 * ks + 8 * kq), bb = *(const pg8::bf16x8*)(KS + (16 * jt + li) * 136 + 32 * ks + 8 * kq);
              acc = __builtin_amdgcn_mfma_f32_16x16x32_bf16(a, bb, acc, 0, 0, 0); }
#pragma unroll
          for (int r = 0; r < 4; ++r) { const int i = 16 * it + 4 * kq + r, j = 16 * jt + li; *(bf16_t*)(gp + GP_AM + (i * 64 + j) * 2) = f2bf(j <= i ? acc[r] : 0.f); } } }
    lds_barrier();
}

__device__ void gla_scan(const Params& p, int item, unsigned char* sm, unsigned long long& tsec) {
    const int s = item & 7, bdh = item >> 3, hh = bdh & 3, dir = (bdh >> 2) & 1, b = bdh >> 3;
    const int tid = ltid_w(p.wave), lane = tid & 63, wid = tid >> 6, li = lane & 15, kq = lane >> 4;
    constexpr int O_VT = 0, SZ_VT = 32 * 72 * 2, O_ST = 2 * SZ_VT;
    float* outp = dir ? p.ob : p.of;
    const unsigned char* gbase = p.gp + (size_t)(bdh * 65) * GP_STRIDE;
    const int it = wid >> 1, eto = wid & 1;
    struct RS { u32x4v fa[2], fq[4], fk[2], v; f32x4 dec; };
    auto LOAD = [&](int n, RS& R) {
        const unsigned char* g = gbase + (size_t)n * GP_STRIDE;
#pragma unroll
        for (int ks = 0; ks < 2; ++ks) R.fa[ks] = *(const u32x4v*)(g + GP_AM + ((16 * it + li) * 64 + 32 * ks + 8 * kq) * 2);
#pragma unroll
        for (int ks = 0; ks < 4; ++ks) R.fq[ks] = *(const u32x4v*)(g + GP_QT + ((16 * it + li) * 128 + 32 * ks + 8 * kq) * 2);
#pragma unroll
        for (int ks = 0; ks < 2; ++ks) R.fk[ks] = *(const u32x4v*)(g + GP_KT + ((16 * wid + li) * 64 + 32 * ks + 8 * kq) * 2);
        R.dec = *(const f32x4*)(g + GP_DEC + (16 * wid + 4 * kq) * 4);
        const int tau = dir ? 4159 - (64 * n + lane) : 64 * n + lane;
        R.v = (u32x4v){0u, 0u, 0u, 0u};
        R.v = *(const u32x4v*)(p.big + (size_t)(b * L + (tau < 48 ? 0 : tau - 48)) * INCP + C_V + hh * 256 + s * 32 + (wid & 3) * 8);
    };
    auto PUTV = [&](int buf, const RS& R) {
        if (wid < 4) { bf16_t* vt = (bf16_t*)(sm + O_VT + buf * SZ_VT);
#pragma unroll
            for (int x = 0; x < 4; ++x) { vt[(wid * 8 + 2 * x) * 72 + lane] = (bf16_t)(R.v[x] & 0xffffu); vt[(wid * 8 + 2 * x + 1) * 72 + lane] = (bf16_t)(R.v[x] >> 16); } }
    };
    f32x4 S[2];
    S[0] = (f32x4){0.f, 0.f, 0.f, 0.f}; S[1] = S[0];
    for (int i = tid; i < 8704 / 16; i += 512) *(u32x4v*)(sm + O_ST + i * 16) = (u32x4v){0u, 0u, 0u, 0u};
    const bf16_t* ST = (const bf16_t*)(sm + O_ST);
    auto STEP = [&](int n, RS& RA, const RS& RB, RS& RC) {
        unsigned long long ts0_ = PROBE_MASK ? wall_clock64() : 0ull;
        if (n + 2 < 65) LOAD(n + 2, RC);
        const bf16_t* VT = (const bf16_t*)(sm + O_VT + (n & 1) * SZ_VT);
        { f32x4 o = {0.f, 0.f, 0.f, 0.f};
#pragma unroll
          for (int ks = 0; ks < 2; ++ks) { const pg8::bf16x8 bb = *(const pg8::bf16x8*)(VT + (16 * eto + li) * 72 + 32 * ks + 8 * kq);
              o = __builtin_amdgcn_mfma_f32_16x16x32_bf16(__builtin_bit_cast(pg8::bf16x8, RA.fa[ks]), bb, o, 0, 0, 0); }
#pragma unroll
          for (int ks = 0; ks < 4; ++ks) { const pg8::bf16x8 bb = *(const pg8::bf16x8*)(ST + (16 * eto + li) * 136 + 32 * ks + 8 * kq);
              o = __builtin_amdgcn_mfma_f32_16x16x32_bf16(__builtin_bit_cast(pg8::bf16x8, RA.fq[ks]), bb, o, 0, 0, 0); }
#pragma unroll
          for (int r = 0; r < 4; ++r) { const int i = 16 * it + 4 * kq + r; const int tau = dir ? 4159 - (64 * n + i) : 64 * n + i;
              float* dst = tau >= 48 ? outp + (size_t)(b * L + tau - 48) * 1024 + hh * 256 + s * 32 + 16 * eto + li : p.dummy + tid;
              *dst = o[r]; } }
#pragma unroll
        for (int et = 0; et < 2; ++et) { S[et] *= RA.dec;
#pragma unroll
            for (int ks = 0; ks < 2; ++ks) { const pg8::bf16x8 bb = *(const pg8::bf16x8*)(VT + (16 * et + li) * 72 + 32 * ks + 8 * kq);
                S[et] = __builtin_amdgcn_mfma_f32_16x16x32_bf16(__builtin_bit_cast(pg8::bf16x8, RA.fk[ks]), bb, S[et], 0, 0, 0); } }
        HSEC(25);
        lds_barrier();
        HSEC(26);
#pragma unroll
        for (int et = 0; et < 2; ++et) { u32x2v w; w[0] = pk2(S[et][0], S[et][1]); w[1] = pk2(S[et][2], S[et][3]);
            *(u32x2v*)(sm + O_ST + ((16 * et + li) * 136 + 16 * wid + 4 * kq) * 2) = w; }
        if (n + 1 < 65) PUTV((n + 1) & 1, RB);
        lds_barrier();
        HSEC(27);
    };
    RS R0, R1, R2;
    LOAD(0, R0); LOAD(1, R1);
    PUTV(0, R0);
    lds_barrier();
    for (int n = 0; n < 63; n += 3) { STEP(n, R0, R1, R2); STEP(n + 1, R1, R2, R0); STEP(n + 2, R2, R0, R1); }
    STEP(63, R0, R1, R2); STEP(64, R1, R2, R0);
}

__device__ void fin_item(const Params& p, int item) {
    const int tid__ = ltid_w(p.wave), wid = tid__ >> 6, lane = tid__ & 63, m = item * 8 + wid;
    bf16_t* yrow = p.y + (size_t)m * D;
    if (m >= M) { const u32x4v z = {0u, 0u, 0u, 0u};
#pragma unroll
        for (int i = 0; i < 4; ++i) *(u32x4v*)(yrow + (lane + 64 * i) * 8) = z;
        return; }
    const int c0 = lane * 16;
    {
      const int b = m >= L ? 1 : 0, t = m - b * L;
      float x0[16];
#pragma unroll
      for (int i = 0; i < 4; ++i) { const f32x4 cb = *(const f32x4*)(p.conv_b + c0 + 4 * i); x0[4 * i] = cb[0]; x0[4 * i + 1] = cb[1]; x0[4 * i + 2] = cb[2]; x0[4 * i + 3] = cb[3]; }
#pragma unroll
      for (int jj = 0; jj < 3; ++jj) { const int t2 = t + jj - 1; const bool ok = t2 >= 0 && t2 < L; const int t2c = t2 < 0 ? 0 : (t2 >= L ? L - 1 : t2);
          { const bf16_t* row = p.big + (size_t)(b * L + t2c) * INCP + c0; const u32x4v r0 = *(const u32x4v*)row, r1 = *(const u32x4v*)(row + 8); const float okf = ok ? 1.f : 0.f;
#pragma unroll
              for (int i = 0; i < 4; ++i) { const f32x4 cw = *(const f32x4*)(p.conv_w + jj * 3072 + c0 + 4 * i) * okf; const unsigned lo = i < 2 ? r0[2 * i] : r1[2 * i - 4], hi = i < 2 ? r0[2 * i + 1] : r1[2 * i - 3];
                  x0[4 * i] += __uint_as_float(lo << 16) * cw[0]; x0[4 * i + 1] += __uint_as_float(lo & 0xffff0000u) * cw[1]; x0[4 * i + 2] += __uint_as_float(hi << 16) * cw[2]; x0[4 * i + 3] += __uint_as_float(hi & 0xffff0000u) * cw[3]; } } }
      const bf16_t* src = p.yc + (size_t)m * 1024 + c0; const u32x4v y0 = *(const u32x4v*)src, y1 = *(const u32x4v*)(src + 8);
      f32x4 v[4]; float ss = 0.f;
#pragma unroll
      for (int i = 0; i < 4; ++i) { const unsigned lo = i < 2 ? y0[2 * i] : y1[2 * i - 4], hi = i < 2 ? y0[2 * i + 1] : y1[2 * i - 3];
          v[i][0] = __uint_as_float(lo << 16) * x0[4 * i]; v[i][1] = __uint_as_float(lo & 0xffff0000u) * x0[4 * i + 1]; v[i][2] = __uint_as_float(hi << 16) * x0[4 * i + 2]; v[i][3] = __uint_as_float(hi & 0xffff0000u) * x0[4 * i + 3];
          ss += (v[i][0] * v[i][0] + v[i][1] * v[i][1]) + (v[i][2] * v[i][2] + v[i][3] * v[i][3]); }
      ss += shx<1>(ss); ss += shx<2>(ss); ss += shx<4>(ss);
      const float r = rsqrtf(ss * (1.0f / 128.0f) + EPS);
      u32x4v w0, w1;
#pragma unroll
      for (int i = 0; i < 4; ++i) { const f32x4 g = *(const f32x4*)(p.hyena_norm + c0 + 4 * i); const f32x4 o = v[i] * r * g;
          if (i < 2) { w0[2 * i] = pk2(o[0], o[1]); w0[2 * i + 1] = pk2(o[2], o[3]); } else { w1[2 * i - 4] = pk2(o[0], o[1]); w1[2 * i - 3] = pk2(o[2], o[3]); } }
      *(u32x4v*)(yrow + c0) = w0; *(u32x4v*)(yrow + c0 + 8) = w1; }
    { const float* s1 = p.of + (size_t)m * 1024 + c0; const float* s2 = p.ob + (size_t)m * 1024 + c0; f32x4 v[4]; float ss = 0.f;
#pragma unroll
      for (int i = 0; i < 4; ++i) { v[i] = *(const f32x4*)(s1 + 4 * i) + *(const f32x4*)(s2 + 4 * i); ss += (v[i][0] * v[i][0] + v[i][1] * v[i][1]) + (v[i][2] * v[i][2] + v[i][3] * v[i][3]); }
      ss += shx<1>(ss); ss += shx<2>(ss); ss += shx<4>(ss); ss += shx<8>(ss);
      const float r = rsqrtf(ss * (1.0f / 256.0f) + EPS);
      const bf16_t* og = p.big + (size_t)m * INCP + C_OG + c0;
      const u32x4v g0 = *(const u32x4v*)og, g1 = *(const u32x4v*)(og + 8);
      float ogf[16];
#pragma unroll
      for (int i = 0; i < 4; ++i) { ogf[2 * i] = __uint_as_float(g0[i] << 16); ogf[2 * i + 1] = __uint_as_float(g0[i] & 0xffff0000u); ogf[8 + 2 * i] = __uint_as_float(g1[i] << 16); ogf[8 + 2 * i + 1] = __uint_as_float(g1[i] & 0xffff0000u); }
      u32x4v w0, w1;
#pragma unroll
      for (int i = 0; i < 4; ++i) { const f32x4 g = *(const f32x4*)(p.gla_norm + ((c0 + 4 * i) & 255)); f32x4 o = v[i] * r * g;
          o[0] *= silu_f(ogf[4 * i]); o[1] *= silu_f(ogf[4 * i + 1]); o[2] *= silu_f(ogf[4 * i + 2]); o[3] *= silu_f(ogf[4 * i + 3]);
          if (i < 2) { w0[2 * i] = pk2(o[0], o[1]); w0[2 * i + 1] = pk2(o[2], o[3]); } else { w1[2 * i - 4] = pk2(o[0], o[1]); w1[2 * i - 3] = pk2(o[2], o[3]); } }
      *(u32x4v*)(yrow + 1024 + c0) = w0; *(u32x4v*)(yrow + 1024 + c0 + 8) = w1; }
}

__device__ void final_item(const Params& p, int item) {
    const int tid__ = ltid_w(p.wave), wid = tid__ >> 6, lane = tid__ & 63, row = item * 8 + wid, b = row >> 12, s = row & 4095, m = b * L + NMETA + s;
    const float* hrow = p.h + (size_t)m * D; float* orow = p.out + (size_t)row * D; f32x4 v[8]; float ss = 0.f;
#pragma unroll
    for (int i = 0; i < 8; ++i) { v[i] = *(const f32x4*)(hrow + (lane + 64 * i) * 4); ss += (v[i][0] * v[i][0] + v[i][1] * v[i][1]) + (v[i][2] * v[i][2] + v[i][3] * v[i][3]); }
    ss = wave_sum(ss); const float r = rsqrtf(ss * (1.0f / D) + EPS);
#pragma unroll
    for (int i = 0; i < 8; ++i) { const int c = (lane + 64 * i) * 4; *(f32x4*)(orow + c) = v[i] * r * *(const f32x4*)(p.final_norm + c); }
}

template <class TEpi> __device__ __forceinline__ void tail_tile(const bf16_t* A, int arow0, const bf16_t* Bt, int brow0, int brow1, const int K, float* red, const TEpi& E, int c, const int wave) {
    const int tid = ltid_w(wave), wid = tid >> 6, lane = tid & 63, li = lane & 15, kq = lane >> 4;
    const int kw = K >> 3, k0 = wid * kw;
    const bf16_t* ap = A + (size_t)(arow0 + li) * K + k0 + 8 * kq;
    const bf16_t* bp0 = Bt + (size_t)(brow0 + li) * K + k0 + 8 * kq;
    const bf16_t* bp1 = Bt + (size_t)(brow1 + li) * K + k0 + 8 * kq;
    f32x4 acc[2][4];
#pragma unroll
    for (int x = 0; x < 2; ++x)
#pragma unroll
        for (int y = 0; y < 4; ++y) acc[x][y] = (f32x4){0.f, 0.f, 0.f, 0.f};
#pragma unroll 6
    for (int k = 0; k < kw; k += 32) {
        pg8::bf16x8 a[2], bfr[4];
        a[0] = *(const pg8::bf16x8*)(ap + k); a[1] = *(const pg8::bf16x8*)(ap + (size_t)16 * K + k);
        bfr[0] = *(const pg8::bf16x8*)(bp0 + k); bfr[1] = *(const pg8::bf16x8*)(bp0 + (size_t)16 * K + k);
        bfr[2] = *(const pg8::bf16x8*)(bp1 + k); bfr[3] = *(const pg8::bf16x8*)(bp1 + (size_t)16 * K + k);
#pragma unroll
        for (int x = 0; x < 2; ++x)
#pragma unroll
            for (int y = 0; y < 4; ++y) acc[x][y] = __builtin_amdgcn_mfma_f32_16x16x32_bf16(bfr[y], a[x], acc[x][y], 0, 0, 0);
    }
#pragma unroll
    for (int x = 0; x < 2; ++x)
#pragma unroll
        for (int y = 0; y < 4; ++y) *(f32x4*)(red + wid * 2048 + (16 * x + li) * 64 + 16 * y + 4 * kq) = acc[x][y];
    lds_barrier();
    { const int row = tid >> 4, col4 = (tid & 15) * 4; f32x4 v = {0.f, 0.f, 0.f, 0.f};
#pragma unroll
      for (int w = 0; w < 8; ++w) v += *(const f32x4*)(red + w * 2048 + row * 64 + col4);
      E(arow0 + row, c, col4, v); }
    lds_barrier();
}
struct TEpiResid {
    float* H; bf16_t* HB; float* rowss; float scale;
    __device__ __forceinline__ void operator()(int r, int c, int col4, f32x4 v) const {
        float* hp = H + (size_t)r * D + c * 64 + col4; f32x4 a = *(const f32x4*)hp; a += v * scale; *(f32x4*)hp = a;
        float ss = (a[0] * a[0] + a[1] * a[1]) + (a[2] * a[2] + a[3] * a[3]);
        ss += shx<1>(ss); ss += shx<2>(ss); ss += shx<4>(ss); ss += shx<8>(ss);
        if (HB) { u32x2v w; w[0] = pk2(a[0], a[1]); w[1] = pk2(a[2], a[3]); *(u32x2v*)(HB + (size_t)r * D + c * 64 + col4) = w; }
        if (rowss && (lane_id() & 15) == 0) rowss[(size_t)r * 32 + c] = ss;
    }
};
struct TEpiScale {
    bf16_t* O; int ldc; const float* rowss;
    __device__ __forceinline__ void operator()(int r, int c, int col4, f32x4 v) const {
        const int l = lane_id() & 15; float s = rowss[(size_t)r * 32 + 2 * l] + rowss[(size_t)r * 32 + 2 * l + 1];
        s += shx<1>(s); s += shx<2>(s); s += shx<4>(s); s += shx<8>(s);
        const float rs = rsqrtf(s * (1.0f / D) + EPS);
        u32x2v w; w[0] = pk2(v[0] * rs, v[1] * rs); w[1] = pk2(v[2] * rs, v[3] * rs); *(u32x2v*)(O + (size_t)r * ldc + c * 64 + col4) = w;
    }
};

#define run_gemm(...) run_gemm_(__VA_ARGS__, p.wave)
template <class Epi> __device__ __forceinline__ void run_gemm_(PG8_LAS unsigned char* lds, const bf16_t* A, const bf16_t* Bt, int Mr, int N, int K, const Epi& E, const int wave) {
    pg8::Gemm g; g.A = A; g.Bt = Bt; g.M = Mr; g.N = N; g.K = K;
    pg8::StaticOrder S; S.init(Mr, N, (int)gridDim.x, (int)blockIdx.x);
    pg8::gemm_phase<Epi, pg8::StaticOrder>(lds, g, S, E, ltid_w(wave));
}

__device__ __forceinline__ void gbar(const __attribute__((address_space(4))) Params* kp, int wave, int k) {
    __syncthreads();
    if (ltid_w(wave) == 0) {
        unsigned* bar = kp->bar; const unsigned target = (unsigned)k * gridDim.x;
        __threadfence();
        __hip_atomic_fetch_add(bar, 1u, __ATOMIC_RELEASE, __HIP_MEMORY_SCOPE_AGENT);
        while (__hip_atomic_load(bar, __ATOMIC_RELAXED, __HIP_MEMORY_SCOPE_AGENT) < target) __builtin_amdgcn_s_sleep(1);
        __threadfence();
    }
    __syncthreads();
}
typedef const __attribute__((address_space(4))) Params* KParams;
#if defined(__HIP_DEVICE_COMPILE__)
#define LOADP() Params p; { KParams q_ = kp; asm volatile("" : "+s"(q_)); p = *q_; p.wave = wave_s; }
#else
#define LOADP() Params p = p_unused; p.wave = wave_s; (void)kp;
#endif
#define PSEC(i, stmt) do { unsigned long long a_ = PROBE_MASK ? wall_clock64() : 0ull; stmt; if (PROBE_MASK && ((PROBE_MASK >> (i)) & 1u)) t_acc += wall_clock64() - a_; } while (0)
#define MARK(i) do { if (PROBE_MASK) { const unsigned long long t_ = wall_clock64(); if ((PROBE_MASK >> (i)) & 1u) t_acc += t_ - t_last; t_last = t_; } } while (0)
__global__ __launch_bounds__(512, 2) void mega(Params p_unused) {
    KParams kp = (KParams)__builtin_amdgcn_kernarg_segment_ptr();
    const int wave_s = __builtin_amdgcn_readfirstlane((int)(threadIdx.x >> 6));
    unsigned long long t_acc = 0ull, t_last = PROBE_MASK ? wall_clock64() : 0ull;
    extern __shared__ __attribute__((aligned(16))) unsigned char smem[];
    cg::grid_group grid = cg::this_grid();
    PG8_LAS unsigned char* lds = (PG8_LAS unsigned char*)smem;
    float* smf = (float*)smem;
    const int G = gridDim.x, bid = blockIdx.x;
    { LOADP();
      transpose_mat(p.ffn1_wg, p.Wgu1, p.ffn1_norm, D, DFF, DFF, DFF, 1, smf, p.wave);
      transpose_mat(p.ffn1_wu, p.Wgu1, p.ffn1_norm, D, DFF, DFF, DFF, 2, smf, p.wave);
      transpose_mat(p.ffn1_wd, p.Wd1, nullptr, DFF, D, D, D, 0, smf, p.wave); }
    { LOADP();
      transpose_mat(p.w_in, p.Win, p.mix_norm, D, INCP, INC, INC, 0, smf, p.wave);
      transpose_mat(p.w_out, p.Wout, nullptr, D, D, D, D, 0, smf, p.wave); }
    { LOADP();
      transpose_mat(p.ffn2_wg, p.Wgu2, p.ffn2_norm, D, DFF, DFF, DFF, 1, smf, p.wave);
      transpose_mat(p.ffn2_wu, p.Wgu2, p.ffn2_norm, D, DFF, DFF, DFF, 2, smf, p.wave);
      transpose_mat(p.ffn2_wd, p.Wd2, nullptr, DFF, D, D, D, 0, smf, p.wave); }
    { LOADP();
      if (bid == 0 && ltid_w(p.wave) == 0) *p.ctr = 0u;
      wb_items(p);
      for (int it = bid; it < NT_ROWS + NT_Z2; it += G) { if (it < NT_ROWS) row_item(p, it); else z2_item(p, it - NT_ROWS); } }
    grid.sync(); MARK(0);
    { LOADP(); EpiSwiglu E; E.O = p.big; E.rowss = p.rowss; run_gemm(lds, p.hb, p.Wgu1, MP, 2 * DFF, D, E); }
    gbar(kp, wave_s, 1); MARK(1);
    { LOADP(); EpiResid<true> E; E.H = p.h; E.HB = p.hb; E.rowss = p.rowss; E.scale = 0.5f; run_gemm(lds, p.big, p.Wd1, 8192, D, DFF, E); }
    { LOADP(); TEpiResid T; T.H = p.h; T.HB = p.hb; T.rowss = p.rowss; T.scale = 0.5f;
      for (int c = bid; c < 32; c += G) PSEC(24, tail_tile(p.big, 8192, p.Wd1, 64 * c, 64 * c + 32, DFF, smf, T, c, p.wave)); }
    gbar(kp, wave_s, 2); MARK(2);
    { LOADP(); EpiScale E; E.O = p.big; E.ldc = INCP; E.rowss = p.rowss; run_gemm(lds, p.hb, p.Win, 8192, 6144, D, E); }
    { LOADP(); TEpiScale T; T.O = p.big; T.ldc = INCP; T.rowss = p.rowss;
      for (int it = bid; it < 97 + 256; it += G) { if (it < 97) tail_tile(p.hb, 8192, p.Win, 64 * it, 64 * it + 32, D, smf, T, it, p.wave); else tail_tile(p.hb, 32 * (it - 97), p.Win, 6144, 6176, D, smf, T, 96, p.wave); } }
    gbar(kp, wave_s, 3); MARK(3);
    { LOADP(); EpiFilt E; E.GF = p.GF; E.G0 = p.G0; PSEC(20, run_gemm(lds, p.WB, p.ZA, 2048, 4352, 256, E)); }
    { LOADP(); for (int it = bid; it < 1040 + 520; it += G) { if (it < 1040) PSEC(21, gla_pre(p, it, smem)); else PSEC(22, hyu_item(p, it - 1040, smem)); } }
    gbar(kp, wave_s, 4); MARK(4);
    { LOADP(); if (bid < 128) PSEC(23, gla_scan(p, ((((bid & 7) | (((bid >> 3) & 1) << 3)) << 3) | (bid >> 4)), smem, t_acc)); }
    { LOADP();
      for (;;) {
        if (ltid_w(p.wave) == 0) *(int*)(smem + HY_ZERO_OFF + 192) = (int)atomicAdd(p.ctr, 1u);
        lds_barrier();
        const int g = *(const int*)(smem + HY_ZERO_OFF + 192);
        lds_barrier();
        if (g >= 256) break;
        hyena_group(p, (g & 7) * 32 + (g >> 3), smem, t_acc);
      } }
    gbar(kp, wave_s, 5); MARK(5);
    { LOADP(); for (int it = bid; it < MP / 8; it += G) fin_item(p, it); }
    gbar(kp, wave_s, 6); MARK(6);
    { LOADP(); EpiResid<true> E; E.H = p.h; E.HB = p.hb; E.rowss = p.rowss; E.scale = 1.0f; run_gemm(lds, p.y, p.Wout, 8192, D, D, E); }
    { LOADP(); TEpiResid T; T.H = p.h; T.HB = p.hb; T.rowss = p.rowss; T.scale = 1.0f;
      for (int c = bid; c < 32; c += G) tail_tile(p.y, 8192, p.Wout, 64 * c, 64 * c + 32, D, smf, T, c, p.wave); }
    gbar(kp, wave_s, 7); MARK(7);
    { LOADP(); EpiSwiglu E; E.O = p.big; E.rowss = p.rowss; run_gemm(lds, p.hb, p.Wgu2, MP, 2 * DFF, D, E); }
    gbar(kp, wave_s, 8); MARK(8);
    { LOADP(); EpiResid<false> E; E.H = p.h; E.HB = nullptr; E.rowss = nullptr; E.scale = 0.5f; run_gemm(lds, p.big, p.Wd2, 8192, D, DFF, E); }
    { LOADP(); TEpiResid T; T.H = p.h; T.HB = nullptr; T.rowss = nullptr; T.scale = 0.5f;
      for (int c = bid; c < 32; c += G) tail_tile(p.big, 8192, p.Wd2, 64 * c, 64 * c + 32, DFF, smf, T, c, p.wave); }
    gbar(kp, wave_s, 9); MARK(9);
    { LOADP(); for (int it = bid; it < 1024; it += G) final_item(p, it); }
    MARK(10);
    if (PROBE_MASK && bid == 0) { const unsigned long long t0_ = wall_clock64(); while (wall_clock64() - t0_ < (unsigned long long)PROBE_K * t_acc) __builtin_amdgcn_s_sleep(8); }
}

extern "C" void kernel_launch(void* const* d_in, const int* in_sizes, int n_in, void* d_out, int out_size, void* d_ws, size_t ws_size, hipStream_t stream) {
    static int grid_blocks = 0;
    if (!grid_blocks) {
        (void)hipFuncSetAttribute((const void*)mega, hipFuncAttributeMaxDynamicSharedMemorySize, LDS_BYTES);
        int dev = 0, cus = 0, per_cu = 0;
        (void)hipGetDevice(&dev);
        (void)hipDeviceGetAttribute(&cus, hipDeviceAttributeMultiprocessorCount, dev);
        (void)hipOccupancyMaxActiveBlocksPerMultiprocessor(&per_cu, mega, 512, LDS_BYTES);
        if (per_cu > 1) per_cu = 1;
        if (per_cu < 1) { fprintf(stderr, "occupancy query returned %d\n", per_cu); per_cu = 1; }
        grid_blocks = cus * per_cu;
    }
    Params p{};
    const float* const* in = (const float* const*)d_in;
    p.x = in[0]; p.meta = in[1]; p.ffn1_norm = in[2]; p.ffn1_wg = in[3]; p.ffn1_wu = in[4]; p.ffn1_wd = in[5]; p.mix_norm = in[6]; p.w_in = in[7];
    p.conv_w = in[8]; p.conv_b = in[9]; p.filt_w1 = in[10]; p.filt_b1 = in[11]; p.filt_w2 = in[12]; p.filt_b2 = in[13]; p.filt_w3 = in[14]; p.filt_freq = in[15];
    p.hyena_d = in[16]; p.hyena_norm = in[17]; p.gk_w2 = in[18]; p.gk_b2 = in[19]; p.gla_norm = in[20]; p.w_out = in[21];
    p.ffn2_norm = in[22]; p.ffn2_wg = in[23]; p.ffn2_wu = in[24]; p.ffn2_wd = in[25]; p.final_norm = in[26];
    p.out = (float*)d_out;
    unsigned char* ws = (unsigned char*)d_ws;
    constexpr size_t SZ_WGU = (size_t)2 * DFF * D * 2, SZ_WD = (size_t)D * DFF * 2, SZ_WIN = (size_t)INCP * D * 2, SZ_WOUT = (size_t)D * D * 2;
    constexpr size_t SZ_H = (size_t)MP * D * 4, SZ_HB = (size_t)MP * D * 2, SZ_BIG = (size_t)MP * INCP * 2, SZ_RS = (size_t)MP * 32 * 4, SZ_Z2 = (size_t)L * 64 * 4;
    size_t o = 0;
    p.Wgu1 = (bf16_t*)(ws + o); o += SZ_WGU; p.Wd1 = (bf16_t*)(ws + o); o += SZ_WD; p.Win = (bf16_t*)(ws + o); o += SZ_WIN; p.Wout = (bf16_t*)(ws + o); o += SZ_WOUT;
    p.Wgu2 = (bf16_t*)(ws + o); o += SZ_WGU; p.Wd2 = (bf16_t*)(ws + o); o += SZ_WD;
    p.h = (float*)(ws + o); o += SZ_H; p.hb = (bf16_t*)(ws + o); o += SZ_HB; p.big = (bf16_t*)(ws + o); o += SZ_BIG; p.rowss = (float*)(ws + o); o += SZ_RS; p.z2 = (float*)(ws + o); o += SZ_Z2; p.ctr = (unsigned*)(ws + o); o += 256; p.ZA = (bf16_t*)(ws + o); o += (size_t)4352 * 256 * 2; p.WB = (bf16_t*)(ws + o); o += (size_t)2048 * 256 * 2; p.G0 = (float*)(ws + o); o += 2048 * 4; p.bar = (unsigned*)(ws + o); o += 256; p.dummy = (float*)(ws + o); o += 4096;
    p.yc = (bf16_t*)ws; p.y = (bf16_t*)(ws + (size_t)M * 1024 * 2); p.of = (float*)p.hb; p.ob = (float*)d_out; p.gp = ws + (size_t)M * 1024 * 2; p.GF = p.Win; p.uT = (bf16_t*)((unsigned char*)d_out + (size_t)M * 1024 * 4);
    if (o > ws_size) fprintf(stderr, "workspace too small: need %zu have %zu\n", o, ws_size);
    (void)hipMemsetAsync(p.bar, 0, 256, stream);
    void* args[] = {&p};
    hipError_t e = hipLaunchCooperativeKernel((void*)mega, dim3(grid_blocks), dim3(512), args, LDS_BYTES, stream);
    if (e != hipSuccess) fprintf(stderr, "cooperative launch failed: %s (grid %d)\n", hipGetErrorString(e), grid_blocks);
}
```

```cpp
#include <hip/hip_runtime.h>
#include <hip/hip_cooperative_groups.h>
#include <cstdio>
namespace cg = cooperative_groups;
namespace pg8 {
#define PG8_LAS __attribute__((address_space(3)))
typedef unsigned short bf16_t;
typedef short bf16x8 __attribute__((ext_vector_type(8)));
typedef float f32x4 __attribute__((ext_vector_type(4)));
typedef unsigned u32x4 __attribute__((ext_vector_type(4)));
constexpr int BM = 256, BK = 64, HALF = 128, HTB = HALF * BK * 2  , STAGE_BYTES = 8 * HTB, NXCD = 8, WGM = 8;

__host__ __device__ __forceinline__ int lds_byte(int r, int c) { const int st = (r >> 4) * 2 + (c >> 5), rr = r & 15, cc = c & 31, ob = rr * 64 + cc * 2; return st * 1024 + (ob ^ (((ob >> 9) & 1) << 5)); }
__host__ __device__ __forceinline__ void stage_rc(int b, int& R, int& C) { const int st = b / 1024, sb = b % 1024, swz = sb ^ (((sb >> 9) & 1) << 5); R = (st >> 1) * 16 + swz / 64; C = (st & 1) * 32 + (swz % 64) / 2; }
__host__ __device__ __forceinline__ int perm32(int rho) { const int n = rho >> 4, i = rho & 15; return 8 * (i >> 2) + 4 * n + (i & 3); }

struct Unit { int pm, pn; };
struct Gemm { const bf16_t* A; const bf16_t* Bt; int M, N, K; };

struct StaticOrder {
    int nM, nN, nwg, G, c;
    __host__ __device__ void init(int M, int N, int G_, int c_) { nM = M / BM; nN = N / BM; nwg = nM * nN; G = G_; c = c_; }
    __host__ __device__ bool next(int i, Unit& u) const {
        const long L = (long)i * G + c; if (L >= nwg) return false;
        int wgid = (int)L; { const int q = nwg / NXCD, r = nwg % NXCD, xcd = wgid % NXCD, off = wgid / NXCD; wgid = (xcd < r ? xcd * (q + 1) : r * (q + 1) + (xcd - r) * q) + off; }
        const int nig = WGM * nN, gid = wgid / nig, fm = gid * WGM, gsz = (nM - fm) < WGM ? (nM - fm) : WGM;
        u.pm = fm + ((wgid % nig) % gsz); u.pn = (wgid % nig) / gsz; return true;
    }
    __device__ __forceinline__ void a_ready(const Unit&) const {}
    __device__ __forceinline__ void done(const Unit&) const {}
};
__device__ __forceinline__ unsigned cvt_pk_bf16(float lo, float hi) { unsigned r; asm volatile("v_cvt_pk_bf16_f32 %0, %1, %2" : "=v"(r) : "v"(lo), "v"(hi)); return r; }
template <class Epi, class Sched>
__device__ __forceinline__ void gemm_phase(PG8_LAS unsigned char* lds, const Gemm g, const Sched& S, const Epi& E, const int tid_in) {
    const int tid = tid_in, wid = __builtin_amdgcn_readfirstlane(tid >> 6), lane = tid & 63, wr = wid >> 2, wc = wid & 3, fr = lane & 15, fq = lane >> 4;
    const int K = g.K, nt = K / BK;
    unsigned voffA[2], voffB[2];
#pragma unroll
    for (int i = 0; i < 2; ++i) { int R, C; stage_rc(tid * 16 + i * 8192, R, C); const int Rb = Epi::PERM ? ((R & ~31) + perm32(R & 31)) : R;
        voffA[i] = (unsigned)(R * K + C) * 2u; voffB[i] = (unsigned)(Rb * K + C) * 2u; }
    const size_t kstep = (size_t)(BK * 2);
    const size_t hstep = (size_t)HALF * K * 2;
    const size_t tstep = 2 * hstep;
    const unsigned ldsw = (unsigned)wid * 1024u;
    const int aoff = lds_byte(wr * 64 + fr, fq * 8), boff = lds_byte(wc * 32 + fr, fq * 8);
#define PG8_SA(b, h) (((b) * 2 + (h)) * HTB)
#define PG8_SB(b, h) ((4 + (b) * 2 + (h)) * HTB)
#define PG8_STAGE(bufoff, gbase, voff) do { _Pragma("unroll") for (int _i = 0; _i < 2; ++_i) \
        __builtin_amdgcn_global_load_lds((const unsigned*)((const char*)(gbase) + (voff)[_i]), (PG8_LAS unsigned*)(lds + (bufoff) + ldsw + _i * 8192), 16, 0, 0); } while (0)
#define PG8_LDA(dst, b, h) do { _Pragma("unroll") for (int m = 0; m < 4; ++m) _Pragma("unroll") for (int k = 0; k < 2; ++k) dst[m][k] = *(const PG8_LAS bf16x8*)(lds + PG8_SA(b, h) + aoff + m * 2048 + k * 1024); } while (0)
#define PG8_LDB(dst, b, h) do { _Pragma("unroll") for (int n = 0; n < 2; ++n) _Pragma("unroll") for (int k = 0; k < 2; ++k) dst[n][k] = *(const PG8_LAS bf16x8*)(lds + PG8_SB(b, h) + boff + n * 2048 + k * 1024); } while (0)
#define PG8_MMA(ai, bj, At, Bt) do { __builtin_amdgcn_s_setprio(1); _Pragma("unroll") for (int m = 0; m < 4; ++m) _Pragma("unroll") for (int n = 0; n < 2; ++n) _Pragma("unroll") for (int k = 0; k < 2; ++k) \
        acc[ai][bj][m][n] = __builtin_amdgcn_mfma_f32_16x16x32_bf16(Bt[n][k], At[m][k], acc[ai][bj][m][n], 0, 0, 0); __builtin_amdgcn_s_setprio(0); } while (0)
#define PG8_WAIT_V(n) asm volatile("s_waitcnt vmcnt(" #n ")" ::: "memory")
#define PG8_WAIT_L(n) asm volatile("s_waitcnt lgkmcnt(" #n ")" ::: "memory")
#define PG8_BAR __builtin_amdgcn_s_barrier()
#define PG8_SCHED __builtin_amdgcn_sched_barrier(0)
    Unit cur, nxt; int ui = 0;
    if (!S.next(0, cur)) return;
    f32x4 acc[2][2][4][2];
#pragma unroll
    for (int a = 0; a < 2; ++a)
#pragma unroll
        for (int b = 0; b < 2; ++b)
#pragma unroll
            for (int m = 0; m < 4; ++m)
#pragma unroll
                for (int n = 0; n < 2; ++n) acc[a][b][m][n] = (f32x4){0.f, 0.f, 0.f, 0.f};
    bf16x8 At[4][2], B0[2][2], B1[2][2];
    const char* cA = (const char*)g.A + (size_t)cur.pm * tstep; const char* cB = (const char*)g.Bt + (size_t)cur.pn * tstep;
    S.a_ready(cur);
    PG8_STAGE(PG8_SB(0, 0), cB, voffB); PG8_STAGE(PG8_SA(0, 0), cA, voffA); PG8_STAGE(PG8_SB(0, 1), cB + hstep, voffB); PG8_STAGE(PG8_SA(0, 1), cA + hstep, voffA);
    if (wr == 1) PG8_BAR;
    PG8_WAIT_V(4); PG8_BAR;
    PG8_STAGE(PG8_SB(1, 0), cB + kstep, voffB); PG8_STAGE(PG8_SA(1, 0), cA + kstep, voffA); PG8_STAGE(PG8_SB(1, 1), cB + hstep + kstep, voffB);
    PG8_WAIT_V(6); PG8_BAR;
    for (;;) {
        const bool has_next = S.next(ui + 1, nxt);
        const char* nA = has_next ? (const char*)g.A + (size_t)nxt.pm * tstep : cA; const char* nB = has_next ? (const char*)g.Bt + (size_t)nxt.pn * tstep : cB;
        for (int t = 0; t < nt; t += 2) {
            const bool last = (t == nt - 2);
            const char* a1 = cA + (size_t)(t + 1) * kstep;
            const char* a2 = last ? nA : cA + (size_t)(t + 2) * kstep; const char* b2 = last ? nB : cB + (size_t)(t + 2) * kstep;
            const char* a3 = a2 + kstep; const char* b3 = b2 + kstep;
            if (last && has_next) S.a_ready(nxt);
            PG8_LDB(B0, 0, 0); PG8_SCHED; PG8_LDA(At, 0, 0); PG8_STAGE(PG8_SA(1, 1), a1 + hstep, voffA);
            PG8_WAIT_L(8); PG8_BAR; PG8_WAIT_L(0); PG8_MMA(0, 0, At, B0); PG8_BAR; PG8_SCHED;
            PG8_LDB(B1, 0, 1); PG8_STAGE(PG8_SB(0, 0), b2, voffB);
            PG8_BAR; PG8_WAIT_L(0); PG8_MMA(0, 1, At, B1); PG8_BAR;
            PG8_LDA(At, 0, 1); PG8_STAGE(PG8_SA(0, 0), a2, voffA);
            PG8_BAR; PG8_WAIT_L(0); PG8_MMA(1, 0, At, B0); PG8_BAR; PG8_SCHED;
            PG8_STAGE(PG8_SB(0, 1), b2 + hstep, voffB);
            PG8_WAIT_V(6); PG8_BAR; PG8_MMA(1, 1, At, B1); PG8_BAR;
            PG8_LDB(B0, 1, 0); PG8_SCHED; PG8_LDA(At, 1, 0); PG8_STAGE(PG8_SA(0, 1), a2 + hstep, voffA);
            PG8_WAIT_L(8); PG8_BAR; PG8_WAIT_L(0); PG8_MMA(0, 0, At, B0); PG8_BAR; PG8_SCHED;
            PG8_LDB(B1, 1, 1); PG8_STAGE(PG8_SB(1, 0), b3, voffB);
            PG8_BAR; PG8_WAIT_L(0); PG8_MMA(0, 1, At, B1); PG8_BAR;
            PG8_LDA(At, 1, 1); PG8_STAGE(PG8_SA(1, 0), a3, voffA);
            PG8_BAR; PG8_WAIT_L(0); PG8_MMA(1, 0, At, B0); PG8_BAR; PG8_SCHED;
            PG8_STAGE(PG8_SB(1, 1), b3 + hstep, voffB);
            PG8_WAIT_V(6); PG8_BAR; PG8_MMA(1, 1, At, B1); PG8_BAR;
        }
        if constexpr (!Epi::AFTER_DRAIN) { E(acc, cur, wr, wc, fr, fq); S.done(cur); }
        if (!has_next) break;
#pragma unroll
        for (int a = 0; a < 2; ++a)
#pragma unroll
            for (int b = 0; b < 2; ++b)
#pragma unroll
                for (int m = 0; m < 4; ++m)
#pragma unroll
                    for (int n = 0; n < 2; ++n) acc[a][b][m][n] = (f32x4){0.f, 0.f, 0.f, 0.f};
        cur = nxt; cA = nA; cB = nB; ++ui;
    }
    PG8_WAIT_V(0);
    if (wr == 0) PG8_BAR;
    PG8_BAR;
    if constexpr (Epi::AFTER_DRAIN) { E.fused(acc, cur, wr, wc, fr, fq, lds, wid, lane); S.done(cur); }
#undef PG8_SA
#undef PG8_SB
#undef PG8_STAGE
#undef PG8_LDA
#undef PG8_LDB
#undef PG8_MMA
#undef PG8_WAIT_V
#undef PG8_WAIT_L
#undef PG8_BAR
#undef PG8_SCHED
}
}

#include <cstdio>
#include <ctime>
#include <cstdlib>
#include <cstring>
#include <cmath>
#include <vector>
#include <algorithm>

using pg8::bf16_t; using pg8::f32x4; using pg8::Unit;
typedef unsigned u32x2v __attribute__((ext_vector_type(2)));
typedef unsigned u32x4v __attribute__((ext_vector_type(4)));

constexpr int D = 2048, SEQ = 4096, NMETA = 16, L = 4112, M = 8224, MP = 8448, DFF = 5632, INC = 6176, INCP = 6400;
constexpr float EPS = 1e-6f;
constexpr int LDS_BYTES = 4 * (8336 * 2 + 2 * 65 * 144) + 256;
constexpr unsigned PROBE_MASK = 0u; constexpr int PROBE_K = 8;
#define HSEC(i) do { if (PROBE_MASK) { const unsigned long long t_ = wall_clock64(); if ((PROBE_MASK >> (i)) & 1u) tsec += t_ - ts0_; ts0_ = t_; } } while (0)
constexpr int C_Q = 3072, C_K = 3584, C_V = 4096, C_OG = 5120, C_LR = 6144;

struct Params {
    const float *x, *meta, *ffn1_norm, *ffn1_wg, *ffn1_wu, *ffn1_wd, *mix_norm, *w_in, *conv_w, *conv_b,
        *filt_w1, *filt_b1, *filt_w2, *filt_b2, *filt_w3, *filt_freq, *hyena_d, *hyena_norm, *gk_w2, *gk_b2, *gla_norm, *w_out,
        *ffn2_norm, *ffn2_wg, *ffn2_wu, *ffn2_wd, *final_norm;
    float* out;
    bf16_t *Wgu1, *Wd1, *Win, *Wout, *Wgu2, *Wd2;
    float* h; bf16_t* hb; bf16_t* big; float* rowss; float* z2;
    bf16_t* y; bf16_t* yc; float* of; float* ob; unsigned char* gp; unsigned* ctr; bf16_t* uT; bf16_t* ZA; bf16_t* WB; bf16_t* GF; float* G0; unsigned* bar; float* dummy; int wave; int pad_;
};

__device__ __forceinline__ int lane_id() { return (int)__builtin_amdgcn_mbcnt_hi(~0u, __builtin_amdgcn_mbcnt_lo(~0u, 0u)); }
__device__ __forceinline__ int ltid_w(int wave) { int t = (wave << 6) | lane_id(); asm volatile("" : "+v"(t)); return t; }
__device__ __forceinline__ void lds_barrier() { asm volatile("s_waitcnt lgkmcnt(0)" ::: "memory"); __builtin_amdgcn_s_barrier(); asm volatile("" ::: "memory"); }
__device__ __forceinline__ float bf2f(bf16_t b) { return __uint_as_float(((unsigned)b) << 16); }
__device__ __forceinline__ unsigned pk2(float lo, float hi) { return pg8::cvt_pk_bf16(lo, hi); }
__device__ __forceinline__ bf16_t f2bf(float v) { return (bf16_t)(pk2(v, 0.f) & 0xffffu); }
template <int MSK> __device__ __forceinline__ float shx(float v) {
    if constexpr (MSK < 32) return __int_as_float(__builtin_amdgcn_ds_swizzle(__float_as_int(v), 0x1f | (MSK << 10)));
    else { int l = lane_id(); asm volatile("" : "+v"(l)); return __int_as_float(__builtin_amdgcn_ds_bpermute((l ^ 32) << 2, __float_as_int(v))); }
}
__device__ __forceinline__ float wave_sum(float v) { v += shx<32>(v); v += shx<16>(v); v += shx<8>(v); v += shx<4>(v); v += shx<2>(v); v += shx<1>(v); return v; }
__device__ __forceinline__ float silu_f(float x) { return x * __builtin_amdgcn_rcpf(1.0f + __expf(-x)); }

__device__ __forceinline__ float row_rscale(const float* rowss, int r, int fq) {
    const f32x4* q = (const f32x4*)(rowss + (size_t)r * 32 + fq * 8);
    const f32x4 a = q[0], b = q[1];
    float s = ((a[0] + a[1]) + (a[2] + a[3])) + ((b[0] + b[1]) + (b[2] + b[3]));
    s += shx<16>(s); s += shx<32>(s);
    return rsqrtf(s * (1.0f / D) + EPS);
}

struct EpiSwiglu {
    static constexpr bool PERM = true, AFTER_DRAIN = false;
    bf16_t* O; const float* rowss;
    __device__ __forceinline__ void operator()(const f32x4 (&acc)[2][2][4][2], const Unit& u, int wr, int wc, int fr, int fq) const {
        const int row0 = u.pm * 256 + wr * 64 + fr, col0 = u.pn * 128 + wc * 32 + 8 * fq;
#pragma unroll
        for (int ai = 0; ai < 2; ++ai)
#pragma unroll
            for (int m = 0; m < 4; ++m) {
                const int r = row0 + ai * 128 + m * 16; const float rs = row_rscale(rowss, r, fq);
                u32x4v w;
#pragma unroll
                for (int n = 0; n < 2; ++n) { const f32x4 g = acc[ai][0][m][n] * rs, uu = acc[ai][1][m][n] * rs;
                    w[2 * n] = pk2(silu_f(g[0]) * uu[0], silu_f(g[1]) * uu[1]); w[2 * n + 1] = pk2(silu_f(g[2]) * uu[2], silu_f(g[3]) * uu[3]); }
                *(u32x4v*)(O + (size_t)r * DFF + col0) = w;
            }
    }
};
struct EpiScale {
    static constexpr bool PERM = true, AFTER_DRAIN = false;
    bf16_t* O; int ldc; const float* rowss;
    __device__ __forceinline__ void operator()(const f32x4 (&acc)[2][2][4][2], const Unit& u, int wr, int wc, int fr, int fq) const {
        const int row0 = u.pm * 256 + wr * 64 + fr, col0 = u.pn * 256 + wc * 32 + 8 * fq;
#pragma unroll
        for (int ai = 0; ai < 2; ++ai)
#pragma unroll
            for (int m = 0; m < 4; ++m) {
                const int r = row0 + ai * 128 + m * 16; const float rs = row_rscale(rowss, r, fq);
#pragma unroll
                for (int bj = 0; bj < 2; ++bj) { const f32x4 a = acc[ai][bj][m][0] * rs, b = acc[ai][bj][m][1] * rs;
                    u32x4v w; w[0] = pk2(a[0], a[1]); w[1] = pk2(a[2], a[3]); w[2] = pk2(b[0], b[1]); w[3] = pk2(b[2], b[3]);
                    *(u32x4v*)(O + (size_t)r * ldc + col0 + bj * 128) = w; }
            }
    }
};
template <bool WHB> struct EpiResid {
    static constexpr bool PERM = true, AFTER_DRAIN = false;
    float* H; bf16_t* HB; float* rowss; float scale;
    __device__ __forceinline__ void operator()(const f32x4 (&acc)[2][2][4][2], const Unit& u, int wr, int wc, int fr, int fq) const {
        const int row0 = u.pm * 256 + wr * 64 + fr, col0 = u.pn * 256 + wc * 32 + 8 * fq;
#pragma unroll
        for (int ai = 0; ai < 2; ++ai)
#pragma unroll
            for (int m = 0; m < 4; ++m) {
                const int r = row0 + ai * 128 + m * 16; float ss = 0.f;
#pragma unroll
                for (int bj = 0; bj < 2; ++bj) { float* hp = H + (size_t)r * D + col0 + bj * 128;
                    f32x4 a = *(const f32x4*)hp, b = *(const f32x4*)(hp + 4);
                    a += acc[ai][bj][m][0] * scale; b += acc[ai][bj][m][1] * scale;
                    *(f32x4*)hp = a; *(f32x4*)(hp + 4) = b;
                    ss += (a[0] * a[0] + a[1] * a[1]) + (a[2] * a[2] + a[3] * a[3]) + (b[0] * b[0] + b[1] * b[1]) + (b[2] * b[2] + b[3] * b[3]);
                    if (WHB) { u32x4v w; w[0] = pk2(a[0], a[1]); w[1] = pk2(a[2], a[3]); w[2] = pk2(b[0], b[1]); w[3] = pk2(b[2], b[3]);
                        *(u32x4v*)(HB + (size_t)r * D + col0 + bj * 128) = w; } }
                ss += shx<16>(ss); ss += shx<32>(ss);
                if (WHB && fq == 0) rowss[(size_t)r * 32 + u.pn * 4 + wc] = ss;
            }
    }
};

constexpr int NT_FFN = 2816, NT_WIN = 3200, NT_WOUT = 1024, NT_TR = 6 * NT_FFN + NT_WIN + NT_WOUT, NT_ROWS = MP / 8, NT_Z2 = 4352 / 8, P0_ITEMS = NT_TR + NT_ROWS + NT_Z2;

__device__ __forceinline__ void transpose_mat(const float* src, bf16_t* dst, const float* gain, const int K, const int N, const int ld, const int nvalid, const int mode, float* tl, const int wave) {
    const int nst = (N + 511) / 512, nkt = K / 64, nitems = nkt * nst, tid = ltid_w(wave);
    for (int it = blockIdx.x; it < nitems; it += gridDim.x) {
        const int st = it / nkt, kt = it - st * nkt, k0 = kt * 64, nbase = st * 512;
        { const int r = tid >> 4, c4 = (tid & 15) * 4;
          const float g0 = gain ? gain[k0 + r] : 1.0f, g1 = gain ? gain[k0 + r + 32] : 1.0f;
          f32x4 v[8][2];
#pragma unroll
          for (int s8 = 0; s8 < 8; ++s8)
#pragma unroll
              for (int i = 0; i < 2; ++i) { const int n = nbase + s8 * 64 + c4; v[s8][i] = (f32x4){0.f, 0.f, 0.f, 0.f};
                  if (n < nvalid) v[s8][i] = *(const f32x4*)(src + (size_t)(k0 + r + 32 * i) * ld + n); }
#pragma unroll
          for (int s8 = 0; s8 < 8; ++s8)
#pragma unroll
              for (int i = 0; i < 2; ++i) { const float g = i ? g1 : g0; float* t = tl + s8 * 4160 + (r + 32 * i) * 65 + c4;
                  t[0] = v[s8][i][0] * g; t[1] = v[s8][i][1] * g; t[2] = v[s8][i][2] * g; t[3] = v[s8][i][3] * g; } }
        lds_barrier();
        { const int nl = tid >> 3, k8 = (tid & 7) * 8;
#pragma unroll
          for (int s8 = 0; s8 < 8; ++s8) { const int n0 = nbase + s8 * 64;
              if (n0 < N) { float w8[8];
#pragma unroll
                  for (int j = 0; j < 8; ++j) w8[j] = tl[s8 * 4160 + (k8 + j) * 65 + nl];
                  u32x4v w; w[0] = pk2(w8[0], w8[1]); w[1] = pk2(w8[2], w8[3]); w[2] = pk2(w8[4], w8[5]); w[3] = pk2(w8[6], w8[7]);
                  const long drow0 = mode == 0 ? n0 : (n0 / 128) * 256 + (n0 % 128) + (mode == 2 ? 128 : 0);
                  *(u32x4v*)(dst + (size_t)(drow0 + nl) * K + k0 + k8) = w; } } }
        lds_barrier();
    }
}

__device__ void row_item(const Params& p, int item) {
    const int tid__ = ltid_w(p.wave), wid = tid__ >> 6, lane = tid__ & 63, m = item * 8 + wid;
    float* hrow = p.h + (size_t)m * D; bf16_t* hbrow = p.hb + (size_t)m * D;
    if (m < M) { const int b = m / L, t = m - b * L;
        const float* src = t < NMETA ? p.meta + (size_t)t * D : p.x + ((size_t)b * SEQ + t - NMETA) * D;
        float ss = 0.f;
#pragma unroll
        for (int i = 0; i < 8; ++i) { const int c = (lane + 64 * i) * 4; const f32x4 v = *(const f32x4*)(src + c);
            ss += (v[0] * v[0] + v[1] * v[1]) + (v[2] * v[2] + v[3] * v[3]);
            *(f32x4*)(hrow + c) = v; u32x2v w; w[0] = pk2(v[0], v[1]); w[1] = pk2(v[2], v[3]); *(u32x2v*)(hbrow + c) = w; }
        ss = wave_sum(ss);
        if (lane < 32) p.rowss[(size_t)m * 32 + lane] = lane == 0 ? ss : 0.f;
    } else {
#pragma unroll
        for (int i = 0; i < 8; ++i) { const int c = (lane + 64 * i) * 4; *(f32x4*)(hrow + c) = (f32x4){0.f, 0.f, 0.f, 0.f}; u32x2v w; w[0] = 0u; w[1] = 0u; *(u32x2v*)(hbrow + c) = w; }
        if (lane < 32) p.rowss[(size_t)m * 32 + lane] = 0.f;
    }
}

__device__ void z2_item(const Params& p, int item) {
    const int tid__ = ltid_w(p.wave), wid = tid__ >> 6, lane = tid__ & 63, j = item * 8 + wid;
    bf16_t* za = p.ZA + (size_t)j * 256;
    if (j >= L) { za[lane] = 0; za[64 + lane] = 0; za[128 + lane] = 0; za[192 + lane] = 0; return; }
    float feat = 0.f;
    const float w = (float)(2.0 * 3.14159265358979323846 / L) * (float)j;
    if (lane == 0) feat = (float)j * (1.0f / (float)(L - 1));
    else if (lane <= 32) { const int bi = (lane - 1) & 15; const float band = 1e-4f + (float)bi * ((15.0f - 1e-4f) / 15.0f); const float ang = w * band;
        feat = lane <= 16 ? cosf(ang) : -sinf(ang); }
    float a = p.filt_b1[lane];
    for (int i = 0; i < 33; ++i) a += __int_as_float(__builtin_amdgcn_readlane(__float_as_int(feat), i)) * p.filt_w1[i * 64 + lane];
    const float fr = p.filt_freq[lane];
    const float z1 = sinf(fr * a);
    float c = p.filt_b2[lane];
    for (int k = 0; k < 64; ++k) c += __int_as_float(__builtin_amdgcn_readlane(__float_as_int(z1), k)) * p.filt_w2[k * 64 + lane];
    const float z = sinf(fr * c);
    const bf16_t hi = f2bf(z), lo = f2bf(z - bf2f(hi));
    za[lane] = hi; za[64 + lane] = lo; za[128 + lane] = hi; za[192 + lane] = 0;
}
__device__ void wb_items(const Params& p) {
    for (int idx = blockIdx.x * 512 + ltid_w(p.wave); idx < 2048 * 64; idx += gridDim.x * 512) { const int n = idx >> 6, k = idx & 63;
        const float w = p.filt_w3[(size_t)k * 2048 + n]; const bf16_t hi = f2bf(w), lo = f2bf(w - bf2f(hi));
        bf16_t* wb = p.WB + (size_t)n * 256; wb[k] = hi; wb[64 + k] = hi; wb[128 + k] = lo; wb[192 + k] = 0; }
}
struct EpiFilt {
    static constexpr bool PERM = true, AFTER_DRAIN = false;
    bf16_t* GF; float* G0;
    __device__ __forceinline__ void operator()(const f32x4 (&acc)[2][2][4][2], const Unit& u, int wr, int wc, int fr, int fq) const {
        const int row0 = u.pm * 256 + wr * 64 + fr, col0 = u.pn * 256 + wc * 32 + 8 * fq;
        const float la = -3.0701134573253945f, lb = -15.350567286626973f;
#pragma unroll
        for (int ai = 0; ai < 2; ++ai)
#pragma unroll
            for (int m = 0; m < 4; ++m) { const int n = row0 + ai * 128 + m * 16; const float delta = fabsf(la + (float)(n & 1023) * ((lb - la) / 1023.0f)) * (1.0f / (float)(L - 1));
                const float r1 = __expf(-delta), r2 = r1 * r1, r3 = r2 * r1;
                bf16_t* grow = GF + (size_t)n * 4352 + col0;
#pragma unroll
                for (int bj = 0; bj < 2; ++bj)
#pragma unroll
                    for (int nn = 0; nn < 2; ++nn) { const int j0 = col0 + bj * 128 + 4 * nn; const f32x4 a4 = acc[ai][bj][m][nn];
                        const float w0 = __expf(-(float)j0 * delta);
                        const float v0 = a4[0] * w0, v1 = a4[1] * (w0 * r1), v2 = a4[2] * (w0 * r2), v3 = a4[3] * (w0 * r3);
                        u32x2v w; w[0] = pk2(v0, v1); w[1] = pk2(v2, v3);
                        *(u32x2v*)(grow + bj * 128 + 4 * nn) = w;
                        if (j0 == 0) G0[n] = v0; } }

    }
};

constexpr int HY_G_ELEMS = 8336, HY_G_BYTES = HY_G_ELEMS * 2, HY_USTR = 144, HY_U_BYTES = 65 * HY_USTR, HY_CH_BYTES = HY_G_BYTES + 2 * HY_U_BYTES, HY_ZERO_OFF = 4 * HY_CH_BYTES;
static_assert(HY_ZERO_OFF + 256 <= LDS_BYTES, "lds");
static_assert(HY_CH_BYTES % 16 == 0 && HY_G_BYTES % 16 == 0, "align");
__device__ void hyu_item(const Params& p, int item, unsigned char* sm) {
    const int cb = item & 3, bt = item >> 2, b = bt / 65, tile = bt - b * 65, t0 = tile * 64;
    const int tid = ltid_w(p.wave), q = tid & 31, rg = tid >> 5, c8 = cb * 256 + q * 8, tb = t0 + 4 * rg;
    bf16_t* LT = (bf16_t*)sm;
    u32x4v x1[6], vh[6]; float okf[6];
#pragma unroll
    for (int i = 0; i < 6; ++i) { const int t2 = tb - 1 + i; okf[i] = (t2 >= 0 && t2 < L) ? 1.f : 0.f; const int t2c = t2 < 0 ? 0 : (t2 >= L ? L - 1 : t2);
        const bf16_t* row = p.big + (size_t)(b * L + t2c) * INCP + c8; x1[i] = *(const u32x4v*)(row + 1024); vh[i] = *(const u32x4v*)(row + 2048); }
    f32x4 w1[3][2], w2[3][2], b1[2], b2v[2];
#pragma unroll
    for (int h2 = 0; h2 < 2; ++h2) { b1[h2] = *(const f32x4*)(p.conv_b + 1024 + c8 + 4 * h2); b2v[h2] = *(const f32x4*)(p.conv_b + 2048 + c8 + 4 * h2);
#pragma unroll
        for (int jj = 0; jj < 3; ++jj) { w1[jj][h2] = *(const f32x4*)(p.conv_w + jj * 3072 + 1024 + c8 + 4 * h2); w2[jj][h2] = *(const f32x4*)(p.conv_w + jj * 3072 + 2048 + c8 + 4 * h2); } }
    float u[4][8];
#pragma unroll
    for (int r = 0; r < 4; ++r) { float a1[8], a2[8];
#pragma unroll
        for (int e = 0; e < 8; ++e) { a1[e] = b1[e >> 2][e & 3]; a2[e] = b2v[e >> 2][e & 3]; }
#pragma unroll
        for (int jj = 0; jj < 3; ++jj) { const int i = r + jj; const float m = okf[i];
#pragma unroll
            for (int e = 0; e < 8; ++e) { const unsigned xa = x1[i][e >> 1], xb = vh[i][e >> 1];
                const float fa = (e & 1) ? __uint_as_float(xa & 0xffff0000u) : __uint_as_float(xa << 16), fb = (e & 1) ? __uint_as_float(xb & 0xffff0000u) : __uint_as_float(xb << 16);
                a1[e] += fa * (w1[jj][e >> 2][e & 3] * m); a2[e] += fb * (w2[jj][e >> 2][e & 3] * m); } }
        const float vm = (tb + r) < L ? 1.f : 0.f;
#pragma unroll
        for (int e = 0; e < 8; ++e) u[r][e] = a1[e] * a2[e] * vm; }
#pragma unroll
    for (int e = 0; e < 8; ++e) { u32x2v w; w[0] = pk2(u[0][e], u[1][e]); w[1] = pk2(u[2][e], u[3][e]); *(u32x2v*)(LT + (q * 8 + e) * 72 + 4 * rg) = w; }
    lds_barrier();
    { const int row = tid >> 1, half = tid & 1; bf16_t* dst = p.uT + ((size_t)(cb * 256 + row) * 2 + b) * 4160 + t0 + half * 32;
#pragma unroll
      for (int i = 0; i < 4; ++i) *(u32x4v*)(dst + 8 * i) = *(const u32x4v*)(LT + row * 72 + half * 32 + 8 * i); }
    lds_barrier();
}
__device__ void hyena_group(const Params& p, int grp_, unsigned char* sm, unsigned long long& tsec) {
    unsigned long long ts0_ = PROBE_MASK ? wall_clock64() : 0ull;
    const int grp = __builtin_amdgcn_readfirstlane(grp_);
    const int tid = ltid_w(p.wave), wid = tid >> 6, lane = tid & 63, c0 = grp * 4;
    { const unsigned char* src = (const unsigned char*)(p.uT + (size_t)c0 * 2 * 4160);
      for (int idx = tid; idx < 8 * 520; idx += 512) { const int r = idx / 520, i = idx - r * 520;
          *(u32x4v*)(sm + (r >> 1) * HY_CH_BYTES + HY_G_BYTES + (r & 1) * HY_U_BYTES + (i >> 3) * HY_USTR + (i & 7) * 16) = *(const u32x4v*)(src + (size_t)idx * 16); } }
    if (tid < 36) ((unsigned*)(sm + HY_ZERO_OFF))[tid] = 0u;
    for (int i = tid; i < 4 * 113; i += 512) { const int ch = i / 113, q = i - ch * 113; const int idx = q < 49 ? q : 8272 + (q - 49);
        *(unsigned short*)(sm + ch * HY_CH_BYTES + 2 * idx) = 0; }
    for (int idx = tid; idx < 4 * 514; idx += 512) { const int ch = idx / 514, pc = idx - ch * 514, j0 = pc * 8;
        unsigned short* gb = (unsigned short*)(sm + ch * HY_CH_BYTES);
        const u32x4v f = *(const u32x4v*)(p.GF + (size_t)(c0 + ch) * 4352 + j0); u32x4v bk = *(const u32x4v*)(p.GF + (size_t)(1024 + c0 + ch) * 4352 + j0);
        if (pc == 0) bk[0] = (bk[0] & 0xffff0000u) | (pk2(p.G0[c0 + ch] + p.G0[1024 + c0 + ch], 0.f) & 0xffffu);
        *(u32x4v*)(gb + 4160 + j0) = bk;
#pragma unroll
        for (int e = 0; e < 8; ++e) if (pc != 0 || e != 0) gb[4160 - j0 - e] = (unsigned short)((e & 1) ? (f[e >> 1] >> 16) : (f[e >> 1] & 0xffffu)); }
    lds_barrier();
    HSEC(12);
    const int ch = wid >> 1, b = wid & 1, li = lane & 15, kq = lane >> 4;
    unsigned char* Ub = sm + ch * HY_CH_BYTES + HY_G_BYTES + b * HY_U_BYTES;
    const unsigned char* Zb = sm + HY_ZERO_OFF + kq * 16;
    f32x4 acc[4][5];
#pragma unroll
    for (int rb = 0; rb < 4; ++rb)
#pragma unroll
        for (int nb = 0; nb < 5; ++nb) acc[rb][nb] = (f32x4){0.f, 0.f, 0.f, 0.f};
    const unsigned shl = (li & 1) ? 16u : 0u;
    unsigned gq[5];
#pragma unroll
    for (int w = 0; w < 5; ++w) { unsigned t_ = (unsigned)(ch * HY_CH_BYTES + 4 * (((4160 + 8 * kq - li) >> 1) + w)); asm volatile("" : "+v"(t_)); gq[w] = t_; }
    PG8_LAS const unsigned char* sml = (PG8_LAS const unsigned char*)sm;
    auto gload = [&](int mp, unsigned (&e)[5]) {
#pragma unroll
        for (int w = 0; w < 5; ++w) e[w] = *(PG8_LAS const unsigned*)(sml + (gq[w] - 32 * mp));
    };
    auto gmake = [&](const unsigned (&e)[5]) -> pg8::bf16x8 {
        u32x4v r;
#pragma unroll
        for (int w = 0; w < 4; ++w) r[w] = __builtin_amdgcn_alignbit(e[w + 1], e[w], shl);
        return __builtin_bit_cast(pg8::bf16x8, r);
    };
    pg8::bf16x8 F[6];
    unsigned E[4][5];
    { unsigned e0[5], e1[5]; gload(4 * (-64) - 2, e0); gload(4 * (-64) - 1, e1); F[4] = gmake(e0); F[5] = gmake(e1); }
#pragma unroll
    for (int q = 0; q < 4; ++q) gload(4 * (-64) + q, E[q]);
    for (int d = -64; d <= 64; ++d) {
        F[0] = F[4]; F[1] = F[5];
#pragma unroll
        for (int q = 2; q < 6; ++q) F[q] = gmake(E[q - 2]);
        if (d < 64) {
#pragma unroll
            for (int q = 0; q < 4; ++q) gload(4 * (d + 1) + q, E[q]);
        }
        const int nb_lo = d > 0 ? (d >> 4) : 0, nb_hi = (d + 64) >> 4;
#pragma unroll
        for (int nb = 0; nb < 5; ++nb) {
            if (nb >= nb_lo && nb <= nb_hi) {
                const int sblk = 16 * nb + li - d;
                const unsigned char* up = ((unsigned)sblk < 65u) ? (Ub + sblk * HY_USTR + kq * 16) : Zb;
                const pg8::bf16x8 B0 = *(const pg8::bf16x8*)up, B1 = *(const pg8::bf16x8*)(up + 64);
#pragma unroll
                for (int rb = 0; rb < 4; ++rb) {
                    acc[rb][nb] = __builtin_amdgcn_mfma_f32_16x16x32_bf16(F[rb + 2], B0, acc[rb][nb], 0, 0, 0);
                    acc[rb][nb] = __builtin_amdgcn_mfma_f32_16x16x32_bf16(F[rb], B1, acc[rb][nb], 0, 0, 0);
                }
            }
        }
    }
    HSEC(13);
    {
        const float dc = p.hyena_d[c0 + ch];
#pragma unroll
        for (int nb = 0; nb < 5; ++nb) { const int t1 = 16 * nb + li;
            if (t1 < 65) {
#pragma unroll
                for (int rb = 0; rb < 4; ++rb) { unsigned char* up = Ub + t1 * HY_USTR + (16 * rb + 4 * kq) * 2;
                    const u32x2v uu = *(const u32x2v*)up; const f32x4 a = acc[rb][nb];
                    u32x2v w; w[0] = pk2(a[0] + dc * __uint_as_float(uu[0] << 16), a[1] + dc * __uint_as_float(uu[0] & 0xffff0000u));
                    w[1] = pk2(a[2] + dc * __uint_as_float(uu[1] << 16), a[3] + dc * __uint_as_float(uu[1] & 0xffff0000u));
                    *(u32x2v*)up = w; } } }
    }
    lds_barrier();
    for (int tt = tid; tt < 2 * L; tt += 512) { const int bb = tt >= L ? 1 : 0, t = tt - bb * L;
        const unsigned char* up = sm + HY_G_BYTES + bb * HY_U_BYTES + (t >> 6) * HY_USTR + (t & 63) * 2;
        const unsigned v0 = *(const unsigned short*)up, v1 = *(const unsigned short*)(up + HY_CH_BYTES), v2 = *(const unsigned short*)(up + 2 * HY_CH_BYTES), v3 = *(const unsigned short*)(up + 3 * HY_CH_BYTES);
        u32x2v w; w[0] = v0 | (v1 << 16); w[1] = v2 | (v3 << 16);
        *(u32x2v*)(p.yc + (size_t)(bb * L + t) * 1024 + c0) = w; }
    lds_barrier();
    HSEC(14);
}

constexpr int GP_QT = 0, GP_KT = 16384, GP_AM = 32768, GP_DEC = 40960, GP_STRIDE = 41472;
__device__ void gla_pre(const Params& p, int item, unsigned char* sm) {
    const int n = item % 65, bdh = item / 65, hh = bdh & 3, dir = (bdh >> 2) & 1, b = bdh >> 3;
    const int tid = ltid_w(p.wave), d = tid & 127, seg = tid >> 7, lane = tid & 63, wid = tid >> 6, li = lane & 15, kq = lane >> 4;
    float* LR = (float*)sm; float* SEGT = LR + 1024; bf16_t* QS = (bf16_t*)(sm + 8192); bf16_t* KS = QS + 64 * 136;
    unsigned char* gp = p.gp + (size_t)item * GP_STRIDE;
    { const int i = tid >> 3, r2 = (tid & 7) * 2; const int tau = dir ? 4159 - (64 * n + i) : 64 * n + i; float v0 = 0.f, v1 = 0.f;
      { const unsigned w = *(const unsigned*)(p.big + (size_t)(b * L + (tau < 48 ? 0 : tau - 48)) * INCP + C_LR + dir * 16 + r2); if (tau >= 48) { v0 = __uint_as_float(w << 16); v1 = __uint_as_float(w & 0xffff0000u); } }
      LR[i * 16 + r2] = v0; LR[i * 16 + r2 + 1] = v1; }
    float w2[16];
#pragma unroll
    for (int r = 0; r < 16; ++r) w2[r] = p.gk_w2[(size_t)(dir * 16 + r) * 512 + hh * 128 + d];
    const float b2 = p.gk_b2[dir * 512 + hh * 128 + d];
    unsigned short qraw[16], kraw[16];
#pragma unroll
    for (int ii = 0; ii < 16; ++ii) { const int i = seg * 16 + ii; const int tau = dir ? 4159 - (64 * n + i) : 64 * n + i; const int tc = tau < 48 ? 0 : tau - 48;
        const bf16_t* row = p.big + (size_t)(b * L + tc) * INCP + hh * 128 + d; qraw[ii] = row[C_Q]; kraw[ii] = row[C_K];
        if (tau < 48) { qraw[ii] = 0; kraw[ii] = 0; } }
    lds_barrier();
    float cs[16]; float run = 0.f;
#pragma unroll
    for (int ii = 0; ii < 16; ++ii) { const int i = seg * 16 + ii; const int tau = dir ? 4159 - (64 * n + i) : 64 * n + i;
        float xg = b2;
#pragma unroll
        for (int r4 = 0; r4 < 4; ++r4) { const f32x4 l4 = *(const f32x4*)(LR + i * 16 + 4 * r4); xg += l4[0] * w2[4 * r4] + l4[1] * w2[4 * r4 + 1] + l4[2] * w2[4 * r4 + 2] + l4[3] * w2[4 * r4 + 3]; }
        const float lg = tau >= 48 ? (fminf(xg, 0.f) - __logf(1.0f + __expf(-fabsf(xg)))) * (1.0f / 16.0f) : 0.f;
        run += lg; cs[ii] = run; }
    SEGT[seg * 128 + d] = run;
    lds_barrier();
    float off = 0.f, tot = 0.f;
#pragma unroll
    for (int s = 0; s < 4; ++s) { const float v = SEGT[s * 128 + d]; if (s < seg) off += v; tot += v; }
    unsigned kt[8];
#pragma unroll
    for (int ii = 0; ii < 16; ii += 2) { float kh[2];
#pragma unroll
        for (int x = 0; x < 2; ++x) { const int i = seg * 16 + ii + x; const float q = bf2f(qraw[ii + x]), k = bf2f(kraw[ii + x]);
            const float bi = off + cs[ii + x]; const bf16_t qv = f2bf(q * 0.08838834764831845f * __expf(bi));
            QS[i * 136 + d] = qv; KS[i * 136 + d] = f2bf(k * __expf(-bi)); *(bf16_t*)(gp + GP_QT + (i * 128 + d) * 2) = qv; kh[x] = k * __expf(tot - bi); }
        kt[ii >> 1] = pk2(kh[0], kh[1]); }
    { u32x4v w0, w1; w0[0] = kt[0]; w0[1] = kt[1]; w0[2] = kt[2]; w0[3] = kt[3]; w1[0] = kt[4]; w1[1] = kt[5]; w1[2] = kt[6]; w1[3] = kt[7];
      *(u32x4v*)(gp + GP_KT + (d * 64 + seg * 16) * 2) = w0; *(u32x4v*)(gp + GP_KT + (d * 64 + seg * 16 + 8) * 2) = w1; }
    if (seg == 0) *(float*)(gp + GP_DEC + d * 4) = __expf(tot);
    lds_barrier();
    { const int it = wid >> 1;
#pragma unroll
      for (int x = 0; x < 2; ++x) { const int jt = (wid & 1) * 2 + x; f32x4 acc = {0.f, 0.f, 0.f, 0.f};
#pragma unroll
          for (int ks = 0; ks < 4; ++ks) { const pg8::bf16x8 a = *(const pg8::bf16x8*)(QS + (16 * it + li) * 136 + 32 * ks + 8 * kq), bb = *(const pg8::bf16x8*)(KS + (16 * jt + li) * 136 + 32 * ks + 8 * kq);
              acc = __builtin_amdgcn_mfma_f32_16x16x32_bf16(a, bb, acc, 0, 0, 0); }
#pragma unroll
          for (int r = 0; r < 4; ++r) { const int i = 16 * it + 4 * kq + r, j = 16 * jt + li; *(bf16_t*)(gp + GP_AM + (i * 64 + j) * 2) = f2bf(j <= i ? acc[r] : 0.f); } } }
    lds_barrier();
}

__device__ void gla_scan(const Params& p, int item, unsigned char* sm, unsigned long long& tsec) {
    const int s = item & 7, bdh = item >> 3, hh = bdh & 3, dir = (bdh >> 2) & 1, b = bdh >> 3;
    const int tid = ltid_w(p.wave), lane = tid & 63, wid = tid >> 6, li = lane & 15, kq = lane >> 4;
    constexpr int O_VT = 0, SZ_VT = 32 * 72 * 2, O_ST = 2 * SZ_VT;
    float* outp = dir ? p.ob : p.of;
    const unsigned char* gbase = p.gp + (size_t)(bdh * 65) * GP_STRIDE;
    const int it = wid >> 1, eto = wid & 1;
    struct RS { u32x4v fa[2], fq[4], fk[2], v; f32x4 dec; };
    auto LOAD = [&](int n, RS& R) {
        const unsigned char* g = gbase + (size_t)n * GP_STRIDE;
#pragma unroll
        for (int ks = 0; ks < 2; ++ks) R.fa[ks] = *(const u32x4v*)(g + GP_AM + ((16 * it + li) * 64 + 32 * ks + 8 * kq) * 2);
#pragma unroll
        for (int ks = 0; ks < 4; ++ks) R.fq[ks] = *(const u32x4v*)(g + GP_QT + ((16 * it + li) * 128 + 32 * ks + 8 * kq) * 2);
#pragma unroll
        for (int ks = 0; ks < 2; ++ks) R.fk[ks] = *(const u32x4v*)(g + GP_KT + ((16 * wid + li) * 64 + 32 * ks + 8 * kq) * 2);
        R.dec = *(const f32x4*)(g + GP_DEC + (16 * wid + 4 * kq) * 4);
        const int tau = dir ? 4159 - (64 * n + lane) : 64 * n + lane;
        R.v = (u32x4v){0u, 0u, 0u, 0u};
        R.v = *(const u32x4v*)(p.big + (size_t)(b * L + (tau < 48 ? 0 : tau - 48)) * INCP + C_V + hh * 256 + s * 32 + (wid & 3) * 8);
    };
    auto PUTV = [&](int buf, const RS& R) {
        if (wid < 4) { bf16_t* vt = (bf16_t*)(sm + O_VT + buf * SZ_VT);
#pragma unroll
            for (int x = 0; x < 4; ++x) { vt[(wid * 8 + 2 * x) * 72 + lane] = (bf16_t)(R.v[x] & 0xffffu); vt[(wid * 8 + 2 * x + 1) * 72 + lane] = (bf16_t)(R.v[x] >> 16); } }
    };
    f32x4 S[2];
    S[0] = (f32x4){0.f, 0.f, 0.f, 0.f}; S[1] = S[0];
    for (int i = tid; i < 8704 / 16; i += 512) *(u32x4v*)(sm + O_ST + i * 16) = (u32x4v){0u, 0u, 0u, 0u};
    const bf16_t* ST = (const bf16_t*)(sm + O_ST);
    auto STEP = [&](int n, RS& RA, const RS& RB, RS& RC) {
        unsigned long long ts0_ = PROBE_MASK ? wall_clock64() : 0ull;
        if (n + 2 < 65) LOAD(n + 2, RC);
        const bf16_t* VT = (const bf16_t*)(sm + O_VT + (n & 1) * SZ_VT);
        { f32x4 o = {0.f, 0.f, 0.f, 0.f};
#pragma unroll
          for (int ks = 0; ks < 2; ++ks) { const pg8::bf16x8 bb = *(const pg8::bf16x8*)(VT + (16 * eto + li) * 72 + 32 * ks + 8 * kq);
              o = __builtin_amdgcn_mfma_f32_16x16x32_bf16(__builtin_bit_cast(pg8::bf16x8, RA.fa[ks]), bb, o, 0, 0, 0); }
#pragma unroll
          for (int ks = 0; ks < 4; ++ks) { const pg8::bf16x8 bb = *(const pg8::bf16x8*)(ST + (16 * eto + li) * 136 + 32 * ks + 8 * kq);
              o = __builtin_amdgcn_mfma_f32_16x16x32_bf16(__builtin_bit_cast(pg8::bf16x8, RA.fq[ks]), bb, o, 0, 0, 0); }
#pragma unroll
          for (int r = 0; r < 4; ++r) { const int i = 16 * it + 4 * kq + r; const int tau = dir ? 4159 - (64 * n + i) : 64 * n + i;
              float* dst = tau >= 48 ? outp + (size_t)(b * L + tau - 48) * 1024 + hh * 256 + s * 32 + 16 * eto + li : p.dummy + tid;
              *dst = o[r]; } }
#pragma unroll
        for (int et = 0; et < 2; ++et) { S[et] *= RA.dec;
#pragma unroll
            for (int ks = 0; ks < 2; ++ks) { const pg8::bf16x8 bb = *(const pg8::bf16x8*)(VT + (16 * et + li) * 72 + 32 * ks + 8 * kq);
                S[et] = __builtin_amdgcn_mfma_f32_16x16x32_bf16(__builtin_bit_cast(pg8::bf16x8, RA.fk[ks]), bb, S[et], 0, 0, 0); } }
        HSEC(25);
        lds_barrier();
        HSEC(26);
#pragma unroll
        for (int et = 0; et < 2; ++et) { u32x2v w; w[0] = pk2(S[et][0], S[et][1]); w[1] = pk2(S[et][2], S[et][3]);
            *(u32x2v*)(sm + O_ST + ((16 * et + li) * 136 + 16 * wid + 4 * kq) * 2) = w; }
        if (n + 1 < 65) PUTV((n + 1) & 1, RB);
        lds_barrier();
        HSEC(27);
    };
    RS R0, R1, R2;
    LOAD(0, R0); LOAD(1, R1);
    PUTV(0, R0);
    lds_barrier();
    for (int n = 0; n < 63; n += 3) { STEP(n, R0, R1, R2); STEP(n + 1, R1, R2, R0); STEP(n + 2, R2, R0, R1); }
    STEP(63, R0, R1, R2); STEP(64, R1, R2, R0);
}

__device__ void fin_item(const Params& p, int item) {
    const int tid__ = ltid_w(p.wave), wid = tid__ >> 6, lane = tid__ & 63, m = item * 8 + wid;
    bf16_t* yrow = p.y + (size_t)m * D;
    if (m >= M) { const u32x4v z = {0u, 0u, 0u, 0u};
#pragma unroll
        for (int i = 0; i < 4; ++i) *(u32x4v*)(yrow + (lane + 64 * i) * 8) = z;
        return; }
    const int c0 = lane * 16;
    {
      const int b = m >= L ? 1 : 0, t = m - b * L;
      float x0[16];
#pragma unroll
      for (int i = 0; i < 4; ++i) { const f32x4 cb = *(const f32x4*)(p.conv_b + c0 + 4 * i); x0[4 * i] = cb[0]; x0[4 * i + 1] = cb[1]; x0[4 * i + 2] = cb[2]; x0[4 * i + 3] = cb[3]; }
#pragma unroll
      for (int jj = 0; jj < 3; ++jj) { const int t2 = t + jj - 1; const bool ok = t2 >= 0 && t2 < L; const int t2c = t2 < 0 ? 0 : (t2 >= L ? L - 1 : t2);
          { const bf16_t* row = p.big + (size_t)(b * L + t2c) * INCP + c0; const u32x4v r0 = *(const u32x4v*)row, r1 = *(const u32x4v*)(row + 8); const float okf = ok ? 1.f : 0.f;
#pragma unroll
              for (int i = 0; i < 4; ++i) { const f32x4 cw = *(const f32x4*)(p.conv_w + jj * 3072 + c0 + 4 * i) * okf; const unsigned lo = i < 2 ? r0[2 * i] : r1[2 * i - 4], hi = i < 2 ? r0[2 * i + 1] : r1[2 * i - 3];
                  x0[4 * i] += __uint_as_float(lo << 16) * cw[0]; x0[4 * i + 1] += __uint_as_float(lo & 0xffff0000u) * cw[1]; x0[4 * i + 2] += __uint_as_float(hi << 16) * cw[2]; x0[4 * i + 3] += __uint_as_float(hi & 0xffff0000u) * cw[3]; } } }
      const bf16_t* src = p.yc + (size_t)m * 1024 + c0; const u32x4v y0 = *(const u32x4v*)src, y1 = *(const u32x4v*)(src + 8);
      f32x4 v[4]; float ss = 0.f;
#pragma unroll
      for (int i = 0; i < 4; ++i) { const unsigned lo = i < 2 ? y0[2 * i] : y1[2 * i - 4], hi = i < 2 ? y0[2 * i + 1] : y1[2 * i - 3];
          v[i][0] = __uint_as_float(lo << 16) * x0[4 * i]; v[i][1] = __uint_as_float(lo & 0xffff0000u) * x0[4 * i + 1]; v[i][2] = __uint_as_float(hi << 16) * x0[4 * i + 2]; v[i][3] = __uint_as_float(hi & 0xffff0000u) * x0[4 * i + 3];
          ss += (v[i][0] * v[i][0] + v[i][1] * v[i][1]) + (v[i][2] * v[i][2] + v[i][3] * v[i][3]); }
      ss += shx<1>(ss); ss += shx<2>(ss); ss += shx<4>(ss);
      const float r = rsqrtf(ss * (1.0f / 128.0f) + EPS);
      u32x4v w0, w1;
#pragma unroll
      for (int i = 0; i < 4; ++i) { const f32x4 g = *(const f32x4*)(p.hyena_norm + c0 + 4 * i); const f32x4 o = v[i] * r * g;
          if (i < 2) { w0[2 * i] = pk2(o[0], o[1]); w0[2 * i + 1] = pk2(o[2], o[3]); } else { w1[2 * i - 4] = pk2(o[0], o[1]); w1[2 * i - 3] = pk2(o[2], o[3]); } }
      *(u32x4v*)(yrow + c0) = w0; *(u32x4v*)(yrow + c0 + 8) = w1; }
    { const float* s1 = p.of + (size_t)m * 1024 + c0; const float* s2 = p.ob + (size_t)m * 1024 + c0; f32x4 v[4]; float ss = 0.f;
#pragma unroll
      for (int i = 0; i < 4; ++i) { v[i] = *(const f32x4*)(s1 + 4 * i) + *(const f32x4*)(s2 + 4 * i); ss += (v[i][0] * v[i][0] + v[i][1] * v[i][1]) + (v[i][2] * v[i][2] + v[i][3] * v[i][3]); }
      ss += shx<1>(ss); ss += shx<2>(ss); ss += shx<4>(ss); ss += shx<8>(ss);
      const float r = rsqrtf(ss * (1.0f / 256.0f) + EPS);
      const bf16_t* og = p.big + (size_t)m * INCP + C_OG + c0;
      const u32x4v g0 = *(const u32x4v*)og, g1 = *(const u32x4v*)(og + 8);
      float ogf[16];
#pragma unroll
      for (int i = 0; i < 4; ++i) { ogf[2 * i] = __uint_as_float(g0[i] << 16); ogf[2 * i + 1] = __uint_as_float(g0[i] & 0xffff0000u); ogf[8 + 2 * i] = __uint_as_float(g1[i] << 16); ogf[8 + 2 * i + 1] = __uint_as_float(g1[i] & 0xffff0000u); }
      u32x4v w0, w1;
#pragma unroll
      for (int i = 0; i < 4; ++i) { const f32x4 g = *(const f32x4*)(p.gla_norm + ((c0 + 4 * i) & 255)); f32x4 o = v[i] * r * g;
          o[0] *= silu_f(ogf[4 * i]); o[1] *= silu_f(ogf[4 * i + 1]); o[2] *= silu_f(ogf[4 * i + 2]); o[3] *= silu_f(ogf[4 * i + 3]);
          if (i < 2) { w0[2 * i] = pk2(o[0], o[1]); w0[2 * i + 1] = pk2(o[2], o[3]); } else { w1[2 * i - 4] = pk2(o[0], o[1]); w1[2 * i - 3] = pk2(o[2], o[3]); } }
      *(u32x4v*)(yrow + 1024 + c0) = w0; *(u32x4v*)(yrow + 1024 + c0 + 8) = w1; }
}

__device__ void final_item(const Params& p, int item) {
    const int tid__ = ltid_w(p.wave), wid = tid__ >> 6, lane = tid__ & 63, row = item * 8 + wid, b = row >> 12, s = row & 4095, m = b * L + NMETA + s;
    const float* hrow = p.h + (size_t)m * D; float* orow = p.out + (size_t)row * D; f32x4 v[8]; float ss = 0.f;
#pragma unroll
    for (int i = 0; i < 8; ++i) { v[i] = *(const f32x4*)(hrow + (lane + 64 * i) * 4); ss += (v[i][0] * v[i][0] + v[i][1] * v[i][1]) + (v[i][2] * v[i][2] + v[i][3] * v[i][3]); }
    ss = wave_sum(ss); const float r = rsqrtf(ss * (1.0f / D) + EPS);
#pragma unroll
    for (int i = 0; i < 8; ++i) { const int c = (lane + 64 * i) * 4; *(f32x4*)(orow + c) = v[i] * r * *(const f32x4*)(p.final_norm + c); }
}

template <class TEpi> __device__ __forceinline__ void tail_tile(const bf16_t* A, int arow0, const bf16_t* Bt, int brow0, int brow1, const int K, float* red, const TEpi& E, int c, const int wave) {
    const int tid = ltid_w(wave), wid = tid >> 6, lane = tid & 63, li = lane & 15, kq = lane >> 4;
    const int kw = K >> 3, k0 = wid * kw;
    const bf16_t* ap = A + (size_t)(arow0 + li) * K + k0 + 8 * kq;
    const bf16_t* bp0 = Bt + (size_t)(brow0 + li) * K + k0 + 8 * kq;
    const bf16_t* bp1 = Bt + (size_t)(brow1 + li) * K + k0 + 8 * kq;
    f32x4 acc[2][4];
#pragma unroll
    for (int x = 0; x < 2; ++x)
#pragma unroll
        for (int y = 0; y < 4; ++y) acc[x][y] = (f32x4){0.f, 0.f, 0.f, 0.f};
#pragma unroll 6
    for (int k = 0; k < kw; k += 32) {
        pg8::bf16x8 a[2], bfr[4];
        a[0] = *(const pg8::bf16x8*)(ap + k); a[1] = *(const pg8::bf16x8*)(ap + (size_t)16 * K + k);
        bfr[0] = *(const pg8::bf16x8*)(bp0 + k); bfr[1] = *(const pg8::bf16x8*)(bp0 + (size_t)16 * K + k);
        bfr[2] = *(const pg8::bf16x8*)(bp1 + k); bfr[3] = *(const pg8::bf16x8*)(bp1 + (size_t)16 * K + k);
#pragma unroll
        for (int x = 0; x < 2; ++x)
#pragma unroll
            for (int y = 0; y < 4; ++y) acc[x][y] = __builtin_amdgcn_mfma_f32_16x16x32_bf16(bfr[y], a[x], acc[x][y], 0, 0, 0);
    }
#pragma unroll
    for (int x = 0; x < 2; ++x)
#pragma unroll
        for (int y = 0; y < 4; ++y) *(f32x4*)(red + wid * 2048 + (16 * x + li) * 64 + 16 * y + 4 * kq) = acc[x][y];
    lds_barrier();
    { const int row = tid >> 4, col4 = (tid & 15) * 4; f32x4 v = {0.f, 0.f, 0.f, 0.f};
#pragma unroll
      for (int w = 0; w < 8; ++w) v += *(const f32x4*)(red + w * 2048 + row * 64 + col4);
      E(arow0 + row, c, col4, v); }
    lds_barrier();
}
struct TEpiResid {
    float* H; bf16_t* HB; float* rowss; float scale;
    __device__ __forceinline__ void operator()(int r, int c, int col4, f32x4 v) const {
        float* hp = H + (size_t)r * D + c * 64 + col4; f32x4 a = *(const f32x4*)hp; a += v * scale; *(f32x4*)hp = a;
        float ss = (a[0] * a[0] + a[1] * a[1]) + (a[2] * a[2] + a[3] * a[3]);
        ss += shx<1>(ss); ss += shx<2>(ss); ss += shx<4>(ss); ss += shx<8>(ss);
        if (HB) { u32x2v w; w[0] = pk2(a[0], a[1]); w[1] = pk2(a[2], a[3]); *(u32x2v*)(HB + (size_t)r * D + c * 64 + col4) = w; }
        if (rowss && (lane_id() & 15) == 0) rowss[(size_t)r * 32 + c] = ss;
    }
};
struct TEpiScale {
    bf16_t* O; int ldc; const float* rowss;
    __device__ __forceinline__ void operator()(int r, int c, int col4, f32x4 v) const {
        const int l = lane_id() & 15; float s = rowss[(size_t)r * 32 + 2 * l] + rowss[(size_t)r * 32 + 2 * l + 1];
        s += shx<1>(s); s += shx<2>(s); s += shx<4>(s); s += shx<8>(s);
        const float rs = rsqrtf(s * (1.0f / D) + EPS);
        u32x2v w; w[0] = pk2(v[0] * rs, v[1] * rs); w[1] = pk2(v[2] * rs, v[3] * rs); *(u32x2v*)(O + (size_t)r * ldc + c * 64 + col4) = w;
    }
};

#define run_gemm(...) run_gemm_(__VA_ARGS__, p.wave)
template <class Epi> __device__ __forceinline__ void run_gemm_(PG8_LAS unsigned char* lds, const bf16_t* A, const bf16_t* Bt, int Mr, int N, int K, const Epi& E, const int wave) {
    pg8::Gemm g; g.A = A; g.Bt = Bt; g.M = Mr; g.N = N; g.K = K;
    pg8::StaticOrder S; S.init(Mr, N, (int)gridDim.x, (int)blockIdx.x);
    pg8::gemm_phase<Epi, pg8::StaticOrder>(lds, g, S, E, ltid_w(wave));
}

__device__ __forceinline__ void gbar(const __attribute__((address_space(4))) Params* kp, int wave, int k) {
    __syncthreads();
    if (ltid_w(wave) == 0) {
        unsigned* bar = kp->bar; const unsigned target = (unsigned)k * gridDim.x;
        __threadfence();
        __hip_atomic_fetch_add(bar, 1u, __ATOMIC_RELEASE, __HIP_MEMORY_SCOPE_AGENT);
        while (__hip_atomic_load(bar, __ATOMIC_RELAXED, __HIP_MEMORY_SCOPE_AGENT) < target) __builtin_amdgcn_s_sleep(1);
        __threadfence();
    }
    __syncthreads();
}
typedef const __attribute__((address_space(4))) Params* KParams;
#if defined(__HIP_DEVICE_COMPILE__)
#define LOADP() Params p; { KParams q_ = kp; asm volatile("" : "+s"(q_)); p = *q_; p.wave = wave_s; }
#else
#define LOADP() Params p = p_unused; p.wave = wave_s; (void)kp;
#endif
#define PSEC(i, stmt) do { unsigned long long a_ = PROBE_MASK ? wall_clock64() : 0ull; stmt; if (PROBE_MASK && ((PROBE_MASK >> (i)) & 1u)) t_acc += wall_clock64() - a_; } while (0)
#define MARK(i) do { if (PROBE_MASK) { const unsigned long long t_ = wall_clock64(); if ((PROBE_MASK >> (i)) & 1u) t_acc += t_ - t_last; t_last = t_; } } while (0)
__global__ __launch_bounds__(512, 2) void mega(Params p_unused) {
    KParams kp = (KParams)__builtin_amdgcn_kernarg_segment_ptr();
    const int wave_s = __builtin_amdgcn_readfirstlane((int)(threadIdx.x >> 6));
    unsigned long long t_acc = 0ull, t_last = PROBE_MASK ? wall_clock64() : 0ull;
    extern __shared__ __attribute__((aligned(16))) unsigned char smem[];
    cg::grid_group grid = cg::this_grid();
    PG8_LAS unsigned char* lds = (PG8_LAS unsigned char*)smem;
    float* smf = (float*)smem;
    const int G = gridDim.x, bid = blockIdx.x;
    { LOADP();
      transpose_mat(p.ffn1_wg, p.Wgu1, p.ffn1_norm, D, DFF, DFF, DFF, 1, smf, p.wave);
      transpose_mat(p.ffn1_wu, p.Wgu1, p.ffn1_norm, D, DFF, DFF, DFF, 2, smf, p.wave);
      transpose_mat(p.ffn1_wd, p.Wd1, nullptr, DFF, D, D, D, 0, smf, p.wave); }
    { LOADP();
      transpose_mat(p.w_in, p.Win, p.mix_norm, D, INCP, INC, INC, 0, smf, p.wave);
      transpose_mat(p.w_out, p.Wout, nullptr, D, D, D, D, 0, smf, p.wave); }
    { LOADP();
      transpose_mat(p.ffn2_wg, p.Wgu2, p.ffn2_norm, D, DFF, DFF, DFF, 1, smf, p.wave);
      transpose_mat(p.ffn2_wu, p.Wgu2, p.ffn2_norm, D, DFF, DFF, DFF, 2, smf, p.wave);
      transpose_mat(p.ffn2_wd, p.Wd2, nullptr, DFF, D, D, D, 0, smf, p.wave); }
    { LOADP();
      if (bid == 0 && ltid_w(p.wave) == 0) *p.ctr = 0u;
      wb_items(p);
      for (int it = bid; it < NT_ROWS + NT_Z2; it += G) { if (it < NT_ROWS) row_item(p, it); else z2_item(p, it - NT_ROWS); } }
    grid.sync(); MARK(0);
    { LOADP(); EpiSwiglu E; E.O = p.big; E.rowss = p.rowss; run_gemm(lds, p.hb, p.Wgu1, MP, 2 * DFF, D, E); }
    gbar(kp, wave_s, 1); MARK(1);
    { LOADP(); EpiResid<true> E; E.H = p.h; E.HB = p.hb; E.rowss = p.rowss; E.scale = 0.5f; run_gemm(lds, p.big, p.Wd1, 8192, D, DFF, E); }
    { LOADP(); TEpiResid T; T.H = p.h; T.HB = p.hb; T.rowss = p.rowss; T.scale = 0.5f;
      for (int c = bid; c < 32; c += G) PSEC(24, tail_tile(p.big, 8192, p.Wd1, 64 * c, 64 * c + 32, DFF, smf, T, c, p.wave)); }
    gbar(kp, wave_s, 2); MARK(2);
    { LOADP(); EpiScale E; E.O = p.big; E.ldc = INCP; E.rowss = p.rowss; run_gemm(lds, p.hb, p.Win, 8192, 6144, D, E); }
    { LOADP(); TEpiScale T; T.O = p.big; T.ldc = INCP; T.rowss = p.rowss;
      for (int it = bid; it < 97 + 256; it += G) { if (it < 97) tail_tile(p.hb, 8192, p.Win, 64 * it, 64 * it + 32, D, smf, T, it, p.wave); else tail_tile(p.hb, 32 * (it - 97), p.Win, 6144, 6176, D, smf, T, 96, p.wave); } }
    gbar(kp, wave_s, 3); MARK(3);
    { LOADP(); EpiFilt E; E.GF = p.GF; E.G0 = p.G0; PSEC(20, run_gemm(lds, p.WB, p.ZA, 2048, 4352, 256, E)); }
    { LOADP(); for (int it = bid; it < 1040 + 520; it += G) { if (it < 1040) PSEC(21, gla_pre(p, it, smem)); else PSEC(22, hyu_item(p, it - 1040, smem)); } }
    gbar(kp, wave_s, 4); MARK(4);
    { LOADP(); if (bid < 128) PSEC(23, gla_scan(p, ((((bid & 7) | (((bid >> 3) & 1) << 3)) << 3) | (bid >> 4)), smem, t_acc)); }
    { LOADP();
      for (;;) {
        if (ltid_w(p.wave) == 0) *(int*)(smem + HY_ZERO_OFF + 192) = (int)atomicAdd(p.ctr, 1u);
        lds_barrier();
        const int g = *(const int*)(smem + HY_ZERO_OFF + 192);
        lds_barrier();
        if (g >= 256) break;
        hyena_group(p, (g & 7) * 32 + (g >> 3), smem, t_acc);
      } }
    gbar(kp, wave_s, 5); MARK(5);
    { LOADP(); for (int it = bid; it < MP / 8; it += G) fin_item(p, it); }
    gbar(kp, wave_s, 6); MARK(6);
    { LOADP(); EpiResid<true> E; E.H = p.h; E.HB = p.hb; E.rowss = p.rowss; E.scale = 1.0f; run_gemm(lds, p.y, p.Wout, 8192, D, D, E); }
    { LOADP(); TEpiResid T; T.H = p.h; T.HB = p.hb; T.rowss = p.rowss; T.scale = 1.0f;
      for (int c = bid; c < 32; c += G) tail_tile(p.y, 8192, p.Wout, 64 * c, 64 * c + 32, D, smf, T, c, p.wave); }
    gbar(kp, wave_s, 7); MARK(7);
    { LOADP(); EpiSwiglu E; E.O = p.big; E.rowss = p.rowss; run_gemm(lds, p.hb, p.Wgu2, MP, 2 * DFF, D, E); }
    gbar(kp, wave_s, 8); MARK(8);
    { LOADP(); EpiResid<false> E; E.H = p.h; E.HB = nullptr; E.rowss = nullptr; E.scale = 0.5f; run_gemm(lds, p.big, p.Wd2, 8192, D, DFF, E); }
    { LOADP(); TEpiResid T; T.H = p.h; T.HB = nullptr; T.rowss = nullptr; T.scale = 0.5f;
      for (int c = bid; c < 32; c += G) tail_tile(p.big, 8192, p.Wd2, 64 * c, 64 * c + 32, DFF, smf, T, c, p.wave); }
    gbar(kp, wave_s, 9); MARK(9);
    { LOADP(); for (int it = bid; it < 1024; it += G) final_item(p, it); }
    MARK(10);
    if (PROBE_MASK && bid == 0) { const unsigned long long t0_ = wall_clock64(); while (wall_clock64() - t0_ < (unsigned long long)PROBE_K * t_acc) __builtin_amdgcn_s_sleep(8); }
}

extern "C" void kernel_launch(void* const* d_in, const int* in_sizes, int n_in, void* d_out, int out_size, void* d_ws, size_t ws_size, hipStream_t stream) {
    static int grid_blocks = 0;
    if (!grid_blocks) {
        (void)hipFuncSetAttribute((const void*)mega, hipFuncAttributeMaxDynamicSharedMemorySize, LDS_BYTES);
        int dev = 0, cus = 0, per_cu = 0;
        (void)hipGetDevice(&dev);
        (void)hipDeviceGetAttribute(&cus, hipDeviceAttributeMultiprocessorCount, dev);
        (void)hipOccupancyMaxActiveBlocksPerMultiprocessor(&per_cu, mega, 512, LDS_BYTES);
        if (per_cu > 1) per_cu = 1;
        if (per_cu < 1) { fprintf(stderr, "occupancy query returned %d\n", per_cu); per_cu = 1; }
        grid_blocks = cus * per_cu;
    }
    Params p{};
    const float* const* in = (const float* const*)d_in;
    p.x = in[0]; p.meta = in[1]; p.ffn1_norm = in[2]; p.ffn1_wg = in[3]; p.ffn1_wu = in[4]; p.ffn1_wd = in[5]; p.mix_norm = in[6]; p.w_in = in[7];
    p.conv_w = in[8]; p.conv_b = in[9]; p.filt_w1 = in[10]; p.filt_b1 = in[11]; p.filt_w2 = in[12]; p.filt_b2 = in[13]; p.filt_w3 = in[14]; p.filt_freq = in[15];
    p.hyena_d = in[16]; p.hyena_norm = in[17]; p.gk_w2 = in[18]; p.gk_b2 = in[19]; p.gla_norm = in[20]; p.w_out = in[21];
    p.ffn2_norm = in[22]; p.ffn2_wg = in[23]; p.ffn2_wu = in[24]; p.ffn2_wd = in[25]; p.final_norm = in[26];
    p.out = (float*)d_out;
    unsigned char* ws = (unsigned char*)d_ws;
    constexpr size_t SZ_WGU = (size_t)2 * DFF * D * 2, SZ_WD = (size_t)D * DFF * 2, SZ_WIN = (size_t)INCP * D * 2, SZ_WOUT = (size_t)D * D * 2;
    constexpr size_t SZ_H = (size_t)MP * D * 4, SZ_HB = (size_t)MP * D * 2, SZ_BIG = (size_t)MP * INCP * 2, SZ_RS = (size_t)MP * 32 * 4, SZ_Z2 = (size_t)L * 64 * 4;
    size_t o = 0;
    p.Wgu1 = (bf16_t*)(ws + o); o += SZ_WGU; p.Wd1 = (bf16_t*)(ws + o); o += SZ_WD; p.Win = (bf16_t*)(ws + o); o += SZ_WIN; p.Wout = (bf16_t*)(ws + o); o += SZ_WOUT;
    p.Wgu2 = (bf16_t*)(ws + o); o += SZ_WGU; p.Wd2 = (bf16_t*)(ws + o); o += SZ_WD;
    p.h = (float*)(ws + o); o += SZ_H; p.hb = (bf16_t*)(ws + o); o += SZ_HB; p.big = (bf16_t*)(ws + o); o += SZ_BIG; p.rowss = (float*)(ws + o); o += SZ_RS; p.z2 = (float*)(ws + o); o += SZ_Z2; p.ctr = (unsigned*)(ws + o); o += 256; p.ZA = (bf16_t*)(ws + o); o += (size_t)4352 * 256 * 2; p.WB = (bf16_t*)(ws + o); o += (size_t)2048 * 256 * 2; p.G0 = (float*)(ws + o); o += 2048 * 4; p.bar = (unsigned*)(ws + o); o += 256; p.dummy = (float*)(ws + o); o += 4096;
    p.yc = (bf16_t*)ws; p.y = (bf16_t*)(ws + (size_t)M * 1024 * 2); p.of = (float*)p.hb; p.ob = (float*)d_out; p.gp = ws + (size_t)M * 1024 * 2; p.GF = p.Win; p.uT = (bf16_t*)((unsigned char*)d_out + (size_t)M * 1024 * 4);
    if (o > ws_size) fprintf(stderr, "workspace too small: need %zu have %zu\n", o, ws_size);
    (void)hipMemsetAsync(p.bar, 0, 256, stream);
    void* args[] = {&p};
    hipError_t e = hipLaunchCooperativeKernel((void*)mega, dim3(grid_blocks), dim3(512), args, LDS_BYTES, stream);
    if (e != hipSuccess) fprintf(stderr, "cooperative launch failed: %s (grid %d)\n", hipGetErrorString(e), grid_blocks);
}
```

```cpp
#include <hip/hip_runtime.h>
#include <hip/hip_cooperative_groups.h>
#include <cstdio>
namespace cg = cooperative_groups;
namespace pg8 {
#define PG8_LAS __attribute__((address_space(3)))
typedef unsigned short bf16_t;
typedef short bf16x8 __attribute__((ext_vector_type(8)));
typedef float f32x4 __attribute__((ext_vector_type(4)));
typedef unsigned u32x4 __attribute__((ext_vector_type(4)));
constexpr int BM = 256, BK = 64, HALF = 128, HTB = HALF * BK * 2  , STAGE_BYTES = 8 * HTB, NXCD = 8, WGM = 8;

__host__ __device__ __forceinline__ int lds_byte(int r, int c) { const int st = (r >> 4) * 2 + (c >> 5), rr = r & 15, cc = c & 31, ob = rr * 64 + cc * 2; return st * 1024 + (ob ^ (((ob >> 9) & 1) << 5)); }
__host__ __device__ __forceinline__ void stage_rc(int b, int& R, int& C) { const int st = b / 1024, sb = b % 1024, swz = sb ^ (((sb >> 9) & 1) << 5); R = (st >> 1) * 16 + swz / 64; C = (st & 1) * 32 + (swz % 64) / 2; }
__host__ __device__ __forceinline__ int perm32(int rho) { const int n = rho >> 4, i = rho & 15; return 8 * (i >> 2) + 4 * n + (i & 3); }

struct Unit { int pm, pn; };
struct Gemm { const bf16_t* A; const bf16_t* Bt; int M, N, K; };

struct StaticOrder {
    int nM, nN, nwg, G, c;
    __host__ __device__ void init(int M, int N, int G_, int c_) { nM = M / BM; nN = N / BM; nwg = nM * nN; G = G_; c = c_; }
    __host__ __device__ bool next(int i, Unit& u) const {
        const long L = (long)i * G + c; if (L >= nwg) return false;
        int wgid = (int)L; { const int q = nwg / NXCD, r = nwg % NXCD, xcd = wgid % NXCD, off = wgid / NXCD; wgid = (xcd < r ? xcd * (q + 1) : r * (q + 1) + (xcd - r) * q) + off; }
        const int nig = WGM * nN, gid = wgid / nig, fm = gid * WGM, gsz = (nM - fm) < WGM ? (nM - fm) : WGM;
        u.pm = fm + ((wgid % nig) % gsz); u.pn = (wgid % nig) / gsz; return true;
    }
    __device__ __forceinline__ void a_ready(const Unit&) const {}
    __device__ __forceinline__ void done(const Unit&) const {}
};
__device__ __forceinline__ unsigned cvt_pk_bf16(float lo, float hi) { unsigned r; asm volatile("v_cvt_pk_bf16_f32 %0, %1, %2" : "=v"(r) : "v"(lo), "v"(hi)); return r; }
template <class Epi, class Sched>
__device__ __forceinline__ void gemm_phase(PG8_LAS unsigned char* lds, const Gemm g, const Sched& S, const Epi& E, const int tid_in) {
    const int tid = tid_in, wid = __builtin_amdgcn_readfirstlane(tid >> 6), lane = tid & 63, wr = wid >> 2, wc = wid & 3, fr = lane & 15, fq = lane >> 4;
    const int K = g.K, nt = K / BK;
    unsigned voffA[2], voffB[2];
#pragma unroll
    for (int i = 0; i < 2; ++i) { int R, C; stage_rc(tid * 16 + i * 8192, R, C); const int Rb = Epi::PERM ? ((R & ~31) + perm32(R & 31)) : R;
        voffA[i] = (unsigned)(R * K + C) * 2u; voffB[i] = (unsigned)(Rb * K + C) * 2u; }
    const size_t kstep = (size_t)(BK * 2);
    const size_t hstep = (size_t)HALF * K * 2;
    const size_t tstep = 2 * hstep;
    const unsigned ldsw = (unsigned)wid * 1024u;
    const int aoff = lds_byte(wr * 64 + fr, fq * 8), boff = lds_byte(wc * 32 + fr, fq * 8);
#define PG8_SA(b, h) (((b) * 2 + (h)) * HTB)
#define PG8_SB(b, h) ((4 + (b) * 2 + (h)) * HTB)
#define PG8_STAGE(bufoff, gbase, voff) do { _Pragma("unroll") for (int _i = 0; _i < 2; ++_i) \
        __builtin_amdgcn_global_load_lds((const unsigned*)((const char*)(gbase) + (voff)[_i]), (PG8_LAS unsigned*)(lds + (bufoff) + ldsw + _i * 8192), 16, 0, 0); } while (0)
#define PG8_LDA(dst, b, h) do { _Pragma("unroll") for (int m = 0; m < 4; ++m) _Pragma("unroll") for (int k = 0; k < 2; ++k) dst[m][k] = *(const PG8_LAS bf16x8*)(lds + PG8_SA(b, h) + aoff + m * 2048 + k * 1024); } while (0)
#define PG8_LDB(dst, b, h) do { _Pragma("unroll") for (int n = 0; n < 2; ++n) _Pragma("unroll") for (int k = 0; k < 2; ++k) dst[n][k] = *(const PG8_LAS bf16x8*)(lds + PG8_SB(b, h) + boff + n * 2048 + k * 1024); } while (0)
#define PG8_MMA(ai, bj, At, Bt) do { __builtin_amdgcn_s_setprio(1); _Pragma("unroll") for (int m = 0; m < 4; ++m) _Pragma("unroll") for (int n = 0; n < 2; ++n) _Pragma("unroll") for (int k = 0; k < 2; ++k) \
        acc[ai][bj][m][n] = __builtin_amdgcn_mfma_f32_16x16x32_bf16(Bt[n][k], At[m][k], acc[ai][bj][m][n], 0, 0, 0); __builtin_amdgcn_s_setprio(0); } while (0)
#define PG8_WAIT_V(n) asm volatile("s_waitcnt vmcnt(" #n ")" ::: "memory")
#define PG8_WAIT_L(n) asm volatile("s_waitcnt lgkmcnt(" #n ")" ::: "memory")
#define PG8_BAR __builtin_amdgcn_s_barrier()
#define PG8_SCHED __builtin_amdgcn_sched_barrier(0)
    Unit cur, nxt; int ui = 0;
    if (!S.next(0, cur)) return;
    f32x4 acc[2][2][4][2];
#pragma unroll
    for (int a = 0; a < 2; ++a)
#pragma unroll
        for (int b = 0; b < 2; ++b)
#pragma unroll
            for (int m = 0; m < 4; ++m)
#pragma unroll
                for (int n = 0; n < 2; ++n) acc[a][b][m][n] = (f32x4){0.f, 0.f, 0.f, 0.f};
    bf16x8 At[4][2], B0[2][2], B1[2][2];
    const char* cA = (const char*)g.A + (size_t)cur.pm * tstep; const char* cB = (const char*)g.Bt + (size_t)cur.pn * tstep;
    S.a_ready(cur);
    PG8_STAGE(PG8_SB(0, 0), cB, voffB); PG8_STAGE(PG8_SA(0, 0), cA, voffA); PG8_STAGE(PG8_SB(0, 1), cB + hstep, voffB); PG8_STAGE(PG8_SA(0, 1), cA + hstep, voffA);
    if (wr == 1) PG8_BAR;
    PG8_WAIT_V(4); PG8_BAR;
    PG8_STAGE(PG8_SB(1, 0), cB + kstep, voffB); PG8_STAGE(PG8_SA(1, 0), cA + kstep, voffA); PG8_STAGE(PG8_SB(1, 1), cB + hstep + kstep, voffB);
    PG8_WAIT_V(6); PG8_BAR;
    for (;;) {
        const bool has_next = S.next(ui + 1, nxt);
        const char* nA = has_next ? (const char*)g.A + (size_t)nxt.pm * tstep : cA; const char* nB = has_next ? (const char*)g.Bt + (size_t)nxt.pn * tstep : cB;
        for (int t = 0; t < nt; t += 2) {
            const bool last = (t == nt - 2);
            const char* a1 = cA + (size_t)(t + 1) * kstep;
            const char* a2 = last ? nA : cA + (size_t)(t + 2) * kstep; const char* b2 = last ? nB : cB + (size_t)(t + 2) * kstep;
            const char* a3 = a2 + kstep; const char* b3 = b2 + kstep;
            if (last && has_next) S.a_ready(nxt);
            PG8_LDB(B0, 0, 0); PG8_SCHED; PG8_LDA(At, 0, 0); PG8_STAGE(PG8_SA(1, 1), a1 + hstep, voffA);
            PG8_WAIT_L(8); PG8_BAR; PG8_WAIT_L(0); PG8_MMA(0, 0, At, B0); PG8_BAR; PG8_SCHED;
            PG8_LDB(B1, 0, 1); PG8_STAGE(PG8_SB(0, 0), b2, voffB);
            PG8_BAR; PG8_WAIT_L(0); PG8_MMA(0, 1, At, B1); PG8_BAR;
            PG8_LDA(At, 0, 1); PG8_STAGE(PG8_SA(0, 0), a2, voffA);
            PG8_BAR; PG8_WAIT_L(0); PG8_MMA(1, 0, At, B0); PG8_BAR; PG8_SCHED;
            PG8_STAGE(PG8_SB(0, 1), b2 + hstep, voffB);
            PG8_WAIT_V(6); PG8_BAR; PG8_MMA(1, 1, At, B1); PG8_BAR;
            PG8_LDB(B0, 1, 0); PG8_SCHED; PG8_LDA(At, 1, 0); PG8_STAGE(PG8_SA(0, 1), a2 + hstep, voffA);
            PG8_WAIT_L(8); PG8_BAR; PG8_WAIT_L(0); PG8_MMA(0, 0, At, B0); PG8_BAR; PG8_SCHED;
            PG8_LDB(B1, 1, 1); PG8_STAGE(PG8_SB(1, 0), b3, voffB);
            PG8_BAR; PG8_WAIT_L(0); PG8_MMA(0, 1, At, B1); PG8_BAR;
            PG8_LDA(At, 1, 1); PG8_STAGE(PG8_SA(1, 0), a3, voffA);
            PG8_BAR; PG8_WAIT_L(0); PG8_MMA(1, 0, At, B0); PG8_BAR; PG8_SCHED;
            PG8_STAGE(PG8_SB(1, 1), b3 + hstep, voffB);
            PG8_WAIT_V(6); PG8_BAR; PG8_MMA(1, 1, At, B1); PG8_BAR;
        }
        if constexpr (!Epi::AFTER_DRAIN) { E(acc, cur, wr, wc, fr, fq); S.done(cur); }
        if (!has_next) break;
#pragma unroll
        for (int a = 0; a < 2; ++a)
#pragma unroll
            for (int b = 0; b < 2; ++b)
#pragma unroll
                for (int m = 0; m < 4; ++m)
#pragma unroll
                    for (int n = 0; n < 2; ++n) acc[a][b][m][n] = (f32x4){0.f, 0.f, 0.f, 0.f};
        cur = nxt; cA = nA; cB = nB; ++ui;
    }
    PG8_WAIT_V(0);
    if (wr == 0) PG8_BAR;
    PG8_BAR;
    if constexpr (Epi::AFTER_DRAIN) { E.fused(acc, cur, wr, wc, fr, fq, lds, wid, lane); S.done(cur); }
#undef PG8_SA
#undef PG8_SB
#undef PG8_STAGE
#undef PG8_LDA
#undef PG8_LDB
#undef PG8_MMA
#undef PG8_WAIT_V
#undef PG8_WAIT_L
#undef PG8_BAR
#undef PG8_SCHED
}
}

#include <cstdio>
#include <ctime>
#include <cstdlib>
#include <cstring>
#include <cmath>
#include <vector>
#include <algorithm>

using pg8::bf16_t; using pg8::f32x4; using pg8::Unit;
typedef unsigned u32x2v __attribute__((ext_vector_type(2)));
typedef unsigned u32x4v __attribute__((ext_vector_type(4)));

constexpr int D = 2048, SEQ = 4096, NMETA = 16, L = 4112, M = 8224, MP = 8448, DFF = 5632, INC = 6176, INCP = 6400;
constexpr float EPS = 1e-6f;
constexpr int LDS_BYTES = 4 * (8336 * 2 + 2 * 65 * 144) + 256;
constexpr unsigned PROBE_MASK = 0u; constexpr int PROBE_K = 8;
#define HSEC(i) do { if (PROBE_MASK) { const unsigned long long t_ = wall_clock64(); if ((PROBE_MASK >> (i)) & 1u) tsec += t_ - ts0_; ts0_ = t_; } } while (0)
constexpr int C_Q = 3072, C_K = 3584, C_V = 4096, C_OG = 5120, C_LR = 6144;

struct Params {
    const float *x, *meta, *ffn1_norm, *ffn1_wg, *ffn1_wu, *ffn1_wd, *mix_norm, *w_in, *conv_w, *conv_b,
        *filt_w1, *filt_b1, *filt_w2, *filt_b2, *filt_w3, *filt_freq, *hyena_d, *hyena_norm, *gk_w2, *gk_b2, *gla_norm, *w_out,
        *ffn2_norm, *ffn2_wg, *ffn2_wu, *ffn2_wd, *final_norm;
    float* out;
    bf16_t *Wgu1, *Wd1, *Win, *Wout, *Wgu2, *Wd2;
    float* h; bf16_t* hb; bf16_t* big; float* rowss; float* z2;
    bf16_t* y; bf16_t* yc; float* of; float* ob; unsigned char* gp; unsigned* ctr; bf16_t* uT; bf16_t* ZA; bf16_t* WB; bf16_t* GF; float* G0; unsigned* bar; float* dummy; int wave; int pad_;
};

__device__ __forceinline__ int lane_id() { return (int)__builtin_amdgcn_mbcnt_hi(~0u, __builtin_amdgcn_mbcnt_lo(~0u, 0u)); }
__device__ __forceinline__ int ltid_w(int wave) { int t = (wave << 6) | lane_id(); asm volatile("" : "+v"(t)); return t; }
__device__ __forceinline__ void lds_barrier() { asm volatile("s_waitcnt lgkmcnt(0)" ::: "memory"); __builtin_amdgcn_s_barrier(); asm volatile("" ::: "memory"); }
__device__ __forceinline__ float bf2f(bf16_t b) { return __uint_as_float(((unsigned)b) << 16); }
__device__ __forceinline__ unsigned pk2(float lo, float hi) { return pg8::cvt_pk_bf16(lo, hi); }
__device__ __forceinline__ bf16_t f2bf(float v) { return (bf16_t)(pk2(v, 0.f) & 0xffffu); }
template <int MSK> __device__ __forceinline__ float shx(float v) {
    if constexpr (MSK < 32) return __int_as_float(__builtin_amdgcn_ds_swizzle(__float_as_int(v), 0x1f | (MSK << 10)));
    else { int l = lane_id(); asm volatile("" : "+v"(l)); return __int_as_float(__builtin_amdgcn_ds_bpermute((l ^ 32) << 2, __float_as_int(v))); }
}
__device__ __forceinline__ float wave_sum(float v) { v += shx<32>(v); v += shx<16>(v); v += shx<8>(v); v += shx<4>(v); v += shx<2>(v); v += shx<1>(v); return v; }
__device__ __forceinline__ float silu_f(float x) { return x * __builtin_amdgcn_rcpf(1.0f + __expf(-x)); }

__device__ __forceinline__ float row_rscale(const float* rowss, int r, int fq) {
    const f32x4* q = (const f32x4*)(rowss + (size_t)r * 32 + fq * 8);
    const f32x4 a = q[0], b = q[1];
    float s = ((a[0] + a[1]) + (a[2] + a[3])) + ((b[0] + b[1]) + (b[2] + b[3]));
    s += shx<16>(s); s += shx<32>(s);
    return rsqrtf(s * (1.0f / D) + EPS);
}

struct EpiSwiglu {
    static constexpr bool PERM = true, AFTER_DRAIN = false;
    bf16_t* O; const float* rowss;
    __device__ __forceinline__ void operator()(const f32x4 (&acc)[2][2][4][2], const Unit& u, int wr, int wc, int fr, int fq) const {
        const int row0 = u.pm * 256 + wr * 64 + fr, col0 = u.pn * 128 + wc * 32 + 8 * fq;
#pragma unroll
        for (int ai = 0; ai < 2; ++ai)
#pragma unroll
            for (int m = 0; m < 4; ++m) {
                const int r = row0 + ai * 128 + m * 16; const float rs = row_rscale(rowss, r, fq);
                u32x4v w;
#pragma unroll
                for (int n = 0; n < 2; ++n) { const f32x4 g = acc[ai][0][m][n] * rs, uu = acc[ai][1][m][n] * rs;
                    w[2 * n] = pk2(silu_f(g[0]) * uu[0], silu_f(g[1]) * uu[1]); w[2 * n + 1] = pk2(silu_f(g[2]) * uu[2], silu_f(g[3]) * uu[3]); }
                *(u32x4v*)(O + (size_t)r * DFF + col0) = w;
            }
    }
};
struct EpiScale {
    static constexpr bool PERM = true, AFTER_DRAIN = false;
    bf16_t* O; int ldc; const float* rowss;
    __device__ __forceinline__ void operator()(const f32x4 (&acc)[2][2][4][2], const Unit& u, int wr, int wc, int fr, int fq) const {
        const int row0 = u.pm * 256 + wr * 64 + fr, col0 = u.pn * 256 + wc * 32 + 8 * fq;
#pragma unroll
        for (int ai = 0; ai < 2; ++ai)
#pragma unroll
            for (int m = 0; m < 4; ++m) {
                const int r = row0 + ai * 128 + m * 16; const float rs = row_rscale(rowss, r, fq);
#pragma unroll
                for (int bj = 0; bj < 2; ++bj) { const f32x4 a = acc[ai][bj][m][0] * rs, b = acc[ai][bj][m][1] * rs;
                    u32x4v w; w[0] = pk2(a[0], a[1]); w[1] = pk2(a[2], a[3]); w[2] = pk2(b[0], b[1]); w[3] = pk2(b[2], b[3]);
                    *(u32x4v*)(O + (size_t)r * ldc + col0 + bj * 128) = w; }
            }
    }
};
template <bool WHB> struct EpiResid {
    static constexpr bool PERM = true, AFTER_DRAIN = false;
    float* H; bf16_t* HB; float* rowss; float scale;
    __device__ __forceinline__ void operator()(const f32x4 (&acc)[2][2][4][2], const Unit& u, int wr, int wc, int fr, int fq) const {
        const int row0 = u.pm * 256 + wr * 64 + fr, col0 = u.pn * 256 + wc * 32 + 8 * fq;
#pragma unroll
        for (int ai = 0; ai < 2; ++ai)
#pragma unroll
            for (int m = 0; m < 4; ++m) {
                const int r = row0 + ai * 128 + m * 16; float ss = 0.f;
#pragma unroll
                for (int bj = 0; bj < 2; ++bj) { float* hp = H + (size_t)r * D + col0 + bj * 128;
                    f32x4 a = *(const f32x4*)hp, b = *(const f32x4*)(hp + 4);
                    a += acc[ai][bj][m][0] * scale; b += acc[ai][bj][m][1] * scale;
                    *(f32x4*)hp = a; *(f32x4*)(hp + 4) = b;
                    ss += (a[0] * a[0] + a[1] * a[1]) + (a[2] * a[2] + a[3] * a[3]) + (b[0] * b[0] + b[1] * b[1]) + (b[2] * b[2] + b[3] * b[3]);
                    if (WHB) { u32x4v w; w[0] = pk2(a[0], a[1]); w[1] = pk2(a[2], a[3]); w[2] = pk2(b[0], b[1]); w[3] = pk2(b[2], b[3]);
                        *(u32x4v*)(HB + (size_t)r * D + col0 + bj * 128) = w; } }
                ss += shx<16>(ss); ss += shx<32>(ss);
                if (WHB && fq == 0) rowss[(size_t)r * 32 + u.pn * 4 + wc] = ss;
            }
    }
};

constexpr int NT_FFN = 2816, NT_WIN = 3200, NT_WOUT = 1024, NT_TR = 6 * NT_FFN + NT_WIN + NT_WOUT, NT_ROWS = MP / 8, NT_Z2 = 4352 / 8, P0_ITEMS = NT_TR + NT_ROWS + NT_Z2;

__device__ __forceinline__ void transpose_mat(const float* src, bf16_t* dst, const float* gain, const int K, const int N, const int ld, const int nvalid, const int mode, float* tl, const int wave) {
    const int nst = (N + 511) / 512, nkt = K / 64, nitems = nkt * nst, tid = ltid_w(wave);
    for (int it = blockIdx.x; it < nitems; it += gridDim.x) {
        const int st = it / nkt, kt = it - st * nkt, k0 = kt * 64, nbase = st * 512;
        { const int r = tid >> 4, c4 = (tid & 15) * 4;
          const float g0 = gain ? gain[k0 + r] : 1.0f, g1 = gain ? gain[k0 + r + 32] : 1.0f;
          f32x4 v[8][2];
#pragma unroll
          for (int s8 = 0; s8 < 8; ++s8)
#pragma unroll
              for (int i = 0; i < 2; ++i) { const int n = nbase + s8 * 64 + c4; v[s8][i] = (f32x4){0.f, 0.f, 0.f, 0.f};
                  if (n < nvalid) v[s8][i] = *(const f32x4*)(src + (size_t)(k0 + r + 32 * i) * ld + n); }
#pragma unroll
          for (int s8 = 0; s8 < 8; ++s8)
#pragma unroll
              for (int i = 0; i < 2; ++i) { const float g = i ? g1 : g0; float* t = tl + s8 * 4160 + (r + 32 * i) * 65 + c4;
                  t[0] = v[s8][i][0] * g; t[1] = v[s8][i][1] * g; t[2] = v[s8][i][2] * g; t[3] = v[s8][i][3] * g; } }
        lds_barrier();
        { const int nl = tid >> 3, k8 = (tid & 7) * 8;
#pragma unroll
          for (int s8 = 0; s8 < 8; ++s8) { const int n0 = nbase + s8 * 64;
              if (n0 < N) { float w8[8];
#pragma unroll
                  for (int j = 0; j < 8; ++j) w8[j] = tl[s8 * 4160 + (k8 + j) * 65 + nl];
                  u32x4v w; w[0] = pk2(w8[0], w8[1]); w[1] = pk2(w8[2], w8[3]); w[2] = pk2(w8[4], w8[5]); w[3] = pk2(w8[6], w8[7]);
                  const long drow0 = mode == 0 ? n0 : (n0 / 128) * 256 + (n0 % 128) + (mode == 2 ? 128 : 0);
                  *(u32x4v*)(dst + (size_t)(drow0 + nl) * K + k0 + k8) = w; } } }
        lds_barrier();
    }
}

__device__ void row_item(const Params& p, int item) {
    const int tid__ = ltid_w(p.wave), wid = tid__ >> 6, lane = tid__ & 63, m = item * 8 + wid;
    float* hrow = p.h + (size_t)m * D; bf16_t* hbrow = p.hb + (size_t)m * D;
    if (m < M) { const int b = m / L, t = m - b * L;
        const float* src = t < NMETA ? p.meta + (size_t)t * D : p.x + ((size_t)b * SEQ + t - NMETA) * D;
        float ss = 0.f;
#pragma unroll
        for (int i = 0; i < 8; ++i) { const int c = (lane + 64 * i) * 4; const f32x4 v = *(const f32x4*)(src + c);
            ss += (v[0] * v[0] + v[1] * v[1]) + (v[2] * v[2] + v[3] * v[3]);
            *(f32x4*)(hrow + c) = v; u32x2v w; w[0] = pk2(v[0], v[1]); w[1] = pk2(v[2], v[3]); *(u32x2v*)(hbrow + c) = w; }
        ss = wave_sum(ss);
        if (lane < 32) p.rowss[(size_t)m * 32 + lane] = lane == 0 ? ss : 0.f;
    } else {
#pragma unroll
        for (int i = 0; i < 8; ++i) { const int c = (lane + 64 * i) * 4; *(f32x4*)(hrow + c) = (f32x4){0.f, 0.f, 0.f, 0.f}; u32x2v w; w[0] = 0u; w[1] = 0u; *(u32x2v*)(hbrow + c) = w; }
        if (lane < 32) p.rowss[(size_t)m * 32 + lane] = 0.f;
    }
}

__device__ void z2_item(const Params& p, int item) {
    const int tid__ = ltid_w(p.wave), wid = tid__ >> 6, lane = tid__ & 63, j = item * 8 + wid;
    bf16_t* za = p.ZA + (size_t)j * 256;
    if (j >= L) { za[lane] = 0; za[64 + lane] = 0; za[128 + lane] = 0; za[192 + lane] = 0; return; }
    float feat = 0.f;
    const float w = (float)(2.0 * 3.14159265358979323846 / L) * (float)j;
    if (lane == 0) feat = (float)j * (1.0f / (float)(L - 1));
    else if (lane <= 32) { const int bi = (lane - 1) & 15; const float band = 1e-4f + (float)bi * ((15.0f - 1e-4f) / 15.0f); const float ang = w * band;
        feat = lane <= 16 ? cosf(ang) : -sinf(ang); }
    float a = p.filt_b1[lane];
    for (int i = 0; i < 33; ++i) a += __int_as_float(__builtin_amdgcn_readlane(__float_as_int(feat), i)) * p.filt_w1[i * 64 + lane];
    const float fr = p.filt_freq[lane];
    const float z1 = sinf(fr * a);
    float c = p.filt_b2[lane];
    for (int k = 0; k < 64; ++k) c += __int_as_float(__builtin_amdgcn_readlane(__float_as_int(z1), k)) * p.filt_w2[k * 64 + lane];
    const float z = sinf(fr * c);
    const bf16_t hi = f2bf(z), lo = f2bf(z - bf2f(hi));
    za[lane] = hi; za[64 + lane] = lo; za[128 + lane] = hi; za[192 + lane] = 0;
}
__device__ void wb_items(const Params& p) {
    for (int idx = blockIdx.x * 512 + ltid_w(p.wave); idx < 2048 * 64; idx += gridDim.x * 512) { const int n = idx >> 6, k = idx & 63;
        const float w = p.filt_w3[(size_t)k * 2048 + n]; const bf16_t hi = f2bf(w), lo = f2bf(w - bf2f(hi));
        bf16_t* wb = p.WB + (size_t)n * 256; wb[k] = hi; wb[64 + k] = hi; wb[128 + k] = lo; wb[192 + k] = 0; }
}
struct EpiFilt {
    static constexpr bool PERM = true, AFTER_DRAIN = false;
    bf16_t* GF; float* G0;
    __device__ __forceinline__ void operator()(const f32x4 (&acc)[2][2][4][2], const Unit& u, int wr, int wc, int fr, int fq) const {
        const int row0 = u.pm * 256 + wr * 64 + fr, col0 = u.pn * 256 + wc * 32 + 8 * fq;
        const float la = -3.0701134573253945f, lb = -15.350567286626973f;
#pragma unroll
        for (int ai = 0; ai < 2; ++ai)
#pragma unroll
            for (int m = 0; m < 4; ++m) { const int n = row0 + ai * 128 + m * 16; const float delta = fabsf(la + (float)(n & 1023) * ((lb - la) / 1023.0f)) * (1.0f / (float)(L - 1));
                const float r1 = __expf(-delta), r2 = r1 * r1, r3 = r2 * r1;
                bf16_t* grow = GF + (size_t)n * 4352 + col0;
#pragma unroll
                for (int bj = 0; bj < 2; ++bj)
#pragma unroll
                    for (int nn = 0; nn < 2; ++nn) { const int j0 = col0 + bj * 128 + 4 * nn; const f32x4 a4 = acc[ai][bj][m][nn];
                        const float w0 = __expf(-(float)j0 * delta);
                        const float v0 = a4[0] * w0, v1 = a4[1] * (w0 * r1), v2 = a4[2] * (w0 * r2), v3 = a4[3] * (w0 * r3);
                        u32x2v w; w[0] = pk2(v0, v1); w[1] = pk2(v2, v3);
                        *(u32x2v*)(grow + bj * 128 + 4 * nn) = w;
                        if (j0 == 0) G0[n] = v0; } }

    }
};

constexpr int HY_G_ELEMS = 8336, HY_G_BYTES = HY_G_ELEMS * 2, HY_USTR = 144, HY_U_BYTES = 65 * HY_USTR, HY_CH_BYTES = HY_G_BYTES + 2 * HY_U_BYTES, HY_ZERO_OFF = 4 * HY_CH_BYTES;
static_assert(HY_ZERO_OFF + 256 <= LDS_BYTES, "lds");
static_assert(HY_CH_BYTES % 16 == 0 && HY_G_BYTES % 16 == 0, "align");
__device__ void hyu_item(const Params& p, int item, unsigned char* sm) {
    const int cb = item & 3, bt = item >> 2, b = bt / 65, tile = bt - b * 65, t0 = tile * 64;
    const int tid = ltid_w(p.wave), q = tid & 31, rg = tid >> 5, c8 = cb * 256 + q * 8, tb = t0 + 4 * rg;
    bf16_t* LT = (bf16_t*)sm;
    u32x4v x1[6], vh[6]; float okf[6];
#pragma unroll
    for (int i = 0; i < 6; ++i) { const int t2 = tb - 1 + i; okf[i] = (t2 >= 0 && t2 < L) ? 1.f : 0.f; const int t2c = t2 < 0 ? 0 : (t2 >= L ? L - 1 : t2);
        const bf16_t* row = p.big + (size_t)(b * L + t2c) * INCP + c8; x1[i] = *(const u32x4v*)(row + 1024); vh[i] = *(const u32x4v*)(row + 2048); }
    f32x4 w1[3][2], w2[3][2], b1[2], b2v[2];
#pragma unroll
    for (int h2 = 0; h2 < 2; ++h2) { b1[h2] = *(const f32x4*)(p.conv_b + 1024 + c8 + 4 * h2); b2v[h2] = *(const f32x4*)(p.conv_b + 2048 + c8 + 4 * h2);
#pragma unroll
        for (int jj = 0; jj < 3; ++jj) { w1[jj][h2] = *(const f32x4*)(p.conv_w + jj * 3072 + 1024 + c8 + 4 * h2); w2[jj][h2] = *(const f32x4*)(p.conv_w + jj * 3072 + 2048 + c8 + 4 * h2); } }
    float u[4][8];
#pragma unroll
    for (int r = 0; r < 4; ++r) { float a1[8], a2[8];
#pragma unroll
        for (int e = 0; e < 8; ++e) { a1[e] = b1[e >> 2][e & 3]; a2[e] = b2v[e >> 2][e & 3]; }
#pragma unroll
        for (int jj = 0; jj < 3; ++jj) { const int i = r + jj; const float m = okf[i];
#pragma unroll
            for (int e = 0; e < 8; ++e) { const unsigned xa = x1[i][e >> 1], xb = vh[i][e >> 1];
                const float fa = (e & 1) ? __uint_as_float(xa & 0xffff0000u) : __uint_as_float(xa << 16), fb = (e & 1) ? __uint_as_float(xb & 0xffff0000u) : __uint_as_float(xb << 16);
                a1[e] += fa * (w1[jj][e >> 2][e & 3] * m); a2[e] += fb * (w2[jj][e >> 2][e & 3] * m); } }
        const float vm = (tb + r) < L ? 1.f : 0.f;
#pragma unroll
        for (int e = 0; e < 8; ++e) u[r][e] = a1[e] * a2[e] * vm; }
#pragma unroll
    for (int e = 0; e < 8; ++e) { u32x2v w; w[0] = pk2(u[0][e], u[1][e]); w[1] = pk2(u[2][e], u[3][e]); *(u32x2v*)(LT + (q * 8 + e) * 72 + 4 * rg) = w; }
    lds_barrier();
    { const int row = tid >> 1, half = tid & 1; bf16_t* dst = p.uT + ((size_t)(cb * 256 + row) * 2 + b) * 4160 + t0 + half * 32;
#pragma unroll
      for (int i = 0; i < 4; ++i) *(u32x4v*)(dst + 8 * i) = *(const u32x4v*)(LT + row * 72 + half * 32 + 8 * i); }
    lds_barrier();
}
__device__ void hyena_group(const Params& p, int grp_, unsigned char* sm, unsigned long long& tsec) {
    unsigned long long ts0_ = PROBE_MASK ? wall_clock64() : 0ull;
    const int grp = __builtin_amdgcn_readfirstlane(grp_);
    const int tid = ltid_w(p.wave), wid = tid >> 6, lane = tid & 63, c0 = grp * 4;
    { const unsigned char* src = (const unsigned char*)(p.uT + (size_t)c0 * 2 * 4160);
      for (int idx = tid; idx < 8 * 520; idx += 512) { const int r = idx / 520, i = idx - r * 520;
          *(u32x4v*)(sm + (r >> 1) * HY_CH_BYTES + HY_G_BYTES + (r & 1) * HY_U_BYTES + (i >> 3) * HY_USTR + (i & 7) * 16) = *(const u32x4v*)(src + (size_t)idx * 16); } }
    if (tid < 36) ((unsigned*)(sm + HY_ZERO_OFF))[tid] = 0u;
    for (int i = tid; i < 4 * 113; i += 512) { const int ch = i / 113, q = i - ch * 113; const int idx = q < 49 ? q : 8272 + (q - 49);
        *(unsigned short*)(sm + ch * HY_CH_BYTES + 2 * idx) = 0; }
    for (int idx = tid; idx < 4 * 514; idx += 512) { const int ch = idx / 514, pc = idx - ch * 514, j0 = pc * 8;
        unsigned short* gb = (unsigned short*)(sm + ch * HY_CH_BYTES);
        const u32x4v f = *(const u32x4v*)(p.GF + (size_t)(c0 + ch) * 4352 + j0); u32x4v bk = *(const u32x4v*)(p.GF + (size_t)(1024 + c0 + ch) * 4352 + j0);
        if (pc == 0) bk[0] = (bk[0] & 0xffff0000u) | (pk2(p.G0[c0 + ch] + p.G0[1024 + c0 + ch], 0.f) & 0xffffu);
        *(u32x4v*)(gb + 4160 + j0) = bk;
#pragma unroll
        for (int e = 0; e < 8; ++e) if (pc != 0 || e != 0) gb[4160 - j0 - e] = (unsigned short)((e & 1) ? (f[e >> 1] >> 16) : (f[e >> 1] & 0xffffu)); }
    lds_barrier();
    HSEC(12);
    const int ch = wid >> 1, b = wid & 1, li = lane & 15, kq = lane >> 4;
    unsigned char* Ub = sm + ch * HY_CH_BYTES + HY_G_BYTES + b * HY_U_BYTES;
    const unsigned char* Zb = sm + HY_ZERO_OFF + kq * 16;
    f32x4 acc[4][5];
#pragma unroll
    for (int rb = 0; rb < 4; ++rb)
#pragma unroll
        for (int nb = 0; nb < 5; ++nb) acc[rb][nb] = (f32x4){0.f, 0.f, 0.f, 0.f};
    const unsigned shl = (li & 1) ? 16u : 0u;
    unsigned gq[5];
#pragma unroll
    for (int w = 0; w < 5; ++w) { unsigned t_ = (unsigned)(ch * HY_CH_BYTES + 4 * (((4160 + 8 * kq - li) >> 1) + w)); asm volatile("" : "+v"(t_)); gq[w] = t_; }
    PG8_LAS const unsigned char* sml = (PG8_LAS const unsigned char*)sm;
    auto gload = [&](int mp, unsigned (&e)[5]) {
#pragma unroll
        for (int w = 0; w < 5; ++w) e[w] = *(PG8_LAS const unsigned*)(sml + (gq[w] - 32 * mp));
    };
    auto gmake = [&](const unsigned (&e)[5]) -> pg8::bf16x8 {
        u32x4v r;
#pragma unroll
        for (int w = 0; w < 4; ++w) r[w] = __builtin_amdgcn_alignbit(e[w + 1], e[w], shl);
        return __builtin_bit_cast(pg8::bf16x8, r);
    };
    pg8::bf16x8 F[6];
    unsigned E[4][5];
    { unsigned e0[5], e1[5]; gload(4 * (-64) - 2, e0); gload(4 * (-64) - 1, e1); F[4] = gmake(e0); F[5] = gmake(e1); }
#pragma unroll
    for (int q = 0; q < 4; ++q) gload(4 * (-64) + q, E[q]);
    for (int d = -64; d <= 64; ++d) {
        F[0] = F[4]; F[1] = F[5];
#pragma unroll
        for (int q = 2; q < 6; ++q) F[q] = gmake(E[q - 2]);
        if (d < 64) {
#pragma unroll
            for (int q = 0; q < 4; ++q) gload(4 * (d + 1) + q, E[q]);
        }
        const int nb_lo = d > 0 ? (d >> 4) : 0, nb_hi = (d + 64) >> 4;
#pragma unroll
        for (int nb = 0; nb < 5; ++nb) {
            if (nb >= nb_lo && nb <= nb_hi) {
                const int sblk = 16 * nb + li - d;
                const unsigned char* up = ((unsigned)sblk < 65u) ? (Ub + sblk * HY_USTR + kq * 16) : Zb;
                const pg8::bf16x8 B0 = *(const pg8::bf16x8*)up, B1 = *(const pg8::bf16x8*)(up + 64);
#pragma unroll
                for (int rb = 0; rb < 4; ++rb) {
                    acc[rb][nb] = __builtin_amdgcn_mfma_f32_16x16x32_bf16(F[rb + 2], B0, acc[rb][nb], 0, 0, 0);
                    acc[rb][nb] = __builtin_amdgcn_mfma_f32_16x16x32_bf16(F[rb], B1, acc[rb][nb], 0, 0, 0);
                }
            }
        }
    }
    HSEC(13);
    {
        const float dc = p.hyena_d[c0 + ch];
#pragma unroll
        for (int nb = 0; nb < 5; ++nb) { const int t1 = 16 * nb + li;
            if (t1 < 65) {
#pragma unroll
                for (int rb = 0; rb < 4; ++rb) { unsigned char* up = Ub + t1 * HY_USTR + (16 * rb + 4 * kq) * 2;
                    const u32x2v uu = *(const u32x2v*)up; const f32x4 a = acc[rb][nb];
                    u32x2v w; w[0] = pk2(a[0] + dc * __uint_as_float(uu[0] << 16), a[1] + dc * __uint_as_float(uu[0] & 0xffff0000u));
                    w[1] = pk2(a[2] + dc * __uint_as_float(uu[1] << 16), a[3] + dc * __uint_as_float(uu[1] & 0xffff0000u));
                    *(u32x2v*)up = w; } } }
    }
    lds_barrier();
    for (int tt = tid; tt < 2 * L; tt += 512) { const int bb = tt >= L ? 1 : 0, t = tt - bb * L;
        const unsigned char* up = sm + HY_G_BYTES + bb * HY_U_BYTES + (t >> 6) * HY_USTR + (t & 63) * 2;
        const unsigned v0 = *(const unsigned short*)up, v1 = *(const unsigned short*)(up + HY_CH_BYTES), v2 = *(const unsigned short*)(up + 2 * HY_CH_BYTES), v3 = *(const unsigned short*)(up + 3 * HY_CH_BYTES);
        u32x2v w; w[0] = v0 | (v1 << 16); w[1] = v2 | (v3 << 16);
        *(u32x2v*)(p.yc + (size_t)(bb * L + t) * 1024 + c0) = w; }
    lds_barrier();
    HSEC(14);
}

constexpr int GP_QT = 0, GP_KT = 16384, GP_AM = 32768, GP_DEC = 40960, GP_STRIDE = 41472;
__device__ void gla_pre(const Params& p, int item, unsigned char* sm) {
    const int n = item % 65, bdh = item / 65, hh = bdh & 3, dir = (bdh >> 2) & 1, b = bdh >> 3;
    const int tid = ltid_w(p.wave), d = tid & 127, seg = tid >> 7, lane = tid & 63, wid = tid >> 6, li = lane & 15, kq = lane >> 4;
    float* LR = (float*)sm; float* SEGT = LR + 1024; bf16_t* QS = (bf16_t*)(sm + 8192); bf16_t* KS = QS + 64 * 136;
    unsigned char* gp = p.gp + (size_t)item * GP_STRIDE;
    { const int i = tid >> 3, r2 = (tid & 7) * 2; const int tau = dir ? 4159 - (64 * n + i) : 64 * n + i; float v0 = 0.f, v1 = 0.f;
      { const unsigned w = *(const unsigned*)(p.big + (size_t)(b * L + (tau < 48 ? 0 : tau - 48)) * INCP + C_LR + dir * 16 + r2); if (tau >= 48) { v0 = __uint_as_float(w << 16); v1 = __uint_as_float(w & 0xffff0000u); } }
      LR[i * 16 + r2] = v0; LR[i * 16 + r2 + 1] = v1; }
    float w2[16];
#pragma unroll
    for (int r = 0; r < 16; ++r) w2[r] = p.gk_w2[(size_t)(dir * 16 + r) * 512 + hh * 128 + d];
    const float b2 = p.gk_b2[dir * 512 + hh * 128 + d];
    unsigned short qraw[16], kraw[16];
#pragma unroll
    for (int ii = 0; ii < 16; ++ii) { const int i = seg * 16 + ii; const int tau = dir ? 4159 - (64 * n + i) : 64 * n + i; const int tc = tau < 48 ? 0 : tau - 48;
        const bf16_t* row = p.big + (size_t)(b * L + tc) * INCP + hh * 128 + d; qraw[ii] = row[C_Q]; kraw[ii] = row[C_K];
        if (tau < 48) { qraw[ii] = 0; kraw[ii] = 0; } }
    lds_barrier();
    float cs[16]; float run = 0.f;
#pragma unroll
    for (int ii = 0; ii < 16; ++ii) { const int i = seg * 16 + ii; const int tau = dir ? 4159 - (64 * n + i) : 64 * n + i;
        float xg = b2;
#pragma unroll
        for (int r4 = 0; r4 < 4; ++r4) { const f32x4 l4 = *(const f32x4*)(LR + i * 16 + 4 * r4); xg += l4[0] * w2[4 * r4] + l4[1] * w2[4 * r4 + 1] + l4[2] * w2[4 * r4 + 2] + l4[3] * w2[4 * r4 + 3]; }
        const float lg = tau >= 48 ? (fminf(xg, 0.f) - __logf(1.0f + __expf(-fabsf(xg)))) * (1.0f / 16.0f) : 0.f;
        run += lg; cs[ii] = run; }
    SEGT[seg * 128 + d] = run;
    lds_barrier();
    float off = 0.f, tot = 0.f;
#pragma unroll
    for (int s = 0; s < 4; ++s) { const float v = SEGT[s * 128 + d]; if (s < seg) off += v; tot += v; }
    unsigned kt[8];
#pragma unroll
    for (int ii = 0; ii < 16; ii += 2) { float kh[2];
#pragma unroll
        for (int x = 0; x < 2; ++x) { const int i = seg * 16 + ii + x; const float q = bf2f(qraw[ii + x]), k = bf2f(kraw[ii + x]);
            const float bi = off + cs[ii + x]; const bf16_t qv = f2bf(q * 0.08838834764831845f * __expf(bi));
            QS[i * 136 + d] = qv; KS[i * 136 + d] = f2bf(k * __expf(-bi)); *(bf16_t*)(gp + GP_QT + (i * 128 + d) * 2) = qv; kh[x] = k * __expf(tot - bi); }
        kt[ii >> 1] = pk2(kh[0], kh[1]); }
    { u32x4v w0, w1; w0[0] = kt[0]; w0[1] = kt[1]; w0[2] = kt[2]; w0[3] = kt[3]; w1[0] = kt[4]; w1[1] = kt[5]; w1[2] = kt[6]; w1[3] = kt[7];
      *(u32x4v*)(gp + GP_KT + (d * 64 + seg * 16) * 2) = w0; *(u32x4v*)(gp + GP_KT + (d * 64 + seg * 16 + 8) * 2) = w1; }
    if (seg == 0) *(float*)(gp + GP_DEC + d * 4) = __expf(tot);
    lds_barrier();
    { const int it = wid >> 1;
#pragma unroll
      for (int x = 0; x < 2; ++x) { const int jt = (wid & 1) * 2 + x; f32x4 acc = {0.f, 0.f, 0.f, 0.f};
#pragma unroll
          for (int ks = 0; ks < 4; ++ks) { const pg8::bf16x8 a = *(const pg8::bf16x8*)(QS + (16 * it + li) * 136 + 32 * ks + 8 * kq), bb = *(const pg8::bf16x8*)(KS + (16 * jt + li) * 136 + 32 * ks + 8 * kq);
              acc = __builtin_amdgcn_mfma_f32_16x16x32_bf16(a, bb, acc, 0, 0, 0); }
#pragma unroll
          for (int r = 0; r < 4; ++r) { const int i = 16 * it + 4 * kq + r, j = 16 * jt + li; *(bf16_t*)(gp + GP_AM + (i * 64 + j) * 2) = f2bf(j <= i ? acc[r] : 0.f); } } }
    lds_barrier();
}

__device__ void gla_scan(const Params& p, int item, unsigned char* sm, unsigned long long& tsec) {
    const int s = item & 7, bdh = item >> 3, hh = bdh & 3, dir = (bdh >> 2) & 1, b = bdh >> 3;
    const int tid = ltid_w(p.wave), lane = tid & 63, wid = tid >> 6, li = lane & 15, kq = lane >> 4;
    constexpr int O_VT = 0, SZ_VT = 32 * 72 * 2, O_ST = 2 * SZ_VT;
    float* outp = dir ? p.ob : p.of;
    const unsigned char* gbase = p.gp + (size_t)(bdh * 65) * GP_STRIDE;
    const int it = wid >> 1, eto = wid & 1;
    struct RS { u32x4v fa[2], fq[4], fk[2], v; f32x4 dec; };
    auto LOAD = [&](int n, RS& R) {
        const unsigned char* g = gbase + (size_t)n * GP_STRIDE;
#pragma unroll
        for (int ks = 0; ks < 2; ++ks) R.fa[ks] = *(const u32x4v*)(g + GP_AM + ((16 * it + li) * 64 + 32 * ks + 8 * kq) * 2);
#pragma unroll
        for (int ks = 0; ks < 4; ++ks) R.fq[ks] = *(const u32x4v*)(g + GP_QT + ((16 * it + li) * 128 + 32 * ks + 8 * kq) * 2);
#pragma unroll
        for (int ks = 0; ks < 2; ++ks) R.fk[ks] = *(const u32x4v*)(g + GP_KT + ((16 * wid + li) * 64 + 32 * ks + 8 * kq) * 2);
        R.dec = *(const f32x4*)(g + GP_DEC + (16 * wid + 4 * kq) * 4);
        const int tau = dir ? 4159 - (64 * n + lane) : 64 * n + lane;
        R.v = (u32x4v){0u, 0u, 0u, 0u};
        R.v = *(const u32x4v*)(p.big + (size_t)(b * L + (tau < 48 ? 0 : tau - 48)) * INCP + C_V + hh * 256 + s * 32 + (wid & 3) * 8);
    };
    auto PUTV = [&](int buf, const RS& R) {
        if (wid < 4) { bf16_t* vt = (bf16_t*)(sm + O_VT + buf * SZ_VT);
#pragma unroll
            for (int x = 0; x < 4; ++x) { vt[(wid * 8 + 2 * x) * 72 + lane] = (bf16_t)(R.v[x] & 0xffffu); vt[(wid * 8 + 2 * x + 1) * 72 + lane] = (bf16_t)(R.v[x] >> 16); } }
    };
    f32x4 S[2];
    S[0] = (f32x4){0.f, 0.f, 0.f, 0.f}; S[1] = S[0];
    for (int i = tid; i < 8704 / 16; i += 512) *(u32x4v*)(sm + O_ST + i * 16) = (u32x4v){0u, 0u, 0u, 0u};
    const bf16_t* ST = (const bf16_t*)(sm + O_ST);
    auto STEP = [&](int n, RS& RA, const RS& RB, RS& RC) {
        unsigned long long ts0_ = PROBE_MASK ? wall_clock64() : 0ull;
        if (n + 2 < 65) LOAD(n + 2, RC);
        const bf16_t* VT = (const bf16_t*)(sm + O_VT + (n & 1) * SZ_VT);
        { f32x4 o = {0.f, 0.f, 0.f, 0.f};
#pragma unroll
          for (int ks = 0; ks < 2; ++ks) { const pg8::bf16x8 bb = *(const pg8::bf16x8*)(VT + (16 * eto + li) * 72 + 32 * ks + 8 * kq);
              o = __builtin_amdgcn_mfma_f32_16x16x32_bf16(__builtin_bit_cast(pg8::bf16x8, RA.fa[ks]), bb, o, 0, 0, 0); }
#pragma unroll
          for (int ks = 0; ks < 4; ++ks) { const pg8::bf16x8 bb = *(const pg8::bf16x8*)(ST + (16 * eto + li) * 136 + 32 * ks + 8 * kq);
              o = __builtin_amdgcn_mfma_f32_16x16x32_bf16(__builtin_bit_cast(pg8::bf16x8, RA.fq[ks]), bb, o, 0, 0, 0); }
#pragma unroll
          for (int r = 0; r < 4; ++r) { const int i = 16 * it + 4 * kq + r; const int tau = dir ? 4159 - (64 * n + i) : 64 * n + i;
              float* dst = tau >= 48 ? outp + (size_t)(b * L + tau - 48) * 1024 + hh * 256 + s * 32 + 16 * eto + li : p.dummy + tid;
              *dst = o[r]; } }
#pragma unroll
        for (int et = 0; et < 2; ++et) { S[et] *= RA.dec;
#pragma unroll
            for (int ks = 0; ks < 2; ++ks) { const pg8::bf16x8 bb = *(const pg8::bf16x8*)(VT + (16 * et + li) * 72 + 32 * ks + 8 * kq);
                S[et] = __builtin_amdgcn_mfma_f32_16x16x32_bf16(__builtin_bit_cast(pg8::bf16x8, RA.fk[ks]), bb, S[et], 0, 0, 0); } }
        HSEC(25);
        lds_barrier();
        HSEC(26);
#pragma unroll
        for (int et = 0; et < 2; ++et) { u32x2v w; w[0] = pk2(S[et][0], S[et][1]); w[1] = pk2(S[et][2], S[et][3]);
            *(u32x2v*)(sm + O_ST + ((16 * et + li) * 136 + 16 * wid + 4 * kq) * 2) = w; }
        if (n + 1 < 65) PUTV((n + 1) & 1, RB);
        lds_barrier();
        HSEC(27);
    };
    RS R0, R1, R2;
    LOAD(0, R0); LOAD(1, R1);
    PUTV(0, R0);
    lds_barrier();
    for (int n = 0; n < 63; n += 3) { STEP(n, R0, R1, R2); STEP(n + 1, R1, R2, R0); STEP(n + 2, R2, R0, R1); }
    STEP(63, R0, R1, R2); STEP(64, R1, R2, R0);
}

__device__ void fin_item(const Params& p, int item) {
    const int tid__ = ltid_w(p.wave), wid = tid__ >> 6, lane = tid__ & 63, m = item * 8 + wid;
    bf16_t* yrow = p.y + (size_t)m * D;
    if (m >= M) { const u32x4v z = {0u, 0u, 0u, 0u};
#pragma unroll
        for (int i = 0; i < 4; ++i) *(u32x4v*)(yrow + (lane + 64 * i) * 8) = z;
        return; }
    const int c0 = lane * 16;
    {
      const int b = m >= L ? 1 : 0, t = m - b * L;
      float x0[16];
#pragma unroll
      for (int i = 0; i < 4; ++i) { const f32x4 cb = *(const f32x4*)(p.conv_b + c0 + 4 * i); x0[4 * i] = cb[0]; x0[4 * i + 1] = cb[1]; x0[4 * i + 2] = cb[2]; x0[4 * i + 3] = cb[3]; }
#pragma unroll
      for (int jj = 0; jj < 3; ++jj) { const int t2 = t + jj - 1; const bool ok = t2 >= 0 && t2 < L; const int t2c = t2 < 0 ? 0 : (t2 >= L ? L - 1 : t2);
          { const bf16_t* row = p.big + (size_t)(b * L + t2c) * INCP + c0; const u32x4v r0 = *(const u32x4v*)row, r1 = *(const u32x4v*)(row + 8); const float okf = ok ? 1.f : 0.f;
#pragma unroll
              for (int i = 0; i < 4; ++i) { const f32x4 cw = *(const f32x4*)(p.conv_w + jj * 3072 + c0 + 4 * i) * okf; const unsigned lo = i < 2 ? r0[2 * i] : r1[2 * i - 4], hi = i < 2 ? r0[2 * i + 1] : r1[2 * i - 3];
                  x0[4 * i] += __uint_as_float(lo << 16) * cw[0]; x0[4 * i + 1] += __uint_as_float(lo & 0xffff0000u) * cw[1]; x0[4 * i + 2] += __uint_as_float(hi << 16) * cw[2]; x0[4 * i + 3] += __uint_as_float(hi & 0xffff0000u) * cw[3]; } } }
      const bf16_t* src = p.yc + (size_t)m * 1024 + c0; const u32x4v y0 = *(const u32x4v*)src, y1 = *(const u32x4v*)(src + 8);
      f32x4 v[4]; float ss = 0.f;
#pragma unroll
      for (int i = 0; i < 4; ++i) { const unsigned lo = i < 2 ? y0[2 * i] : y1[2 * i - 4], hi = i < 2 ? y0[2 * i + 1] : y1[2 * i - 3];
          v[i][0] = __uint_as_float(lo << 16) * x0[4 * i]; v[i][1] = __uint_as_float(lo & 0xffff0000u) * x0[4 * i + 1]; v[i][2] = __uint_as_float(hi << 16) * x0[4 * i + 2]; v[i][3] = __uint_as_float(hi & 0xffff0000u) * x0[4 * i + 3];
          ss += (v[i][0] * v[i][0] + v[i][1] * v[i][1]) + (v[i][2] * v[i][2] + v[i][3] * v[i][3]); }
      ss += shx<1>(ss); ss += shx<2>(ss); ss += shx<4>(ss);
      const float r = rsqrtf(ss * (1.0f / 128.0f) + EPS);
      u32x4v w0, w1;
#pragma unroll
      for (int i = 0; i < 4; ++i) { const f32x4 g = *(const f32x4*)(p.hyena_norm + c0 + 4 * i); const f32x4 o = v[i] * r * g;
          if (i < 2) { w0[2 * i] = pk2(o[0], o[1]); w0[2 * i + 1] = pk2(o[2], o[3]); } else { w1[2 * i - 4] = pk2(o[0], o[1]); w1[2 * i - 3] = pk2(o[2], o[3]); } }
      *(u32x4v*)(yrow + c0) = w0; *(u32x4v*)(yrow + c0 + 8) = w1; }
    { const float* s1 = p.of + (size_t)m * 1024 + c0; const float* s2 = p.ob + (size_t)m * 1024 + c0; f32x4 v[4]; float ss = 0.f;
#pragma unroll
      for (int i = 0; i < 4; ++i) { v[i] = *(const f32x4*)(s1 + 4 * i) + *(const f32x4*)(s2 + 4 * i); ss += (v[i][0] * v[i][0] + v[i][1] * v[i][1]) + (v[i][2] * v[i][2] + v[i][3] * v[i][3]); }
      ss += shx<1>(ss); ss += shx<2>(ss); ss += shx<4>(ss); ss += shx<8>(ss);
      const float r = rsqrtf(ss * (1.0f / 256.0f) + EPS);
      const bf16_t* og = p.big + (size_t)m * INCP + C_OG + c0;
      const u32x4v g0 = *(const u32x4v*)og, g1 = *(const u32x4v*)(og + 8);
      float ogf[16];
#pragma unroll
      for (int i = 0; i < 4; ++i) { ogf[2 * i] = __uint_as_float(g0[i] << 16); ogf[2 * i + 1] = __uint_as_float(g0[i] & 0xffff0000u); ogf[8 + 2 * i] = __uint_as_float(g1[i] << 16); ogf[8 + 2 * i + 1] = __uint_as_float(g1[i] & 0xffff0000u); }
      u32x4v w0, w1;
#pragma unroll
      for (int i = 0; i < 4; ++i) { const f32x4 g = *(const f32x4*)(p.gla_norm + ((c0 + 4 * i) & 255)); f32x4 o = v[i] * r * g;
          o[0] *= silu_f(ogf[4 * i]); o[1] *= silu_f(ogf[4 * i + 1]); o[2] *= silu_f(ogf[4 * i + 2]); o[3] *= silu_f(ogf[4 * i + 3]);
          if (i < 2) { w0[2 * i] = pk2(o[0], o[1]); w0[2 * i + 1] = pk2(o[2], o[3]); } else { w1[2 * i - 4] = pk2(o[0], o[1]); w1[2 * i - 3] = pk2(o[2], o[3]); } }
      *(u32x4v*)(yrow + 1024 + c0) = w0; *(u32x4v*)(yrow + 1024 + c0 + 8) = w1; }
}

__device__ void final_item(const Params& p, int item) {
    const int tid__ = ltid_w(p.wave), wid = tid__ >> 6, lane = tid__ & 63, row = item * 8 + wid, b = row >> 12, s = row & 4095, m = b * L + NMETA + s;
    const float* hrow = p.h + (size_t)m * D; float* orow = p.out + (size_t)row * D; f32x4 v[8]; float ss = 0.f;
#pragma unroll
    for (int i = 0; i < 8; ++i) { v[i] = *(const f32x4*)(hrow + (lane + 64 * i) * 4); ss += (v[i][0] * v[i][0] + v[i][1] * v[i][1]) + (v[i][2] * v[i][2] + v[i][3] * v[i][3]); }
    ss = wave_sum(ss); const float r = rsqrtf(ss * (1.0f / D) + EPS);
#pragma unroll
    for (int i = 0; i < 8; ++i) { const int c = (lane + 64 * i) * 4; *(f32x4*)(orow + c) = v[i] * r * *(const f32x4*)(p.final_norm + c); }
}

template <class TEpi> __device__ __forceinline__ void tail_tile(const bf16_t* A, int arow0, const bf16_t* Bt, int brow0, int brow1, const int K, float* red, const TEpi& E, int c, const int wave) {
    const int tid = ltid_w(wave), wid = tid >> 6, lane = tid & 63, li = lane & 15, kq = lane >> 4;
    const int kw = K >> 3, k0 = wid * kw;
    const bf16_t* ap = A + (size_t)(arow0 + li) * K + k0 + 8 * kq;
    const bf16_t* bp0 = Bt + (size_t)(brow0 + li) * K + k0 + 8 * kq;
    const bf16_t* bp1 = Bt + (size_t)(brow1 + li) * K + k0 + 8 * kq;
    f32x4 acc[2][4];
#pragma unroll
    for (int x = 0; x < 2; ++x)
#pragma unroll
        for (int y = 0; y < 4; ++y) acc[x][y] = (f32x4){0.f, 0.f, 0.f, 0.f};
#pragma unroll 6
    for (int k = 0; k < kw; k += 32) {
        pg8::bf16x8 a[2], bfr[4];
        a[0] = *(const pg8::bf16x8*)(ap + k); a[1] = *(const pg8::bf16x8*)(ap + (size_t)16 * K + k);
        bfr[0] = *(const pg8::bf16x8*)(bp0 + k); bfr[1] = *(const pg8::bf16x8*)(bp0 + (size_t)16 * K + k);
        bfr[2] = *(const pg8::bf16x8*)(bp1 + k); bfr[3] = *(const pg8::bf16x8*)(bp1 + (size_t)16 * K + k);
#pragma unroll
        for (int x = 0; x < 2; ++x)
#pragma unroll
            for (int y = 0; y < 4; ++y) acc[x][y] = __builtin_amdgcn_mfma_f32_16x16x32_bf16(bfr[y], a[x], acc[x][y], 0, 0, 0);
    }
#pragma unroll
    for (int x = 0; x < 2; ++x)
#pragma unroll
        for (int y = 0; y < 4; ++y) *(f32x4*)(red + wid * 2048 + (16 * x + li) * 64 + 16 * y + 4 * kq) = acc[x][y];
    lds_barrier();
    { const int row = tid >> 4, col4 = (tid & 15) * 4; f32x4 v = {0.f, 0.f, 0.f, 0.f};
#pragma unroll
      for (int w = 0; w < 8; ++w) v += *(const f32x4*)(red + w * 2048 + row * 64 + col4);
      E(arow0 + row, c, col4, v); }
    lds_barrier();
}
struct TEpiResid {
    float* H; bf16_t* HB; float* rowss; float scale;
    __device__ __forceinline__ void operator()(int r, int c, int col4, f32x4 v) const {
        float* hp = H + (size_t)r * D + c * 64 + col4; f32x4 a = *(const f32x4*)hp; a += v * scale; *(f32x4*)hp = a;
        float ss = (a[0] * a[0] + a[1] * a[1]) + (a[2] * a[2] + a[3] * a[3]);
        ss += shx<1>(ss); ss += shx<2>(ss); ss += shx<4>(ss); ss += shx<8>(ss);
        if (HB) { u32x2v w; w[0] = pk2(a[0], a[1]); w[1] = pk2(a[2], a[3]); *(u32x2v*)(HB + (size_t)r * D + c * 64 + col4) = w; }
        if (rowss && (lane_id() & 15) == 0) rowss[(size_t)r * 32 + c] = ss;
    }
};
struct TEpiScale {
    bf16_t* O; int ldc; const float* rowss;
    __device__ __forceinline__ void operator()(int r, int c, int col4, f32x4 v) const {
        const int l = lane_id() & 15; float s = rowss[(size_t)r * 32 + 2 * l] + rowss[(size_t)r * 32 + 2 * l + 1];
        s += shx<1>(s); s += shx<2>(s); s += shx<4>(s); s += shx<8>(s);
        const float rs = rsqrtf(s * (1.0f / D) + EPS);
        u32x2v w; w[0] = pk2(v[0] * rs, v[1] * rs); w[1] = pk2(v[2] * rs, v[3] * rs); *(u32x2v*)(O + (size_t)r * ldc + c * 64 + col4) = w;
    }
};

#define run_gemm(...) run_gemm_(__VA_ARGS__, p.wave)
template <class Epi> __device__ __forceinline__ void run_gemm_(PG8_LAS unsigned char* lds, const bf16_t* A, const bf16_t* Bt, int Mr, int N, int K, const Epi& E, const int wave) {
    pg8::Gemm g; g.A = A; g.Bt = Bt; g.M = Mr; g.N = N; g.K = K;
    pg8::StaticOrder S; S.init(Mr, N, (int)gridDim.x, (int)blockIdx.x);
    pg8::gemm_phase<Epi, pg8::StaticOrder>(lds, g, S, E, ltid_w(wave));
}

__device__ __forceinline__ void gbar(const __attribute__((address_space(4))) Params* kp, int wave, int k) {
    __syncthreads();
    if (ltid_w(wave) == 0) {
        unsigned* bar = kp->bar; const unsigned target = (unsigned)k * gridDim.x;
        __threadfence();
        __hip_atomic_fetch_add(bar, 1u, __ATOMIC_RELEASE, __HIP_MEMORY_SCOPE_AGENT);
        while (__hip_atomic_load(bar, __ATOMIC_RELAXED, __HIP_MEMORY_SCOPE_AGENT) < target) __builtin_amdgcn_s_sleep(1);
        __threadfence();
    }
    __syncthreads();
}
typedef const __attribute__((address_space(4))) Params* KParams;
#if defined(__HIP_DEVICE_COMPILE__)
#define LOADP() Params p; { KParams q_ = kp; asm volatile("" : "+s"(q_)); p = *q_; p.wave = wave_s; }
#else
#define LOADP() Params p = p_unused; p.wave = wave_s; (void)kp;
#endif
#define PSEC(i, stmt) do { unsigned long long a_ = PROBE_MASK ? wall_clock64() : 0ull; stmt; if (PROBE_MASK && ((PROBE_MASK >> (i)) & 1u)) t_acc += wall_clock64() - a_; } while (0)
#define MARK(i) do { if (PROBE_MASK) { const unsigned long long t_ = wall_clock64(); if ((PROBE_MASK >> (i)) & 1u) t_acc += t_ - t_last; t_last = t_; } } while (0)
__global__ __launch_bounds__(512, 2) void mega(Params p_unused) {
    KParams kp = (KParams)__builtin_amdgcn_kernarg_segment_ptr();
    const int wave_s = __builtin_amdgcn_readfirstlane((int)(threadIdx.x >> 6));
    unsigned long long t_acc = 0ull, t_last = PROBE_MASK ? wall_clock64() : 0ull;
    extern __shared__ __attribute__((aligned(16))) unsigned char smem[];
    cg::grid_group grid = cg::this_grid();
    PG8_LAS unsigned char* lds = (PG8_LAS unsigned char*)smem;
    float* smf = (float*)smem;
    const int G = gridDim.x, bid = blockIdx.x;
    { LOADP();
      transpose_mat(p.ffn1_wg, p.Wgu1, p.ffn1_norm, D, DFF, DFF, DFF, 1, smf, p.wave);
      transpose_mat(p.ffn1_wu, p.Wgu1, p.ffn1_norm, D, DFF, DFF, DFF, 2, smf, p.wave);
      transpose_mat(p.ffn1_wd, p.Wd1, nullptr, DFF, D, D, D, 0, smf, p.wave); }
    { LOADP();
      transpose_mat(p.w_in, p.Win, p.mix_norm, D, INCP, INC, INC, 0, smf, p.wave);
      transpose_mat(p.w_out, p.Wout, nullptr, D, D, D, D, 0, smf, p.wave); }
    { LOADP();
      transpose_mat(p.ffn2_wg, p.Wgu2, p.ffn2_norm, D, DFF, DFF, DFF, 1, smf, p.wave);
      transpose_mat(p.ffn2_wu, p.Wgu2, p.ffn2_norm, D, DFF, DFF, DFF, 2, smf, p.wave);
      transpose_mat(p.ffn2_wd, p.Wd2, nullptr, DFF, D, D, D, 0, smf, p.wave); }
    { LOADP();
      if (bid == 0 && ltid_w(p.wave) == 0) *p.ctr = 0u;
      wb_items(p);
      for (int it = bid; it < NT_ROWS + NT_Z2; it += G) { if (it < NT_ROWS) row_item(p, it); else z2_item(p, it - NT_ROWS); } }
    grid.sync(); MARK(0);
    { LOADP(); EpiSwiglu E; E.O = p.big; E.rowss = p.rowss; run_gemm(lds, p.hb, p.Wgu1, MP, 2 * DFF, D, E); }
    gbar(kp, wave_s, 1); MARK(1);
    { LOADP(); EpiResid<true> E; E.H = p.h; E.HB = p.hb; E.rowss = p.rowss; E.scale = 0.5f; run_gemm(lds, p.big, p.Wd1, 8192, D, DFF, E); }
    { LOADP(); TEpiResid T; T.H = p.h; T.HB = p.hb; T.rowss = p.rowss; T.scale = 0.5f;
      for (int c = bid; c < 32; c += G) PSEC(24, tail_tile(p.big, 8192, p.Wd1, 64 * c, 64 * c + 32, DFF, smf, T, c, p.wave)); }
    gbar(kp, wave_s, 2); MARK(2);
    { LOADP(); EpiScale E; E.O = p.big; E.ldc = INCP; E.rowss = p.rowss; run_gemm(lds, p.hb, p.Win, 8192, 6144, D, E); }
    { LOADP(); TEpiScale T; T.O = p.big; T.ldc = INCP; T.rowss = p.rowss;
      for (int it = bid; it < 97 + 256; it += G) { if (it < 97) tail_tile(p.hb, 8192, p.Win, 64 * it, 64 * it + 32, D, smf, T, it, p.wave); else tail_tile(p.hb, 32 * (it - 97), p.Win, 6144, 6176, D, smf, T, 96, p.wave); } }
    gbar(kp, wave_s, 3); MARK(3);
    { LOADP(); EpiFilt E; E.GF = p.GF; E.G0 = p.G0; PSEC(20, run_gemm(lds, p.WB, p.ZA, 2048, 4352, 256, E)); }
    { LOADP(); for (int it = bid; it < 1040 + 520; it += G) { if (it < 1040) PSEC(21, gla_pre(p, it, smem)); else PSEC(22, hyu_item(p, it - 1040, smem)); } }
    gbar(kp, wave_s, 4); MARK(4);
    { LOADP(); if (bid < 128) PSEC(23, gla_scan(p, ((((bid & 7) | (((bid >> 3) & 1) << 3)) << 3) | (bid >> 4)), smem, t_acc)); }
    if (bid >= 128) { LOADP();
      for (;;) {
        if (ltid_w(p.wave) == 0) *(int*)(smem + HY_ZERO_OFF + 192) = (int)atomicAdd(p.ctr, 1u);
        lds_barrier();
        const int g = *(const int*)(smem + HY_ZERO_OFF + 192);
        lds_barrier();
        if (g >= 256) break;
        hyena_group(p, (g & 7) * 32 + (g >> 3), smem, t_acc);
      } }
    gbar(kp, wave_s, 5); MARK(5);
    { LOADP(); for (int it = bid; it < MP / 8; it += G) fin_item(p, it); }
    gbar(kp, wave_s, 6); MARK(6);
    { LOADP(); EpiResid<true> E; E.H = p.h; E.HB = p.hb; E.rowss = p.rowss; E.scale = 1.0f; run_gemm(lds, p.y, p.Wout, 8192, D, D, E); }
    { LOADP(); TEpiResid T; T.H = p.h; T.HB = p.hb; T.rowss = p.rowss; T.scale = 1.0f;
      for (int c = bid; c < 32; c += G) tail_tile(p.y, 8192, p.Wout, 64 * c, 64 * c + 32, D, smf, T, c, p.wave); }
    gbar(kp, wave_s, 7); MARK(7);
    { LOADP(); EpiSwiglu E; E.O = p.big; E.rowss = p.rowss; run_gemm(lds, p.hb, p.Wgu2, MP, 2 * DFF, D, E); }
    gbar(kp, wave_s, 8); MARK(8);
    { LOADP(); EpiResid<false> E; E.H = p.h; E.HB = nullptr; E.rowss = nullptr; E.scale = 0.5f; run_gemm(lds, p.big, p.Wd2, 8192, D, DFF, E); }
    { LOADP(); TEpiResid T; T.H = p.h; T.HB = nullptr; T.rowss = nullptr; T.scale = 0.5f;
      for (int c = bid; c < 32; c += G) tail_tile(p.big, 8192, p.Wd2, 64 * c, 64 * c + 32, DFF, smf, T, c, p.wave); }
    gbar(kp, wave_s, 9); MARK(9);
    { LOADP(); for (int it = bid; it < 1024; it += G) final_item(p, it); }
    MARK(10);
    if (PROBE_MASK && bid == 0) { const unsigned long long t0_ = wall_clock64(); while (wall_clock64() - t0_ < (unsigned long long)PROBE_K * t_acc) __builtin_amdgcn_s_sleep(8); }
}

extern "C" void kernel_launch(void* const* d_in, const int* in_sizes, int n_in, void* d_out, int out_size, void* d_ws, size_t ws_size, hipStream_t stream) {
    static int grid_blocks = 0;
    if (!grid_blocks) {
        (void)hipFuncSetAttribute((const void*)mega, hipFuncAttributeMaxDynamicSharedMemorySize, LDS_BYTES);
        int dev = 0, cus = 0, per_cu = 0;
        (void)hipGetDevice(&dev);
        (void)hipDeviceGetAttribute(&cus, hipDeviceAttributeMultiprocessorCount, dev);
        (void)hipOccupancyMaxActiveBlocksPerMultiprocessor(&per_cu, mega, 512, LDS_BYTES);
        if (per_cu > 1) per_cu = 1;
        if (per_cu < 1) { fprintf(stderr, "occupancy query returned %d\n", per_cu); per_cu = 1; }
        grid_blocks = cus * per_cu;
    }
    Params p{};
    const float* const* in = (const float* const*)d_in;
    p.x = in[0]; p.meta = in[1]; p.ffn1_norm = in[2]; p.ffn1_wg = in[3]; p.ffn1_wu = in[4]; p.ffn1_wd = in[5]; p.mix_norm = in[6]; p.w_in = in[7];
    p.conv_w = in[8]; p.conv_b = in[9]; p.filt_w1 = in[10]; p.filt_b1 = in[11]; p.filt_w2 = in[12]; p.filt_b2 = in[13]; p.filt_w3 = in[14]; p.filt_freq = in[15];
    p.hyena_d = in[16]; p.hyena_norm = in[17]; p.gk_w2 = in[18]; p.gk_b2 = in[19]; p.gla_norm = in[20]; p.w_out = in[21];
    p.ffn2_norm = in[22]; p.ffn2_wg = in[23]; p.ffn2_wu = in[24]; p.ffn2_wd = in[25]; p.final_norm = in[26];
    p.out = (float*)d_out;
    unsigned char* ws = (unsigned char*)d_ws;
    constexpr size_t SZ_WGU = (size_t)2 * DFF * D * 2, SZ_WD = (size_t)D * DFF * 2, SZ_WIN = (size_t)INCP * D * 2, SZ_WOUT = (size_t)D * D * 2;
    constexpr size_t SZ_H = (size_t)MP * D * 4, SZ_HB = (size_t)MP * D * 2, SZ_BIG = (size_t)MP * INCP * 2, SZ_RS = (size_t)MP * 32 * 4, SZ_Z2 = (size_t)L * 64 * 4;
    size_t o = 0;
    p.Wgu1 = (bf16_t*)(ws + o); o += SZ_WGU; p.Wd1 = (bf16_t*)(ws + o); o += SZ_WD; p.Win = (bf16_t*)(ws + o); o += SZ_WIN; p.Wout = (bf16_t*)(ws + o); o += SZ_WOUT;
    p.Wgu2 = (bf16_t*)(ws + o); o += SZ_WGU; p.Wd2 = (bf16_t*)(ws + o); o += SZ_WD;
    p.h = (float*)(ws + o); o += SZ_H; p.hb = (bf16_t*)(ws + o); o += SZ_HB; p.big = (bf16_t*)(ws + o); o += SZ_BIG; p.rowss = (float*)(ws + o); o += SZ_RS; p.z2 = (float*)(ws + o); o += SZ_Z2; p.ctr = (unsigned*)(ws + o); o += 256; p.ZA = (bf16_t*)(ws + o); o += (size_t)4352 * 256 * 2; p.WB = (bf16_t*)(ws + o); o += (size_t)2048 * 256 * 2; p.G0 = (float*)(ws + o); o += 2048 * 4; p.bar = (unsigned*)(ws + o); o += 256; p.dummy = (float*)(ws + o); o += 4096;
    p.yc = (bf16_t*)ws; p.y = (bf16_t*)(ws + (size_t)M * 1024 * 2); p.of = (float*)p.hb; p.ob = (float*)d_out; p.gp = ws + (size_t)M * 1024 * 2; p.GF = p.Win; p.uT = (bf16_t*)((unsigned char*)d_out + (size_t)M * 1024 * 4);
    if (o > ws_size) fprintf(stderr, "workspace too small: need %zu have %zu\n", o, ws_size);
    (void)hipMemsetAsync(p.bar, 0, 256, stream);
    void* args[] = {&p};
    hipError_t e = hipLaunchCooperativeKernel((void*)mega, dim3(grid_blocks), dim3(512), args, LDS_BYTES, stream);
    if (e != hipSuccess) fprintf(stderr, "cooperative launch failed: %s (grid %d)\n", hipGetErrorString(e), grid_blocks);
}
```

```cpp
#include <hip/hip_runtime.h>
#include <hip/hip_cooperative_groups.h>
#include <cstdio>
namespace cg = cooperative_groups;
namespace pg8 {
#define PG8_LAS __attribute__((address_space(3)))
typedef unsigned short bf16_t;
typedef short bf16x8 __attribute__((ext_vector_type(8)));
typedef float f32x4 __attribute__((ext_vector_type(4)));
typedef unsigned u32x4 __attribute__((ext_vector_type(4)));
constexpr int BM = 256, BK = 64, HALF = 128, HTB = HALF * BK * 2  , STAGE_BYTES = 8 * HTB, NXCD = 8, WGM = 8;

__host__ __device__ __forceinline__ int lds_byte(int r, int c) { const int st = (r >> 4) * 2 + (c >> 5), rr = r & 15, cc = c & 31, ob = rr * 64 + cc * 2; return st * 1024 + (ob ^ (((ob >> 9) & 1) << 5)); }
__host__ __device__ __forceinline__ void stage_rc(int b, int& R, int& C) { const int st = b / 1024, sb = b % 1024, swz = sb ^ (((sb >> 9) & 1) << 5); R = (st >> 1) * 16 + swz / 64; C = (st & 1) * 32 + (swz % 64) / 2; }
__host__ __device__ __forceinline__ int perm32(int rho) { const int n = rho >> 4, i = rho & 15; return 8 * (i >> 2) + 4 * n + (i & 3); }

struct Unit { int pm, pn; };
struct Gemm { const bf16_t* A; const bf16_t* Bt; int M, N, K; };

struct StaticOrder {
    int nM, nN, nwg, G, c;
    __host__ __device__ void init(int M, int N, int G_, int c_) { nM = M / BM; nN = N / BM; nwg = nM * nN; G = G_; c = c_; }
    __host__ __device__ bool next(int i, Unit& u) const {
        const long L = (long)i * G + c; if (L >= nwg) return false;
        int wgid = (int)L; { const int q = nwg / NXCD, r = nwg % NXCD, xcd = wgid % NXCD, off = wgid / NXCD; wgid = (xcd < r ? xcd * (q + 1) : r * (q + 1) + (xcd - r) * q) + off; }
        const int nig = WGM * nN, gid = wgid / nig, fm = gid * WGM, gsz = (nM - fm) < WGM ? (nM - fm) : WGM;
        u.pm = fm + ((wgid % nig) % gsz); u.pn = (wgid % nig) / gsz; return true;
    }
    __device__ __forceinline__ void a_ready(const Unit&) const {}
    __device__ __forceinline__ void done(const Unit&) const {}
};
__device__ __forceinline__ unsigned cvt_pk_bf16(float lo, float hi) { unsigned r; asm volatile("v_cvt_pk_bf16_f32 %0, %1, %2" : "=v"(r) : "v"(lo), "v"(hi)); return r; }
template <class Epi, class Sched>
__device__ __forceinline__ void gemm_phase(PG8_LAS unsigned char* lds, const Gemm g, const Sched& S, const Epi& E, const int tid_in) {
    const int tid = tid_in, wid = __builtin_amdgcn_readfirstlane(tid >> 6), lane = tid & 63, wr = wid >> 2, wc = wid & 3, fr = lane & 15, fq = lane >> 4;
    const int K = g.K, nt = K / BK;
    unsigned voffA[2], voffB[2];
#pragma unroll
    for (int i = 0; i < 2; ++i) { int R, C; stage_rc(tid * 16 + i * 8192, R, C); const int Rb = Epi::PERM ? ((R & ~31) + perm32(R & 31)) : R;
        voffA[i] = (unsigned)(R * K + C) * 2u; voffB[i] = (unsigned)(Rb * K + C) * 2u; }
    const size_t kstep = (size_t)(BK * 2);
    const size_t hstep = (size_t)HALF * K * 2;
    const size_t tstep = 2 * hstep;
    const unsigned ldsw = (unsigned)wid * 1024u;
    const int aoff = lds_byte(wr * 64 + fr, fq * 8), boff = lds_byte(wc * 32 + fr, fq * 8);
#define PG8_SA(b, h) (((b) * 2 + (h)) * HTB)
#define PG8_SB(b, h) ((4 + (b) * 2 + (h)) * HTB)
#define PG8_STAGE(bufoff, gbase, voff) do { _Pragma("unroll") for (int _i = 0; _i < 2; ++_i) \
        __builtin_amdgcn_global_load_lds((const unsigned*)((const char*)(gbase) + (voff)[_i]), (PG8_LAS unsigned*)(lds + (bufoff) + ldsw + _i * 8192), 16, 0, 0); } while (0)
#define PG8_LDA(dst, b, h) do { _Pragma("unroll") for (int m = 0; m < 4; ++m) _Pragma("unroll") for (int k = 0; k < 2; ++k) dst[m][k] = *(const PG8_LAS bf16x8*)(lds + PG8_SA(b, h) + aoff + m * 2048 + k * 1024); } while (0)
#define PG8_LDB(dst, b, h) do { _Pragma("unroll") for (int n = 0; n < 2; ++n) _Pragma("unroll") for (int k = 0; k < 2; ++k) dst[n][k] = *(const PG8_LAS bf16x8*)(lds + PG8_SB(b, h) + boff + n * 2048 + k * 1024); } while (0)
#define PG8_MMA(ai, bj, At, Bt) do { __builtin_amdgcn_s_setprio(1); _Pragma("unroll") for (int m = 0; m < 4; ++m) _Pragma("unroll") for (int n = 0; n < 2; ++n) _Pragma("unroll") for (int k = 0; k < 2; ++k) \
        acc[ai][bj][m][n] = __builtin_amdgcn_mfma_f32_16x16x32_bf16(Bt[n][k], At[m][k], acc[ai][bj][m][n], 0, 0, 0); __builtin_amdgcn_s_setprio(0); } while (0)
#define PG8_WAIT_V(n) asm volatile("s_waitcnt vmcnt(" #n ")" ::: "memory")
#define PG8_WAIT_L(n) asm volatile("s_waitcnt lgkmcnt(" #n ")" ::: "memory")
#define PG8_BAR __builtin_amdgcn_s_barrier()
#define PG8_SCHED __builtin_amdgcn_sched_barrier(0)
    Unit cur, nxt; int ui = 0;
    if (!S.next(0, cur)) return;
    f32x4 acc[2][2][4][2];
#pragma unroll
    for (int a = 0; a < 2; ++a)
#pragma unroll
        for (int b = 0; b < 2; ++b)
#pragma unroll
            for (int m = 0; m < 4; ++m)
#pragma unroll
                for (int n = 0; n < 2; ++n) acc[a][b][m][n] = (f32x4){0.f, 0.f, 0.f, 0.f};
    bf16x8 At[4][2], B0[2][2], B1[2][2];
    const char* cA = (const char*)g.A + (size_t)cur.pm * tstep; const char* cB = (const char*)g.Bt + (size_t)cur.pn * tstep;
    S.a_ready(cur);
    PG8_STAGE(PG8_SB(0, 0), cB, voffB); PG8_STAGE(PG8_SA(0, 0), cA, voffA); PG8_STAGE(PG8_SB(0, 1), cB + hstep, voffB); PG8_STAGE(PG8_SA(0, 1), cA + hstep, voffA);
    if (wr == 1) PG8_BAR;
    PG8_WAIT_V(4); PG8_BAR;
    PG8_STAGE(PG8_SB(1, 0), cB + kstep, voffB); PG8_STAGE(PG8_SA(1, 0), cA + kstep, voffA); PG8_STAGE(PG8_SB(1, 1), cB + hstep + kstep, voffB);
    PG8_WAIT_V(6); PG8_BAR;
    for (;;) {
        const bool has_next = S.next(ui + 1, nxt);
        const char* nA = has_next ? (const char*)g.A + (size_t)nxt.pm * tstep : cA; const char* nB = has_next ? (const char*)g.Bt + (size_t)nxt.pn * tstep : cB;
        for (int t = 0; t < nt; t += 2) {
            const bool last = (t == nt - 2);
            const char* a1 = cA + (size_t)(t + 1) * kstep;
            const char* a2 = last ? nA : cA + (size_t)(t + 2) * kstep; const char* b2 = last ? nB : cB + (size_t)(t + 2) * kstep;
            const char* a3 = a2 + kstep; const char* b3 = b2 + kstep;
            if (last && has_next) S.a_ready(nxt);
            PG8_LDB(B0, 0, 0); PG8_SCHED; PG8_LDA(At, 0, 0); PG8_STAGE(PG8_SA(1, 1), a1 + hstep, voffA);
            PG8_WAIT_L(8); PG8_BAR; PG8_WAIT_L(0); PG8_MMA(0, 0, At, B0); PG8_BAR; PG8_SCHED;
            PG8_LDB(B1, 0, 1); PG8_STAGE(PG8_SB(0, 0), b2, voffB);
            PG8_BAR; PG8_WAIT_L(0); PG8_MMA(0, 1, At, B1); PG8_BAR;
            PG8_LDA(At, 0, 1); PG8_STAGE(PG8_SA(0, 0), a2, voffA);
            PG8_BAR; PG8_WAIT_L(0); PG8_MMA(1, 0, At, B0); PG8_BAR; PG8_SCHED;
            PG8_STAGE(PG8_SB(0, 1), b2 + hstep, voffB);
            PG8_WAIT_V(6); PG8_BAR; PG8_MMA(1, 1, At, B1); PG8_BAR;
            PG8_LDB(B0, 1, 0); PG8_SCHED; PG8_LDA(At, 1, 0); PG8_STAGE(PG8_SA(0, 1), a2 + hstep, voffA);
            PG8_WAIT_L(8); PG8_BAR; PG8_WAIT_L(0); PG8_MMA(0, 0, At, B0); PG8_BAR; PG8_SCHED;
            PG8_LDB(B1, 1, 1); PG8_STAGE(PG8_SB(1, 0), b3, voffB);
            PG8_BAR; PG8_WAIT_L(0); PG8_MMA(0, 1, At, B1); PG8_BAR;
            PG8_LDA(At, 1, 1); PG8_STAGE(PG8_SA(1, 0), a3, voffA);
            PG8_BAR; PG8_WAIT_L(0); PG8_MMA(1, 0, At, B0); PG8_BAR; PG8_SCHED;
            PG8_STAGE(PG8_SB(1, 1), b3 + hstep, voffB);
            PG8_WAIT_V(6); PG8_BAR; PG8_MMA(1, 1, At, B1); PG8_BAR;
        }
        if constexpr (!Epi::AFTER_DRAIN) { E(acc, cur, wr, wc, fr, fq); S.done(cur); }
        if (!has_next) break;
#pragma unroll
        for (int a = 0; a < 2; ++a)
#pragma unroll
            for (int b = 0; b < 2; ++b)
#pragma unroll
                for (int m = 0; m < 4; ++m)
#pragma unroll
                    for (int n = 0; n < 2; ++n) acc[a][b][m][n] = (f32x4){0.f, 0.f, 0.f, 0.f};
        cur = nxt; cA = nA; cB = nB; ++ui;
    }
    PG8_WAIT_V(0);
    if (wr == 0) PG8_BAR;
    PG8_BAR;
    if constexpr (Epi::AFTER_DRAIN) { E.fused(acc, cur, wr, wc, fr, fq, lds, wid, lane); S.done(cur); }
#undef PG8_SA
#undef PG8_SB
#undef PG8_STAGE
#undef PG8_LDA
#undef PG8_LDB
#undef PG8_MMA
#undef PG8_WAIT_V
#undef PG8_WAIT_L
#undef PG8_BAR
#undef PG8_SCHED
}
}

#include <cstdio>
#include <ctime>
#include <cstdlib>
#include <cstring>
#include <cmath>
#include <vector>
#include <algorithm>

using pg8::bf16_t; using pg8::f32x4; using pg8::Unit;
typedef unsigned u32x2v __attribute__((ext_vector_type(2)));
typedef unsigned u32x4v __attribute__((ext_vector_type(4)));

constexpr int D = 2048, SEQ = 4096, NMETA = 16, L = 4112, M = 8224, MP = 8448, DFF = 5632, INC = 6176, INCP = 6400;
constexpr float EPS = 1e-6f;
constexpr int LDS_BYTES = 4 * (8336 * 2 + 2 * 65 * 144) + 256;
constexpr unsigned PROBE_MASK = 0u; constexpr int PROBE_K = 8;
#define HSEC(i) do { if (PROBE_MASK) { const unsigned long long t_ = wall_clock64(); if ((PROBE_MASK >> (i)) & 1u) tsec += t_ - ts0_; ts0_ = t_; } } while (0)
constexpr int C_Q = 3072, C_K = 3584, C_V = 4096, C_OG = 5120, C_LR = 6144;

struct Params {
    const float *x, *meta, *ffn1_norm, *ffn1_wg, *ffn1_wu, *ffn1_wd, *mix_norm, *w_in, *conv_w, *conv_b,
        *filt_w1, *filt_b1, *filt_w2, *filt_b2, *filt_w3, *filt_freq, *hyena_d, *hyena_norm, *gk_w2, *gk_b2, *gla_norm, *w_out,
        *ffn2_norm, *ffn2_wg, *ffn2_wu, *ffn2_wd, *final_norm;
    float* out;
    bf16_t *Wgu1, *Wd1, *Win, *Wout, *Wgu2, *Wd2;
    float* h; bf16_t* hb; bf16_t* big; float* rowss; float* z2;
    bf16_t* y; bf16_t* yc; float* of; float* ob; unsigned char* gp; unsigned* ctr; bf16_t* uT; bf16_t* ZA; bf16_t* WB; bf16_t* GF; float* G0; unsigned* bar; float* dummy; int wave; int pad_;
};

__device__ __forceinline__ int lane_id() { return (int)__builtin_amdgcn_mbcnt_hi(~0u, __builtin_amdgcn_mbcnt_lo(~0u, 0u)); }
__device__ __forceinline__ int ltid_w(int wave) { int t = (wave << 6) | lane_id(); asm volatile("" : "+v"(t)); return t; }
__device__ __forceinline__ void lds_barrier() { asm volatile("s_waitcnt lgkmcnt(0)" ::: "memory"); __builtin_amdgcn_s_barrier(); asm volatile("" ::: "memory"); }
__device__ __forceinline__ float bf2f(bf16_t b) { return __uint_as_float(((unsigned)b) << 16); }
__device__ __forceinline__ unsigned pk2(float lo, float hi) { return pg8::cvt_pk_bf16(lo, hi); }
__device__ __forceinline__ bf16_t f2bf(float v) { return (bf16_t)(pk2(v, 0.f) & 0xffffu); }
template <int MSK> __device__ __forceinline__ float shx(float v) {
    if constexpr (MSK < 32) return __int_as_float(__builtin_amdgcn_ds_swizzle(__float_as_int(v), 0x1f | (MSK << 10)));
    else { int l = lane_id(); asm volatile("" : "+v"(l)); return __int_as_float(__builtin_amdgcn_ds_bpermute((l ^ 32) << 2, __float_as_int(v))); }
}
__device__ __forceinline__ float wave_sum(float v) { v += shx<32>(v); v += shx<16>(v); v += shx<8>(v); v += shx<4>(v); v += shx<2>(v); v += shx<1>(v); return v; }
__device__ __forceinline__ float silu_f(float x) { return x * __builtin_amdgcn_rcpf(1.0f + __expf(-x)); }

__device__ __forceinline__ float row_rscale(const float* rowss, int r, int fq) {
    const f32x4* q = (const f32x4*)(rowss + (size_t)r * 32 + fq * 8);
    const f32x4 a = q[0], b = q[1];
    float s = ((a[0] + a[1]) + (a[2] + a[3])) + ((b[0] + b[1]) + (b[2] + b[3]));
    s += shx<16>(s); s += shx<32>(s);
    return rsqrtf(s * (1.0f / D) + EPS);
}

struct EpiSwiglu {
    static constexpr bool PERM = true, AFTER_DRAIN = false;
    bf16_t* O; const float* rowss;
    __device__ __forceinline__ void operator()(const f32x4 (&acc)[2][2][4][2], const Unit& u, int wr, int wc, int fr, int fq) const {
        const int row0 = u.pm * 256 + wr * 64 + fr, col0 = u.pn * 128 + wc * 32 + 8 * fq;
#pragma unroll
        for (int ai = 0; ai < 2; ++ai)
#pragma unroll
            for (int m = 0; m < 4; ++m) {
                const int r = row0 + ai * 128 + m * 16; const float rs = row_rscale(rowss, r, fq);
                u32x4v w;
#pragma unroll
                for (int n = 0; n < 2; ++n) { const f32x4 g = acc[ai][0][m][n] * rs, uu = acc[ai][1][m][n] * rs;
                    w[2 * n] = pk2(silu_f(g[0]) * uu[0], silu_f(g[1]) * uu[1]); w[2 * n + 1] = pk2(silu_f(g[2]) * uu[2], silu_f(g[3]) * uu[3]); }
                *(u32x4v*)(O + (size_t)r * DFF + col0) = w;
            }
    }
};
struct EpiScale {
    static constexpr bool PERM = true, AFTER_DRAIN = false;
    bf16_t* O; int ldc; const float* rowss;
    __device__ __forceinline__ void operator()(const f32x4 (&acc)[2][2][4][2], const Unit& u, int wr, int wc, int fr, int fq) const {
        const int row0 = u.pm * 256 + wr * 64 + fr, col0 = u.pn * 256 + wc * 32 + 8 * fq;
#pragma unroll
        for (int ai = 0; ai < 2; ++ai)
#pragma unroll
            for (int m = 0; m < 4; ++m) {
                const int r = row0 + ai * 128 + m * 16; const float rs = row_rscale(rowss, r, fq);
#pragma unroll
                for (int bj = 0; bj < 2; ++bj) { const f32x4 a = acc[ai][bj][m][0] * rs, b = acc[ai][bj][m][1] * rs;
                    u32x4v w; w[0] = pk2(a[0], a[1]); w[1] = pk2(a[2], a[3]); w[2] = pk2(b[0], b[1]); w[3] = pk2(b[2], b[3]);
                    *(u32x4v*)(O + (size_t)r * ldc + col0 + bj * 128) = w; }
            }
    }
};
template <bool WHB> struct EpiResid {
    static constexpr bool PERM = true, AFTER_DRAIN = false;
    float* H; bf16_t* HB; float* rowss; float scale;
    __device__ __forceinline__ void operator()(const f32x4 (&acc)[2][2][4][2], const Unit& u, int wr, int wc, int fr, int fq) const {
        const int row0 = u.pm * 256 + wr * 64 + fr, col0 = u.pn * 256 + wc * 32 + 8 * fq;
#pragma unroll
        for (int ai = 0; ai < 2; ++ai)
#pragma unroll
            for (int m = 0; m < 4; ++m) {
                const int r = row0 + ai * 128 + m * 16; float ss = 0.f;
#pragma unroll
                for (int bj = 0; bj < 2; ++bj) { float* hp = H + (size_t)r * D + col0 + bj * 128;
                    f32x4 a = *(const f32x4*)hp, b = *(const f32x4*)(hp + 4);
                    a += acc[ai][bj][m][0] * scale; b += acc[ai][bj][m][1] * scale;
                    *(f32x4*)hp = a; *(f32x4*)(hp + 4) = b;
                    ss += (a[0] * a[0] + a[1] * a[1]) + (a[2] * a[2] + a[3] * a[3]) + (b[0] * b[0] + b[1] * b[1]) + (b[2] * b[2] + b[3] * b[3]);
                    if (WHB) { u32x4v w; w[0] = pk2(a[0], a[1]); w[1] = pk2(a[2], a[3]); w[2] = pk2(b[0], b[1]); w[3] = pk2(b[2], b[3]);
                        *(u32x4v*)(HB + (size_t)r * D + col0 + bj * 128) = w; } }
                ss += shx<16>(ss); ss += shx<32>(ss);
                if (WHB && fq == 0) rowss[(size_t)r * 32 + u.pn * 4 + wc] = ss;
            }
    }
};

constexpr int NT_FFN = 2816, NT_WIN = 3200, NT_WOUT = 1024, NT_TR = 6 * NT_FFN + NT_WIN + NT_WOUT, NT_ROWS = MP / 8, NT_Z2 = 4352 / 8, P0_ITEMS = NT_TR + NT_ROWS + NT_Z2;

__device__ __forceinline__ void transpose_one(const float* src, bf16_t* dst, const float* gain, const int K, const int N, const int ld, const int nvalid, const int mode, float* tl, const int wave, const int it) {
    const int nkt = K / 64, tid = ltid_w(wave);
        const int st = it / nkt, kt = it - st * nkt, k0 = kt * 64, nbase = st * 512;
        { const int r = tid >> 4, c4 = (tid & 15) * 4;
          const float g0 = gain ? gain[k0 + r] : 1.0f, g1 = gain ? gain[k0 + r + 32] : 1.0f;
          f32x4 v[8][2];
#pragma unroll
          for (int s8 = 0; s8 < 8; ++s8)
#pragma unroll
              for (int i = 0; i < 2; ++i) { const int n = nbase + s8 * 64 + c4; v[s8][i] = (f32x4){0.f, 0.f, 0.f, 0.f};
                  if (n < nvalid) v[s8][i] = *(const f32x4*)(src + (size_t)(k0 + r + 32 * i) * ld + n); }
#pragma unroll
          for (int s8 = 0; s8 < 8; ++s8)
#pragma unroll
              for (int i = 0; i < 2; ++i) { const float g = i ? g1 : g0; float* t = tl + s8 * 4160 + (r + 32 * i) * 65 + c4;
                  t[0] = v[s8][i][0] * g; t[1] = v[s8][i][1] * g; t[2] = v[s8][i][2] * g; t[3] = v[s8][i][3] * g; } }
        lds_barrier();
        { const int nl = tid >> 3, k8 = (tid & 7) * 8;
#pragma unroll
          for (int s8 = 0; s8 < 8; ++s8) { const int n0 = nbase + s8 * 64;
              if (n0 < N) { float w8[8];
#pragma unroll
                  for (int j = 0; j < 8; ++j) w8[j] = tl[s8 * 4160 + (k8 + j) * 65 + nl];
                  u32x4v w; w[0] = pk2(w8[0], w8[1]); w[1] = pk2(w8[2], w8[3]); w[2] = pk2(w8[4], w8[5]); w[3] = pk2(w8[6], w8[7]);
                  const long drow0 = mode == 0 ? n0 : (n0 / 128) * 256 + (n0 % 128) + (mode == 2 ? 128 : 0);
                  *(u32x4v*)(dst + (size_t)(drow0 + nl) * K + k0 + k8) = w; } } }
        lds_barrier();
}
__device__ __forceinline__ void transpose_mat(const float* src, bf16_t* dst, const float* gain, const int K, const int N, const int ld, const int nvalid, const int mode, float* tl, const int wave) {
    const int nitems = (K / 64) * ((N + 511) / 512);
    for (int it = blockIdx.x; it < nitems; it += gridDim.x) transpose_one(src, dst, gain, K, N, ld, nvalid, mode, tl, wave, it);
}
constexpr int BG_ITEMS = 1056;
__device__ __forceinline__ void bg_convert(const Params& p, unsigned char* smem, int budget) {
    for (int k = 0; k < budget; ++k) {
        if (ltid_w(p.wave) == 0) *(int*)(smem + LDS_BYTES - 64) = (int)atomicAdd(p.ctr + 1, 1u);
        lds_barrier();
        const int g = __builtin_amdgcn_readfirstlane(*(const int*)(smem + LDS_BYTES - 64));
        lds_barrier();
        if (g >= BG_ITEMS) break;
        if (g < 352) transpose_one(p.ffn2_wg, p.Wgu2, p.ffn2_norm, D, DFF, DFF, DFF, 1, (float*)smem, p.wave, g);
        else if (g < 704) transpose_one(p.ffn2_wu, p.Wgu2, p.ffn2_norm, D, DFF, DFF, DFF, 2, (float*)smem, p.wave, g - 352);
        else transpose_one(p.ffn2_wd, p.Wd2, nullptr, DFF, D, D, D, 0, (float*)smem, p.wave, g - 704);
    }
}

__device__ void row_item(const Params& p, int item) {
    const int tid__ = ltid_w(p.wave), wid = tid__ >> 6, lane = tid__ & 63, m = item * 8 + wid;
    float* hrow = p.h + (size_t)m * D; bf16_t* hbrow = p.hb + (size_t)m * D;
    if (m < M) { const int b = m / L, t = m - b * L;
        const float* src = t < NMETA ? p.meta + (size_t)t * D : p.x + ((size_t)b * SEQ + t - NMETA) * D;
        float ss = 0.f;
#pragma unroll
        for (int i = 0; i < 8; ++i) { const int c = (lane + 64 * i) * 4; const f32x4 v = *(const f32x4*)(src + c);
            ss += (v[0] * v[0] + v[1] * v[1]) + (v[2] * v[2] + v[3] * v[3]);
            *(f32x4*)(hrow + c) = v; u32x2v w; w[0] = pk2(v[0], v[1]); w[1] = pk2(v[2], v[3]); *(u32x2v*)(hbrow + c) = w; }
        ss = wave_sum(ss);
        if (lane < 32) p.rowss[(size_t)m * 32 + lane] = lane == 0 ? ss : 0.f;
    } else {
#pragma unroll
        for (int i = 0; i < 8; ++i) { const int c = (lane + 64 * i) * 4; *(f32x4*)(hrow + c) = (f32x4){0.f, 0.f, 0.f, 0.f}; u32x2v w; w[0] = 0u; w[1] = 0u; *(u32x2v*)(hbrow + c) = w; }
        if (lane < 32) p.rowss[(size_t)m * 32 + lane] = 0.f;
    }
}

__device__ void z2_item(const Params& p, int item) {
    const int tid__ = ltid_w(p.wave), wid = tid__ >> 6, lane = tid__ & 63, j = item * 8 + wid;
    bf16_t* za = p.ZA + (size_t)j * 256;
    if (j >= L) { za[lane] = 0; za[64 + lane] = 0; za[128 + lane] = 0; za[192 + lane] = 0; return; }
    float feat = 0.f;
    const float w = (float)(2.0 * 3.14159265358979323846 / L) * (float)j;
    if (lane == 0) feat = (float)j * (1.0f / (float)(L - 1));
    else if (lane <= 32) { const int bi = (lane - 1) & 15; const float band = 1e-4f + (float)bi * ((15.0f - 1e-4f) / 15.0f); const float ang = w * band;
        feat = lane <= 16 ? cosf(ang) : -sinf(ang); }
    float a = p.filt_b1[lane];
    for (int i = 0; i < 33; ++i) a += __int_as_float(__builtin_amdgcn_readlane(__float_as_int(feat), i)) * p.filt_w1[i * 64 + lane];
    const float fr = p.filt_freq[lane];
    const float z1 = sinf(fr * a);
    float c = p.filt_b2[lane];
    for (int k = 0; k < 64; ++k) c += __int_as_float(__builtin_amdgcn_readlane(__float_as_int(z1), k)) * p.filt_w2[k * 64 + lane];
    const float z = sinf(fr * c);
    const bf16_t hi = f2bf(z), lo = f2bf(z - bf2f(hi));
    za[lane] = hi; za[64 + lane] = lo; za[128 + lane] = hi; za[192 + lane] = 0;
}
__device__ void wb_items(const Params& p) {
    for (int idx = blockIdx.x * 512 + ltid_w(p.wave); idx < 2048 * 64; idx += gridDim.x * 512) { const int n = idx >> 6, k = idx & 63;
        const float w = p.filt_w3[(size_t)k * 2048 + n]; const bf16_t hi = f2bf(w), lo = f2bf(w - bf2f(hi));
        bf16_t* wb = p.WB + (size_t)n * 256; wb[k] = hi; wb[64 + k] = hi; wb[128 + k] = lo; wb[192 + k] = 0; }
}
struct EpiFilt {
    static constexpr bool PERM = true, AFTER_DRAIN = false;
    bf16_t* GF; float* G0;
    __device__ __forceinline__ void operator()(const f32x4 (&acc)[2][2][4][2], const Unit& u, int wr, int wc, int fr, int fq) const {
        const int row0 = u.pm * 256 + wr * 64 + fr, col0 = u.pn * 256 + wc * 32 + 8 * fq;
        const float la = -3.0701134573253945f, lb = -15.350567286626973f;
#pragma unroll
        for (int ai = 0; ai < 2; ++ai)
#pragma unroll
            for (int m = 0; m < 4; ++m) { const int n = row0 + ai * 128 + m * 16; const float delta = fabsf(la + (float)(n & 1023) * ((lb - la) / 1023.0f)) * (1.0f / (float)(L - 1));
                const float r1 = __expf(-delta), r2 = r1 * r1, r3 = r2 * r1;
                bf16_t* grow = GF + (size_t)n * 4352 + col0;
#pragma unroll
                for (int bj = 0; bj < 2; ++bj)
#pragma unroll
                    for (int nn = 0; nn < 2; ++nn) { const int j0 = col0 + bj * 128 + 4 * nn; const f32x4 a4 = acc[ai][bj][m][nn];
                        const float w0 = __expf(-(float)j0 * delta);
                        const float v0 = a4[0] * w0, v1 = a4[1] * (w0 * r1), v2 = a4[2] * (w0 * r2), v3 = a4[3] * (w0 * r3);
                        u32x2v w; w[0] = pk2(v0, v1); w[1] = pk2(v2, v3);
                        *(u32x2v*)(grow + bj * 128 + 4 * nn) = w;
                        if (j0 == 0) G0[n] = v0; } }

    }
};

constexpr int HY_G_ELEMS = 8336, HY_G_BYTES = HY_G_ELEMS * 2, HY_USTR = 144, HY_U_BYTES = 65 * HY_USTR, HY_CH_BYTES = HY_G_BYTES + 2 * HY_U_BYTES, HY_ZERO_OFF = 4 * HY_CH_BYTES;
static_assert(HY_ZERO_OFF + 256 <= LDS_BYTES, "lds");
static_assert(HY_CH_BYTES % 16 == 0 && HY_G_BYTES % 16 == 0, "align");
__device__ void hyu_item(const Params& p, int item, unsigned char* sm) {
    const int cb = item & 3, bt = item >> 2, b = bt / 65, tile = bt - b * 65, t0 = tile * 64;
    const int tid = ltid_w(p.wave), q = tid & 31, rg = tid >> 5, c8 = cb * 256 + q * 8, tb = t0 + 4 * rg;
    bf16_t* LT = (bf16_t*)sm;
    u32x4v x1[6], vh[6]; float okf[6];
#pragma unroll
    for (int i = 0; i < 6; ++i) { const int t2 = tb - 1 + i; okf[i] = (t2 >= 0 && t2 < L) ? 1.f : 0.f; const int t2c = t2 < 0 ? 0 : (t2 >= L ? L - 1 : t2);
        const bf16_t* row = p.big + (size_t)(b * L + t2c) * INCP + c8; x1[i] = *(const u32x4v*)(row + 1024); vh[i] = *(const u32x4v*)(row + 2048); }
    f32x4 w1[3][2], w2[3][2], b1[2], b2v[2];
#pragma unroll
    for (int h2 = 0; h2 < 2; ++h2) { b1[h2] = *(const f32x4*)(p.conv_b + 1024 + c8 + 4 * h2); b2v[h2] = *(const f32x4*)(p.conv_b + 2048 + c8 + 4 * h2);
#pragma unroll
        for (int jj = 0; jj < 3; ++jj) { w1[jj][h2] = *(const f32x4*)(p.conv_w + jj * 3072 + 1024 + c8 + 4 * h2); w2[jj][h2] = *(const f32x4*)(p.conv_w + jj * 3072 + 2048 + c8 + 4 * h2); } }
    float u[4][8];
#pragma unroll
    for (int r = 0; r < 4; ++r) { float a1[8], a2[8];
#pragma unroll
        for (int e = 0; e < 8; ++e) { a1[e] = b1[e >> 2][e & 3]; a2[e] = b2v[e >> 2][e & 3]; }
#pragma unroll
        for (int jj = 0; jj < 3; ++jj) { const int i = r + jj; const float m = okf[i];
#pragma unroll
            for (int e = 0; e < 8; ++e) { const unsigned xa = x1[i][e >> 1], xb = vh[i][e >> 1];
                const float fa = (e & 1) ? __uint_as_float(xa & 0xffff0000u) : __uint_as_float(xa << 16), fb = (e & 1) ? __uint_as_float(xb & 0xffff0000u) : __uint_as_float(xb << 16);
                a1[e] += fa * (w1[jj][e >> 2][e & 3] * m); a2[e] += fb * (w2[jj][e >> 2][e & 3] * m); } }
        const float vm = (tb + r) < L ? 1.f : 0.f;
#pragma unroll
        for (int e = 0; e < 8; ++e) u[r][e] = a1[e] * a2[e] * vm; }
#pragma unroll
    for (int e = 0; e < 8; ++e) { u32x2v w; w[0] = pk2(u[0][e], u[1][e]); w[1] = pk2(u[2][e], u[3][e]); *(u32x2v*)(LT + (q * 8 + e) * 72 + 4 * rg) = w; }
    lds_barrier();
    { const int row = tid >> 1, half = tid & 1; bf16_t* dst = p.uT + ((size_t)(cb * 256 + row) * 2 + b) * 4160 + t0 + half * 32;
#pragma unroll
      for (int i = 0; i < 4; ++i) *(u32x4v*)(dst + 8 * i) = *(const u32x4v*)(LT + row * 72 + half * 32 + 8 * i); }
    lds_barrier();
}
__device__ void hyena_group(const Params& p, int grp_, unsigned char* sm, unsigned long long& tsec) {
    unsigned long long ts0_ = PROBE_MASK ? wall_clock64() : 0ull;
    const int grp = __builtin_amdgcn_readfirstlane(grp_);
    const int tid = ltid_w(p.wave), wid = tid >> 6, lane = tid & 63, c0 = grp * 4;
    { const unsigned char* src = (const unsigned char*)(p.uT + (size_t)c0 * 2 * 4160);
      for (int idx = tid; idx < 8 * 520; idx += 512) { const int r = idx / 520, i = idx - r * 520;
          *(u32x4v*)(sm + (r >> 1) * HY_CH_BYTES + HY_G_BYTES + (r & 1) * HY_U_BYTES + (i >> 3) * HY_USTR + (i & 7) * 16) = *(const u32x4v*)(src + (size_t)idx * 16); } }
    if (tid < 36) ((unsigned*)(sm + HY_ZERO_OFF))[tid] = 0u;
    for (int i = tid; i < 4 * 113; i += 512) { const int ch = i / 113, q = i - ch * 113; const int idx = q < 49 ? q : 8272 + (q - 49);
        *(unsigned short*)(sm + ch * HY_CH_BYTES + 2 * idx) = 0; }
    for (int idx = tid; idx < 4 * 514; idx += 512) { const int ch = idx / 514, pc = idx - ch * 514, j0 = pc * 8;
        unsigned short* gb = (unsigned short*)(sm + ch * HY_CH_BYTES);
        const u32x4v f = *(const u32x4v*)(p.GF + (size_t)(c0 + ch) * 4352 + j0); u32x4v bk = *(const u32x4v*)(p.GF + (size_t)(1024 + c0 + ch) * 4352 + j0);
        if (pc == 0) bk[0] = (bk[0] & 0xffff0000u) | (pk2(p.G0[c0 + ch] + p.G0[1024 + c0 + ch], 0.f) & 0xffffu);
        *(u32x4v*)(gb + 4160 + j0) = bk;
#pragma unroll
        for (int e = 0; e < 8; ++e) if (pc != 0 || e != 0) gb[4160 - j0 - e] = (unsigned short)((e & 1) ? (f[e >> 1] >> 16) : (f[e >> 1] & 0xffffu)); }
    lds_barrier();
    HSEC(12);
    const int ch = wid >> 1, b = wid & 1, li = lane & 15, kq = lane >> 4;
    unsigned char* Ub = sm + ch * HY_CH_BYTES + HY_G_BYTES + b * HY_U_BYTES;
    const unsigned char* Zb = sm + HY_ZERO_OFF + kq * 16;
    f32x4 acc[4][5];
#pragma unroll
    for (int rb = 0; rb < 4; ++rb)
#pragma unroll
        for (int nb = 0; nb < 5; ++nb) acc[rb][nb] = (f32x4){0.f, 0.f, 0.f, 0.f};
    const unsigned shl = (li & 1) ? 16u : 0u;
    unsigned gq[5];
#pragma unroll
    for (int w = 0; w < 5; ++w) { unsigned t_ = (unsigned)(ch * HY_CH_BYTES + 4 * (((4160 + 8 * kq - li) >> 1) + w)); asm volatile("" : "+v"(t_)); gq[w] = t_; }
    PG8_LAS const unsigned char* sml = (PG8_LAS const unsigned char*)sm;
    auto gload = [&](int mp, unsigned (&e)[5]) {
#pragma unroll
        for (int w = 0; w < 5; ++w) e[w] = *(PG8_LAS const unsigned*)(sml + (gq[w] - 32 * mp));
    };
    auto gmake = [&](const unsigned (&e)[5]) -> pg8::bf16x8 {
        u32x4v r;
#pragma unroll
        for (int w = 0; w < 4; ++w) r[w] = __builtin_amdgcn_alignbit(e[w + 1], e[w], shl);
        return __builtin_bit_cast(pg8::bf16x8, r);
    };
    pg8::bf16x8 F[6];
    unsigned E[4][5];
    { unsigned e0[5], e1[5]; gload(4 * (-64) - 2, e0); gload(4 * (-64) - 1, e1); F[4] = gmake(e0); F[5] = gmake(e1); }
#pragma unroll
    for (int q = 0; q < 4; ++q) gload(4 * (-64) + q, E[q]);
    for (int d = -64; d <= 64; ++d) {
        F[0] = F[4]; F[1] = F[5];
#pragma unroll
        for (int q = 2; q < 6; ++q) F[q] = gmake(E[q - 2]);
        if (d < 64) {
#pragma unroll
            for (int q = 0; q < 4; ++q) gload(4 * (d + 1) + q, E[q]);
        }
        const int nb_lo = d > 0 ? (d >> 4) : 0, nb_hi = (d + 64) >> 4;
#pragma unroll
        for (int nb = 0; nb < 5; ++nb) {
            if (nb >= nb_lo && nb <= nb_hi) {
                const int sblk = 16 * nb + li - d;
                const unsigned char* up = ((unsigned)sblk < 65u) ? (Ub + sblk * HY_USTR + kq * 16) : Zb;
                const pg8::bf16x8 B0 = *(const pg8::bf16x8*)up, B1 = *(const pg8::bf16x8*)(up + 64);
#pragma unroll
                for (int rb = 0; rb < 4; ++rb) {
                    acc[rb][nb] = __builtin_amdgcn_mfma_f32_16x16x32_bf16(F[rb + 2], B0, acc[rb][nb], 0, 0, 0);
                    acc[rb][nb] = __builtin_amdgcn_mfma_f32_16x16x32_bf16(F[rb], B1, acc[rb][nb], 0, 0, 0);
                }
            }
        }
    }
    HSEC(13);
    {
        const float dc = p.hyena_d[c0 + ch];
#pragma unroll
        for (int nb = 0; nb < 5; ++nb) { const int t1 = 16 * nb + li;
            if (t1 < 65) {
#pragma unroll
                for (int rb = 0; rb < 4; ++rb) { unsigned char* up = Ub + t1 * HY_USTR + (16 * rb + 4 * kq) * 2;
                    const u32x2v uu = *(const u32x2v*)up; const f32x4 a = acc[rb][nb];
                    u32x2v w; w[0] = pk2(a[0] + dc * __uint_as_float(uu[0] << 16), a[1] + dc * __uint_as_float(uu[0] & 0xffff0000u));
                    w[1] = pk2(a[2] + dc * __uint_as_float(uu[1] << 16), a[3] + dc * __uint_as_float(uu[1] & 0xffff0000u));
                    *(u32x2v*)up = w; } } }
    }
    lds_barrier();
    for (int tt = tid; tt < 2 * L; tt += 512) { const int bb = tt >= L ? 1 : 0, t = tt - bb * L;
        const unsigned char* up = sm + HY_G_BYTES + bb * HY_U_BYTES + (t >> 6) * HY_USTR + (t & 63) * 2;
        const unsigned v0 = *(const unsigned short*)up, v1 = *(const unsigned short*)(up + HY_CH_BYTES), v2 = *(const unsigned short*)(up + 2 * HY_CH_BYTES), v3 = *(const unsigned short*)(up + 3 * HY_CH_BYTES);
        u32x2v w; w[0] = v0 | (v1 << 16); w[1] = v2 | (v3 << 16);
        *(u32x2v*)(p.yc + (size_t)(bb * L + t) * 1024 + c0) = w; }
    lds_barrier();
    HSEC(14);
}

constexpr int GP_QT = 0, GP_KT = 16384, GP_AM = 32768, GP_DEC = 40960, GP_STRIDE = 41472;
__device__ void gla_pre(const Params& p, int item, unsigned char* sm) {
    const int n = item % 65, bdh = item / 65, hh = bdh & 3, dir = (bdh >> 2) & 1, b = bdh >> 3;
    const int tid = ltid_w(p.wave), d = tid & 127, seg = tid >> 7, lane = tid & 63, wid = tid >> 6, li = lane & 15, kq = lane >> 4;
    float* LR = (float*)sm; float* SEGT = LR + 1024; bf16_t* QS = (bf16_t*)(sm + 8192); bf16_t* KS = QS + 64 * 136;
    unsigned char* gp = p.gp + (size_t)item * GP_STRIDE;
    { const int i = tid >> 3, r2 = (tid & 7) * 2; const int tau = dir ? 4159 - (64 * n + i) : 64 * n + i; float v0 = 0.f, v1 = 0.f;
      { const unsigned w = *(const unsigned*)(p.big + (size_t)(b * L + (tau < 48 ? 0 : tau - 48)) * INCP + C_LR + dir * 16 + r2); if (tau >= 48) { v0 = __uint_as_float(w << 16); v1 = __uint_as_float(w & 0xffff0000u); } }
      LR[i * 16 + r2] = v0; LR[i * 16 + r2 + 1] = v1; }
    float w2[16];
#pragma unroll
    for (int r = 0; r < 16; ++r) w2[r] = p.gk_w2[(size_t)(dir * 16 + r) * 512 + hh * 128 + d];
    const float b2 = p.gk_b2[dir * 512 + hh * 128 + d];
    unsigned short qraw[16], kraw[16];
#pragma unroll
    for (int ii = 0; ii < 16; ++ii) { const int i = seg * 16 + ii; const int tau = dir ? 4159 - (64 * n + i) : 64 * n + i; const int tc = tau < 48 ? 0 : tau - 48;
        const bf16_t* row = p.big + (size_t)(b * L + tc) * INCP + hh * 128 + d; qraw[ii] = row[C_Q]; kraw[ii] = row[C_K];
        if (tau < 48) { qraw[ii] = 0; kraw[ii] = 0; } }
    lds_barrier();
    float cs[16]; float run = 0.f;
#pragma unroll
    for (int ii = 0; ii < 16; ++ii) { const int i = seg * 16 + ii; const int tau = dir ? 4159 - (64 * n + i) : 64 * n + i;
        float xg = b2;
#pragma unroll
        for (int r4 = 0; r4 < 4; ++r4) { const f32x4 l4 = *(const f32x4*)(LR + i * 16 + 4 * r4); xg += l4[0] * w2[4 * r4] + l4[1] * w2[4 * r4 + 1] + l4[2] * w2[4 * r4 + 2] + l4[3] * w2[4 * r4 + 3]; }
        const float lg = tau >= 48 ? (fminf(xg, 0.f) - __logf(1.0f + __expf(-fabsf(xg)))) * (1.0f / 16.0f) : 0.f;
        run += lg; cs[ii] = run; }
    SEGT[seg * 128 + d] = run;
    lds_barrier();
    float off = 0.f, tot = 0.f;
#pragma unroll
    for (int s = 0; s < 4; ++s) { const float v = SEGT[s * 128 + d]; if (s < seg) off += v; tot += v; }
    unsigned kt[8];
#pragma unroll
    for (int ii = 0; ii < 16; ii += 2) { float kh[2];
#pragma unroll
        for (int x = 0; x < 2; ++x) { const int i = seg * 16 + ii + x; const float q = bf2f(qraw[ii + x]), k = bf2f(kraw[ii + x]);
            const float bi = off + cs[ii + x]; const bf16_t qv = f2bf(q * 0.08838834764831845f * __expf(bi));
            QS[i * 136 + d] = qv; KS[i * 136 + d] = f2bf(k * __expf(-bi)); *(bf16_t*)(gp + GP_QT + (i * 128 + d) * 2) = qv; kh[x] = k * __expf(tot - bi); }
        kt[ii >> 1] = pk2(kh[0], kh[1]); }
    { u32x4v w0, w1; w0[0] = kt[0]; w0[1] = kt[1]; w0[2] = kt[2]; w0[3] = kt[3]; w1[0] = kt[4]; w1[1] = kt[5]; w1[2] = kt[6]; w1[3] = kt[7];
      *(u32x4v*)(gp + GP_KT + (d * 64 + seg * 16) * 2) = w0; *(u32x4v*)(gp + GP_KT + (d * 64 + seg * 16 + 8) * 2) = w1; }
    if (seg == 0) *(float*)(gp + GP_DEC + d * 4) = __expf(tot);
    lds_barrier();
    { const int it = wid >> 1;
#pragma unroll
      for (int x = 0; x < 2; ++x) { const int jt = (wid & 1) * 2 + x; f32x4 acc = {0.f, 0.f, 0.f, 0.f};
#pragma unroll
          for (int ks = 0; ks < 4; ++ks) { const pg8::bf16x8 a = *(const pg8::bf16x8*)(QS + (16 * it + li) * 136 + 32 * ks + 8 * kq), bb = *(const pg8::bf16x8*)(KS + (16 * jt + li) * 136 + 32 * ks + 8 * kq);
              acc = __builtin_amdgcn_mfma_f32_16x16x32_bf16(a, bb, acc, 0, 0, 0); }
#pragma unroll
          for (int r = 0; r < 4; ++r) { const int i = 16 * it + 4 * kq + r, j = 16 * jt + li; *(bf16_t*)(gp + GP_AM + (i * 64 + j) * 2) = f2bf(j <= i ? acc[r] : 0.f); } } }
    lds_barrier();
}

__device__ void gla_scan(const Params& p, int item, unsigned char* sm, unsigned long long& tsec) {
    const int s = item & 7, bdh = item >> 3, hh = bdh & 3, dir = (bdh >> 2) & 1, b = bdh >> 3;
    const int tid = ltid_w(p.wave), lane = tid & 63, wid = tid >> 6, li = lane & 15, kq = lane >> 4;
    constexpr int O_VT = 0, SZ_VT = 32 * 72 * 2, O_ST = 2 * SZ_VT;
    float* outp = dir ? p.ob : p.of;
    const unsigned char* gbase = p.gp + (size_t)(bdh * 65) * GP_STRIDE;
    const int it = wid >> 1, eto = wid & 1;
    struct RS { u32x4v fa[2], fq[4], fk[2], v; f32x4 dec; };
    auto LOAD = [&](int n, RS& R) {
        const unsigned char* g = gbase + (size_t)n * GP_STRIDE;
#pragma unroll
        for (int ks = 0; ks < 2; ++ks) R.fa[ks] = *(const u32x4v*)(g + GP_AM + ((16 * it + li) * 64 + 32 * ks + 8 * kq) * 2);
#pragma unroll
        for (int ks = 0; ks < 4; ++ks) R.fq[ks] = *(const u32x4v*)(g + GP_QT + ((16 * it + li) * 128 + 32 * ks + 8 * kq) * 2);
#pragma unroll
        for (int ks = 0; ks < 2; ++ks) R.fk[ks] = *(const u32x4v*)(g + GP_KT + ((16 * wid + li) * 64 + 32 * ks + 8 * kq) * 2);
        R.dec = *(const f32x4*)(g + GP_DEC + (16 * wid + 4 * kq) * 4);
        const int tau = dir ? 4159 - (64 * n + lane) : 64 * n + lane;
        R.v = (u32x4v){0u, 0u, 0u, 0u};
        R.v = *(const u32x4v*)(p.big + (size_t)(b * L + (tau < 48 ? 0 : tau - 48)) * INCP + C_V + hh * 256 + s * 32 + (wid & 3) * 8);
    };
    auto PUTV = [&](int buf, const RS& R) {
        if (wid < 4) { bf16_t* vt = (bf16_t*)(sm + O_VT + buf * SZ_VT);
#pragma unroll
            for (int x = 0; x < 4; ++x) { vt[(wid * 8 + 2 * x) * 72 + lane] = (bf16_t)(R.v[x] & 0xffffu); vt[(wid * 8 + 2 * x + 1) * 72 + lane] = (bf16_t)(R.v[x] >> 16); } }
    };
    f32x4 S[2];
    S[0] = (f32x4){0.f, 0.f, 0.f, 0.f}; S[1] = S[0];
    for (int i = tid; i < 8704 / 16; i += 512) *(u32x4v*)(sm + O_ST + i * 16) = (u32x4v){0u, 0u, 0u, 0u};
    const bf16_t* ST = (const bf16_t*)(sm + O_ST);
    auto STEP = [&](int n, RS& RA, const RS& RB, RS& RC) {
        unsigned long long ts0_ = PROBE_MASK ? wall_clock64() : 0ull;
        if (n + 2 < 65) LOAD(n + 2, RC);
        const bf16_t* VT = (const bf16_t*)(sm + O_VT + (n & 1) * SZ_VT);
        { f32x4 o = {0.f, 0.f, 0.f, 0.f};
#pragma unroll
          for (int ks = 0; ks < 2; ++ks) { const pg8::bf16x8 bb = *(const pg8::bf16x8*)(VT + (16 * eto + li) * 72 + 32 * ks + 8 * kq);
              o = __builtin_amdgcn_mfma_f32_16x16x32_bf16(__builtin_bit_cast(pg8::bf16x8, RA.fa[ks]), bb, o, 0, 0, 0); }
#pragma unroll
          for (int ks = 0; ks < 4; ++ks) { const pg8::bf16x8 bb = *(const pg8::bf16x8*)(ST + (16 * eto + li) * 136 + 32 * ks + 8 * kq);
              o = __builtin_amdgcn_mfma_f32_16x16x32_bf16(__builtin_bit_cast(pg8::bf16x8, RA.fq[ks]), bb, o, 0, 0, 0); }
#pragma unroll
          for (int r = 0; r < 4; ++r) { const int i = 16 * it + 4 * kq + r; const int tau = dir ? 4159 - (64 * n + i) : 64 * n + i;
              float* dst = tau >= 48 ? outp + (size_t)(b * L + tau - 48) * 1024 + hh * 256 + s * 32 + 16 * eto + li : p.dummy + tid;
              *dst = o[r]; } }
#pragma unroll
        for (int et = 0; et < 2; ++et) { S[et] *= RA.dec;
#pragma unroll
            for (int ks = 0; ks < 2; ++ks) { const pg8::bf16x8 bb = *(const pg8::bf16x8*)(VT + (16 * et + li) * 72 + 32 * ks + 8 * kq);
                S[et] = __builtin_amdgcn_mfma_f32_16x16x32_bf16(__builtin_bit_cast(pg8::bf16x8, RA.fk[ks]), bb, S[et], 0, 0, 0); } }
        HSEC(25);
        lds_barrier();
        HSEC(26);
#pragma unroll
        for (int et = 0; et < 2; ++et) { u32x2v w; w[0] = pk2(S[et][0], S[et][1]); w[1] = pk2(S[et][2], S[et][3]);
            *(u32x2v*)(sm + O_ST + ((16 * et + li) * 136 + 16 * wid + 4 * kq) * 2) = w; }
        if (n + 1 < 65) PUTV((n + 1) & 1, RB);
        lds_barrier();
        HSEC(27);
    };
    RS R0, R1, R2;
    LOAD(0, R0); LOAD(1, R1);
    PUTV(0, R0);
    lds_barrier();
    for (int n = 0; n < 63; n += 3) { STEP(n, R0, R1, R2); STEP(n + 1, R1, R2, R0); STEP(n + 2, R2, R0, R1); }
    STEP(63, R0, R1, R2); STEP(64, R1, R2, R0);
}

__device__ void fin_item(const Params& p, int item) {
    const int tid__ = ltid_w(p.wave), wid = tid__ >> 6, lane = tid__ & 63, m = item * 8 + wid;
    bf16_t* yrow = p.y + (size_t)m * D;
    if (m >= M) { const u32x4v z = {0u, 0u, 0u, 0u};
#pragma unroll
        for (int i = 0; i < 4; ++i) *(u32x4v*)(yrow + (lane + 64 * i) * 8) = z;
        return; }
    const int c0 = lane * 16;
    {
      const int b = m >= L ? 1 : 0, t = m - b * L;
      float x0[16];
#pragma unroll
      for (int i = 0; i < 4; ++i) { const f32x4 cb = *(const f32x4*)(p.conv_b + c0 + 4 * i); x0[4 * i] = cb[0]; x0[4 * i + 1] = cb[1]; x0[4 * i + 2] = cb[2]; x0[4 * i + 3] = cb[3]; }
#pragma unroll
      for (int jj = 0; jj < 3; ++jj) { const int t2 = t + jj - 1; const bool ok = t2 >= 0 && t2 < L; const int t2c = t2 < 0 ? 0 : (t2 >= L ? L - 1 : t2);
          { const bf16_t* row = p.big + (size_t)(b * L + t2c) * INCP + c0; const u32x4v r0 = *(const u32x4v*)row, r1 = *(const u32x4v*)(row + 8); const float okf = ok ? 1.f : 0.f;
#pragma unroll
              for (int i = 0; i < 4; ++i) { const f32x4 cw = *(const f32x4*)(p.conv_w + jj * 3072 + c0 + 4 * i) * okf; const unsigned lo = i < 2 ? r0[2 * i] : r1[2 * i - 4], hi = i < 2 ? r0[2 * i + 1] : r1[2 * i - 3];
                  x0[4 * i] += __uint_as_float(lo << 16) * cw[0]; x0[4 * i + 1] += __uint_as_float(lo & 0xffff0000u) * cw[1]; x0[4 * i + 2] += __uint_as_float(hi << 16) * cw[2]; x0[4 * i + 3] += __uint_as_float(hi & 0xffff0000u) * cw[3]; } } }
      const bf16_t* src = p.yc + (size_t)m * 1024 + c0; const u32x4v y0 = *(const u32x4v*)src, y1 = *(const u32x4v*)(src + 8);
      f32x4 v[4]; float ss = 0.f;
#pragma unroll
      for (int i = 0; i < 4; ++i) { const unsigned lo = i < 2 ? y0[2 * i] : y1[2 * i - 4], hi = i < 2 ? y0[2 * i + 1] : y1[2 * i - 3];
          v[i][0] = __uint_as_float(lo << 16) * x0[4 * i]; v[i][1] = __uint_as_float(lo & 0xffff0000u) * x0[4 * i + 1]; v[i][2] = __uint_as_float(hi << 16) * x0[4 * i + 2]; v[i][3] = __uint_as_float(hi & 0xffff0000u) * x0[4 * i + 3];
          ss += (v[i][0] * v[i][0] + v[i][1] * v[i][1]) + (v[i][2] * v[i][2] + v[i][3] * v[i][3]); }
      ss += shx<1>(ss); ss += shx<2>(ss); ss += shx<4>(ss);
      const float r = rsqrtf(ss * (1.0f / 128.0f) + EPS);
      u32x4v w0, w1;
#pragma unroll
      for (int i = 0; i < 4; ++i) { const f32x4 g = *(const f32x4*)(p.hyena_norm + c0 + 4 * i); const f32x4 o = v[i] * r * g;
          if (i < 2) { w0[2 * i] = pk2(o[0], o[1]); w0[2 * i + 1] = pk2(o[2], o[3]); } else { w1[2 * i - 4] = pk2(o[0], o[1]); w1[2 * i - 3] = pk2(o[2], o[3]); } }
      *(u32x4v*)(yrow + c0) = w0; *(u32x4v*)(yrow + c0 + 8) = w1; }
    { const float* s1 = p.of + (size_t)m * 1024 + c0; const float* s2 = p.ob + (size_t)m * 1024 + c0; f32x4 v[4]; float ss = 0.f;
#pragma unroll
      for (int i = 0; i < 4; ++i) { v[i] = *(const f32x4*)(s1 + 4 * i) + *(const f32x4*)(s2 + 4 * i); ss += (v[i][0] * v[i][0] + v[i][1] * v[i][1]) + (v[i][2] * v[i][2] + v[i][3] * v[i][3]); }
      ss += shx<1>(ss); ss += shx<2>(ss); ss += shx<4>(ss); ss += shx<8>(ss);
      const float r = rsqrtf(ss * (1.0f / 256.0f) + EPS);
      const bf16_t* og = p.big + (size_t)m * INCP + C_OG + c0;
      const u32x4v g0 = *(const u32x4v*)og, g1 = *(const u32x4v*)(og + 8);
      float ogf[16];
#pragma unroll
      for (int i = 0; i < 4; ++i) { ogf[2 * i] = __uint_as_float(g0[i] << 16); ogf[2 * i + 1] = __uint_as_float(g0[i] & 0xffff0000u); ogf[8 + 2 * i] = __uint_as_float(g1[i] << 16); ogf[8 + 2 * i + 1] = __uint_as_float(g1[i] & 0xffff0000u); }
      u32x4v w0, w1;
#pragma unroll
      for (int i = 0; i < 4; ++i) { const f32x4 g = *(const f32x4*)(p.gla_norm + ((c0 + 4 * i) & 255)); f32x4 o = v[i] * r * g;
          o[0] *= silu_f(ogf[4 * i]); o[1] *= silu_f(ogf[4 * i + 1]); o[2] *= silu_f(ogf[4 * i + 2]); o[3] *= silu_f(ogf[4 * i + 3]);
          if (i < 2) { w0[2 * i] = pk2(o[0], o[1]); w0[2 * i + 1] = pk2(o[2], o[3]); } else { w1[2 * i - 4] = pk2(o[0], o[1]); w1[2 * i - 3] = pk2(o[2], o[3]); } }
      *(u32x4v*)(yrow + 1024 + c0) = w0; *(u32x4v*)(yrow + 1024 + c0 + 8) = w1; }
}

__device__ void final_item(const Params& p, int item) {
    const int tid__ = ltid_w(p.wave), wid = tid__ >> 6, lane = tid__ & 63, row = item * 8 + wid, b = row >> 12, s = row & 4095, m = b * L + NMETA + s;
    const float* hrow = p.h + (size_t)m * D; float* orow = p.out + (size_t)row * D; f32x4 v[8]; float ss = 0.f;
#pragma unroll
    for (int i = 0; i < 8; ++i) { v[i] = *(const f32x4*)(hrow + (lane + 64 * i) * 4); ss += (v[i][0] * v[i][0] + v[i][1] * v[i][1]) + (v[i][2] * v[i][2] + v[i][3] * v[i][3]); }
    ss = wave_sum(ss); const float r = rsqrtf(ss * (1.0f / D) + EPS);
#pragma unroll
    for (int i = 0; i < 8; ++i) { const int c = (lane + 64 * i) * 4; *(f32x4*)(orow + c) = v[i] * r * *(const f32x4*)(p.final_norm + c); }
}

template <class TEpi> __device__ __forceinline__ void tail_tile(const bf16_t* A, int arow0, const bf16_t* Bt, int brow0, int brow1, const int K, float* red, const TEpi& E, int c, const int wave) {
    const int tid = ltid_w(wave), wid = tid >> 6, lane = tid & 63, li = lane & 15, kq = lane >> 4;
    const int kw = K >> 3, k0 = wid * kw;
    const bf16_t* ap = A + (size_t)(arow0 + li) * K + k0 + 8 * kq;
    const bf16_t* bp0 = Bt + (size_t)(brow0 + li) * K + k0 + 8 * kq;
    const bf16_t* bp1 = Bt + (size_t)(brow1 + li) * K + k0 + 8 * kq;
    f32x4 acc[2][4];
#pragma unroll
    for (int x = 0; x < 2; ++x)
#pragma unroll
        for (int y = 0; y < 4; ++y) acc[x][y] = (f32x4){0.f, 0.f, 0.f, 0.f};
#pragma unroll 6
    for (int k = 0; k < kw; k += 32) {
        pg8::bf16x8 a[2], bfr[4];
        a[0] = *(const pg8::bf16x8*)(ap + k); a[1] = *(const pg8::bf16x8*)(ap + (size_t)16 * K + k);
        bfr[0] = *(const pg8::bf16x8*)(bp0 + k); bfr[1] = *(const pg8::bf16x8*)(bp0 + (size_t)16 * K + k);
        bfr[2] = *(const pg8::bf16x8*)(bp1 + k); bfr[3] = *(const pg8::bf16x8*)(bp1 + (size_t)16 * K + k);
#pragma unroll
        for (int x = 0; x < 2; ++x)
#pragma unroll
            for (int y = 0; y < 4; ++y) acc[x][y] = __builtin_amdgcn_mfma_f32_16x16x32_bf16(bfr[y], a[x], acc[x][y], 0, 0, 0);
    }
#pragma unroll
    for (int x = 0; x < 2; ++x)
#pragma unroll
        for (int y = 0; y < 4; ++y) *(f32x4*)(red + wid * 2048 + (16 * x + li) * 64 + 16 * y + 4 * kq) = acc[x][y];
    lds_barrier();
    { const int row = tid >> 4, col4 = (tid & 15) * 4; f32x4 v = {0.f, 0.f, 0.f, 0.f};
#pragma unroll
      for (int w = 0; w < 8; ++w) v += *(const f32x4*)(red + w * 2048 + row * 64 + col4);
      E(arow0 + row, c, col4, v); }
    lds_barrier();
}
struct TEpiResid {
    float* H; bf16_t* HB; float* rowss; float scale;
    __device__ __forceinline__ void operator()(int r, int c, int col4, f32x4 v) const {
        float* hp = H + (size_t)r * D + c * 64 + col4; f32x4 a = *(const f32x4*)hp; a += v * scale; *(f32x4*)hp = a;
        float ss = (a[0] * a[0] + a[1] * a[1]) + (a[2] * a[2] + a[3] * a[3]);
        ss += shx<1>(ss); ss += shx<2>(ss); ss += shx<4>(ss); ss += shx<8>(ss);
        if (HB) { u32x2v w; w[0] = pk2(a[0], a[1]); w[1] = pk2(a[2], a[3]); *(u32x2v*)(HB + (size_t)r * D + c * 64 + col4) = w; }
        if (rowss && (lane_id() & 15) == 0) rowss[(size_t)r * 32 + c] = ss;
    }
};
struct TEpiScale {
    bf16_t* O; int ldc; const float* rowss;
    __device__ __forceinline__ void operator()(int r, int c, int col4, f32x4 v) const {
        const int l = lane_id() & 15; float s = rowss[(size_t)r * 32 + 2 * l] + rowss[(size_t)r * 32 + 2 * l + 1];
        s += shx<1>(s); s += shx<2>(s); s += shx<4>(s); s += shx<8>(s);
        const float rs = rsqrtf(s * (1.0f / D) + EPS);
        u32x2v w; w[0] = pk2(v[0] * rs, v[1] * rs); w[1] = pk2(v[2] * rs, v[3] * rs); *(u32x2v*)(O + (size_t)r * ldc + c * 64 + col4) = w;
    }
};

#define run_gemm(...) run_gemm_(__VA_ARGS__, p.wave)
template <class Epi> __device__ __forceinline__ void run_gemm_(PG8_LAS unsigned char* lds, const bf16_t* A, const bf16_t* Bt, int Mr, int N, int K, const Epi& E, const int wave) {
    pg8::Gemm g; g.A = A; g.Bt = Bt; g.M = Mr; g.N = N; g.K = K;
    pg8::StaticOrder S; S.init(Mr, N, (int)gridDim.x, (int)blockIdx.x);
    pg8::gemm_phase<Epi, pg8::StaticOrder>(lds, g, S, E, ltid_w(wave));
}

__device__ __forceinline__ void gbar(const __attribute__((address_space(4))) Params* kp, int wave, int k) {
    __syncthreads();
    if (ltid_w(wave) == 0) {
        unsigned* bar = kp->bar; const unsigned target = (unsigned)k * gridDim.x;
        __threadfence();
        __hip_atomic_fetch_add(bar, 1u, __ATOMIC_RELEASE, __HIP_MEMORY_SCOPE_AGENT);
        while (__hip_atomic_load(bar, __ATOMIC_RELAXED, __HIP_MEMORY_SCOPE_AGENT) < target) __builtin_amdgcn_s_sleep(1);
        __threadfence();
    }
    __syncthreads();
}
typedef const __attribute__((address_space(4))) Params* KParams;
#if defined(__HIP_DEVICE_COMPILE__)
#define LOADP() Params p; { KParams q_ = kp; asm volatile("" : "+s"(q_)); p = *q_; p.wave = wave_s; }
#else
#define LOADP() Params p = p_unused; p.wave = wave_s; (void)kp;
#endif
#define PSEC(i, stmt) do { unsigned long long a_ = PROBE_MASK ? wall_clock64() : 0ull; stmt; if (PROBE_MASK && ((PROBE_MASK >> (i)) & 1u)) t_acc += wall_clock64() - a_; } while (0)
#define MARK(i) do { if (PROBE_MASK) { const unsigned long long t_ = wall_clock64(); if ((PROBE_MASK >> (i)) & 1u) t_acc += t_ - t_last; t_last = t_; } } while (0)
__global__ __launch_bounds__(512, 2) void mega(Params p_unused) {
    KParams kp = (KParams)__builtin_amdgcn_kernarg_segment_ptr();
    const int wave_s = __builtin_amdgcn_readfirstlane((int)(threadIdx.x >> 6));
    unsigned long long t_acc = 0ull, t_last = PROBE_MASK ? wall_clock64() : 0ull;
    extern __shared__ __attribute__((aligned(16))) unsigned char smem[];
    cg::grid_group grid = cg::this_grid();
    PG8_LAS unsigned char* lds = (PG8_LAS unsigned char*)smem;
    float* smf = (float*)smem;
    const int G = gridDim.x, bid = blockIdx.x;
    { LOADP();
      transpose_mat(p.ffn1_wg, p.Wgu1, p.ffn1_norm, D, DFF, DFF, DFF, 1, smf, p.wave);
      transpose_mat(p.ffn1_wu, p.Wgu1, p.ffn1_norm, D, DFF, DFF, DFF, 2, smf, p.wave);
      transpose_mat(p.ffn1_wd, p.Wd1, nullptr, DFF, D, D, D, 0, smf, p.wave); }
    { LOADP();
      transpose_mat(p.w_in, p.Win, p.mix_norm, D, INCP, INC, INC, 0, smf, p.wave);
      transpose_mat(p.w_out, p.Wout, nullptr, D, D, D, D, 0, smf, p.wave); }
    { LOADP();
      if (bid == 0 && ltid_w(p.wave) == 0) { p.ctr[0] = 0u; p.ctr[1] = 0u; }
      wb_items(p);
      for (int it = bid; it < NT_ROWS + NT_Z2; it += G) { if (it < NT_ROWS) row_item(p, it); else z2_item(p, it - NT_ROWS); } }
    grid.sync(); MARK(0);
    { LOADP(); EpiSwiglu E; E.O = p.big; E.rowss = p.rowss; run_gemm(lds, p.hb, p.Wgu1, MP, 2 * DFF, D, E); }
    { LOADP(); if (bid >= 172) bg_convert(p, smem, 6); }
    gbar(kp, wave_s, 1); MARK(1);
    { LOADP(); EpiResid<true> E; E.H = p.h; E.HB = p.hb; E.rowss = p.rowss; E.scale = 0.5f; run_gemm(lds, p.big, p.Wd1, 8192, D, DFF, E); }
    { LOADP(); TEpiResid T; T.H = p.h; T.HB = p.hb; T.rowss = p.rowss; T.scale = 0.5f;
      for (int c = bid; c < 32; c += G) PSEC(24, tail_tile(p.big, 8192, p.Wd1, 64 * c, 64 * c + 32, DFF, smf, T, c, p.wave)); }
    { LOADP(); if (bid >= 32) bg_convert(p, smem, 3); }
    gbar(kp, wave_s, 2); MARK(2);
    { LOADP(); EpiScale E; E.O = p.big; E.ldc = INCP; E.rowss = p.rowss; run_gemm(lds, p.hb, p.Win, 8192, 6144, D, E); }
    { LOADP(); TEpiScale T; T.O = p.big; T.ldc = INCP; T.rowss = p.rowss;
      for (int it = bid; it < 97 + 256; it += G) { if (it < 97) tail_tile(p.hb, 8192, p.Win, 64 * it, 64 * it + 32, D, smf, T, it, p.wave); else tail_tile(p.hb, 32 * (it - 97), p.Win, 6144, 6176, D, smf, T, 96, p.wave); } }
    { LOADP(); if (bid >= 97) bg_convert(p, smem, 2); }
    gbar(kp, wave_s, 3); MARK(3);
    { LOADP(); EpiFilt E; E.GF = p.GF; E.G0 = p.G0; PSEC(20, run_gemm(lds, p.WB, p.ZA, 2048, 4352, 256, E)); }
    { LOADP(); for (int it = bid; it < 1040 + 520; it += G) { if (it < 1040) PSEC(21, gla_pre(p, it, smem)); else PSEC(22, hyu_item(p, it - 1040, smem)); } }
    gbar(kp, wave_s, 4); MARK(4);
    { LOADP(); if (bid < 128) PSEC(23, gla_scan(p, ((((bid & 7) | (((bid >> 3) & 1) << 3)) << 3) | (bid >> 4)), smem, t_acc)); }
    if (bid < 128) { LOADP(); bg_convert(p, smem, 6); }
    if (bid >= 128) { LOADP();
      for (;;) {
        if (ltid_w(p.wave) == 0) *(int*)(smem + HY_ZERO_OFF + 192) = (int)atomicAdd(p.ctr, 1u);
        lds_barrier();
        const int g = *(const int*)(smem + HY_ZERO_OFF + 192);
        lds_barrier();
        if (g >= 256) break;
        hyena_group(p, (g & 7) * 32 + (g >> 3), smem, t_acc);
      } }
    gbar(kp, wave_s, 5); MARK(5);
    { LOADP(); for (int it = bid; it < MP / 8; it += G) fin_item(p, it); }
    gbar(kp, wave_s, 6); MARK(6);
    { LOADP(); EpiResid<true> E; E.H = p.h; E.HB = p.hb; E.rowss = p.rowss; E.scale = 1.0f; run_gemm(lds, p.y, p.Wout, 8192, D, D, E); }
    { LOADP(); TEpiResid T; T.H = p.h; T.HB = p.hb; T.rowss = p.rowss; T.scale = 1.0f;
      for (int c = bid; c < 32; c += G) tail_tile(p.y, 8192, p.Wout, 64 * c, 64 * c + 32, D, smf, T, c, p.wave); }
    { LOADP(); bg_convert(p, smem, 1 << 20); }
    gbar(kp, wave_s, 7); MARK(7);
    { LOADP(); EpiSwiglu E; E.O = p.big; E.rowss = p.rowss; run_gemm(lds, p.hb, p.Wgu2, MP, 2 * DFF, D, E); }
    gbar(kp, wave_s, 8); MARK(8);
    { LOADP(); EpiResid<false> E; E.H = p.h; E.HB = nullptr; E.rowss = nullptr; E.scale = 0.5f; run_gemm(lds, p.big, p.Wd2, 8192, D, DFF, E); }
    { LOADP(); TEpiResid T; T.H = p.h; T.HB = nullptr; T.rowss = nullptr; T.scale = 0.5f;
      for (int c = bid; c < 32; c += G) tail_tile(p.big, 8192, p.Wd2, 64 * c, 64 * c + 32, DFF, smf, T, c, p.wave); }
    gbar(kp, wave_s, 9); MARK(9);
    { LOADP(); for (int it = bid; it < 1024; it += G) final_item(p, it); }
    MARK(10);
    if (PROBE_MASK && bid == 0) { const unsigned long long t0_ = wall_clock64(); while (wall_clock64() - t0_ < (unsigned long long)PROBE_K * t_acc) __builtin_amdgcn_s_sleep(8); }
}

extern "C" void kernel_launch(void* const* d_in, const int* in_sizes, int n_in, void* d_out, int out_size, void* d_ws, size_t ws_size, hipStream_t stream) {
    static int grid_blocks = 0;
    if (!grid_blocks) {
        (void)hipFuncSetAttribute((const void*)mega, hipFuncAttributeMaxDynamicSharedMemorySize, LDS_BYTES);
        int dev = 0, cus = 0, per_cu = 0;
        (void)hipGetDevice(&dev);
        (void)hipDeviceGetAttribute(&cus, hipDeviceAttributeMultiprocessorCount, dev);
        (void)hipOccupancyMaxActiveBlocksPerMultiprocessor(&per_cu, mega, 512, LDS_BYTES);
        if (per_cu > 1) per_cu = 1;
        if (per_cu < 1) { fprintf(stderr, "occupancy query returned %d\n", per_cu); per_cu = 1; }
        grid_blocks = cus * per_cu;
    }
    Params p{};
    const float* const* in = (const float* const*)d_in;
    p.x = in[0]; p.meta = in[1]; p.ffn1_norm = in[2]; p.ffn1_wg = in[3]; p.ffn1_wu = in[4]; p.ffn1_wd = in[5]; p.mix_norm = in[6]; p.w_in = in[7];
    p.conv_w = in[8]; p.conv_b = in[9]; p.filt_w1 = in[10]; p.filt_b1 = in[11]; p.filt_w2 = in[12]; p.filt_b2 = in[13]; p.filt_w3 = in[14]; p.filt_freq = in[15];
    p.hyena_d = in[16]; p.hyena_norm = in[17]; p.gk_w2 = in[18]; p.gk_b2 = in[19]; p.gla_norm = in[20]; p.w_out = in[21];
    p.ffn2_norm = in[22]; p.ffn2_wg = in[23]; p.ffn2_wu = in[24]; p.ffn2_wd = in[25]; p.final_norm = in[26];
    p.out = (float*)d_out;
    unsigned char* ws = (unsigned char*)d_ws;
    constexpr size_t SZ_WGU = (size_t)2 * DFF * D * 2, SZ_WD = (size_t)D * DFF * 2, SZ_WIN = (size_t)INCP * D * 2, SZ_WOUT = (size_t)D * D * 2;
    constexpr size_t SZ_H = (size_t)MP * D * 4, SZ_HB = (size_t)MP * D * 2, SZ_BIG = (size_t)MP * INCP * 2, SZ_RS = (size_t)MP * 32 * 4, SZ_Z2 = (size_t)L * 64 * 4;
    size_t o = 0;
    p.Wgu1 = (bf16_t*)(ws + o); o += SZ_WGU; p.Wd1 = (bf16_t*)(ws + o); o += SZ_WD; p.Win = (bf16_t*)(ws + o); o += SZ_WIN; p.Wout = (bf16_t*)(ws + o); o += SZ_WOUT;
    p.Wgu2 = (bf16_t*)(ws + o); o += SZ_WGU; p.Wd2 = (bf16_t*)(ws + o); o += SZ_WD;
    p.h = (float*)(ws + o); o += SZ_H; p.hb = (bf16_t*)(ws + o); o += SZ_HB; p.big = (bf16_t*)(ws + o); o += SZ_BIG; p.rowss = (float*)(ws + o); o += SZ_RS; p.z2 = (float*)(ws + o); o += SZ_Z2; p.ctr = (unsigned*)(ws + o); o += 256; p.ZA = (bf16_t*)(ws + o); o += (size_t)4352 * 256 * 2; p.WB = (bf16_t*)(ws + o); o += (size_t)2048 * 256 * 2; p.G0 = (float*)(ws + o); o += 2048 * 4; p.bar = (unsigned*)(ws + o); o += 256; p.dummy = (float*)(ws + o); o += 4096;
    p.yc = (bf16_t*)ws; p.y = (bf16_t*)(ws + (size_t)M * 1024 * 2); p.of = (float*)p.hb; p.ob = (float*)d_out; p.gp = ws + (size_t)M * 1024 * 2; p.GF = p.Win; p.uT = (bf16_t*)((unsigned char*)d_out + (size_t)M * 1024 * 4);
    if (o > ws_size) fprintf(stderr, "workspace too small: need %zu have %zu\n", o, ws_size);
    (void)hipMemsetAsync(p.bar, 0, 256, stream);
    void* args[] = {&p};
    hipError_t e = hipLaunchCooperativeKernel((void*)mega, dim3(grid_blocks), dim3(512), args, LDS_BYTES, stream);
    if (e != hipSuccess) fprintf(stderr, "cooperative launch failed: %s (grid %d)\n", hipGetErrorString(e), grid_blocks);
}
```
